# Optimizing an MI355X kernel written in HIP

```python
import math
import jax, jax.numpy as jnp
from jax import lax
import numpy as np

D_MODEL = 1024
BATCH = 2
SEQ = 8192
DEPTH = 2

CTX_LEN = 256
GRID_W = 64
Q_BLOCK = 128
RET_CHUNK = 128
ROPE_THETA = 10000.0
NORM_EPS = 1e-6
RWKV_LN_EPS = 64e-5

RET_HEADS = 4
RET_DK = 128
RET_DV = 128
GQA_Q_HEADS = 4
GQA_KV_HEADS = 2
GQA_GROUP = GQA_Q_HEADS // GQA_KV_HEADS
GQA_HEAD_DIM = 128
DIFF_HEADS = 4
DIFF_HEAD_DIM = 64
DIFF_V_DIM = 2 * DIFF_HEAD_DIM
RWKV_HEADS = 8
RWKV_HEAD_DIM = 64
RWKV_W = RWKV_HEADS * RWKV_HEAD_DIM
RWKV_W_LORA = 64
RWKV_A_LORA = 64
RWKV_G_LORA = 128
FFN_HIDDEN = 2816
N_EXPERTS = 8
TOP_K = 2
EXPERT_HIDDEN = 3584

N_EVEN = (DEPTH + 1) // 2
N_ODD = DEPTH // 2

EVEN_WIDTHS = (RET_HEADS * RET_DK, RET_HEADS * RET_DK, RET_HEADS * RET_DV, RET_HEADS * RET_DV,
               GQA_Q_HEADS * GQA_HEAD_DIM, GQA_KV_HEADS * GQA_HEAD_DIM, GQA_KV_HEADS * GQA_HEAD_DIM)
EVEN_IN = sum(EVEN_WIDTHS)
EVEN_MIX = RET_HEADS * RET_DV + GQA_Q_HEADS * GQA_HEAD_DIM
RWKV_WIDTHS = (RWKV_W, RWKV_W, RWKV_W, 2 * RWKV_W_LORA, 2 * RWKV_A_LORA, RWKV_G_LORA)
RWKV_SHIFT_W = sum(RWKV_WIDTHS)
ODD_WIDTHS = (DIFF_HEADS * 2 * DIFF_HEAD_DIM, DIFF_HEADS * 2 * DIFF_HEAD_DIM, DIFF_HEADS * DIFF_V_DIM, RWKV_SHIFT_W)
ODD_IN = sum(ODD_WIDTHS)
ODD_MIX = DIFF_HEADS * DIFF_V_DIM + RWKV_W

kernel_name = 'hybrid_retention_gqa_diffattn_rwkv7_moe_dit'


def rmsnorm(x, g, eps=NORM_EPS):
    xf = x.astype(jnp.float32)
    y = xf * lax.rsqrt(jnp.mean(xf * xf, axis=-1, keepdims=True) + eps)
    return (y * g.astype(jnp.float32)).astype(x.dtype)


def head_layernorm(y, g, b, eps):
    yf = y.astype(jnp.float32)
    mu = jnp.mean(yf, axis=-1, keepdims=True)
    var = jnp.mean(jnp.square(yf - mu), axis=-1, keepdims=True)
    h, n = y.shape[-2:]
    return (yf - mu) * lax.rsqrt(var + eps) * g.reshape(h, n).astype(jnp.float32) + b.reshape(h, n).astype(jnp.float32)


def modulate(h, shift, scale):
    return h * (1.0 + scale) + shift


def split_cols(p, widths):
    out, start = [], 0
    for w in widths:
        out.append(p[..., start:start + w])
        start += w
    return out


def axial_rope_tables(rows, dim):
    row = jnp.repeat(jnp.arange(rows, dtype=jnp.float32), GRID_W)
    col = jnp.tile(jnp.arange(GRID_W, dtype=jnp.float32), rows)
    n_freq = dim // 4
    freqs = ROPE_THETA ** (-jnp.arange(n_freq, dtype=jnp.float32) / n_freq)
    ang = jnp.concatenate([row[:, None] * freqs, col[:, None] * freqs], axis=-1)
    return jnp.cos(ang), jnp.sin(ang)


def apply_rope(x, cos, sin):
    half = x.shape[-1] // 2
    xf = x.astype(jnp.float32)
    x1, x2 = xf[..., :half], xf[..., half:]
    return jnp.concatenate([x1 * cos - x2 * sin, x1 * sin + x2 * cos], axis=-1).astype(x.dtype)


def sweep_query_blocks(block_fn, q):
    lead = q.shape[:-2]
    n, d = q.shape[-2:]
    nb = n // Q_BLOCK
    qb = jnp.moveaxis(q.reshape(lead + (nb, Q_BLOCK, d)), -3, 0)
    out = jnp.moveaxis(lax.map(block_fn, qb), 0, -3)
    return out.reshape(out.shape[:-3] + (n, out.shape[-1]))


def gqa_attend(q, k, v):
    scale = q.shape[-1] ** -0.5
    def block(qb):
        s = jnp.einsum('bkgqd,bksd->bkgqs', qb, k).astype(jnp.float32) * scale
        p = jax.nn.softmax(s, axis=-1).astype(v.dtype)
        return jnp.einsum('bkgqs,bksd->bkgqd', p, v)
    return sweep_query_blocks(block, q)


def diff_attend(q, k, v, lam):
    scale = q.shape[-1] ** -0.5
    def block(qb):
        s = jnp.einsum('bhmqd,bhmsd->bhmqs', qb, k).astype(jnp.float32) * scale
        p = jax.nn.softmax(s, axis=-1)
        p = p[:, :, 0] - lam * p[:, :, 1]
        return jnp.einsum('bhqs,bhsv->bhqv', p.astype(v.dtype), v)
    return sweep_query_blocks(block, q)


def retention_scan(q, k, v, log_gamma, state0, strict):
    bsz, nh, n, dk = q.shape
    dv = v.shape[-1]
    nc = n // RET_CHUNK
    pos = jnp.arange(RET_CHUNK, dtype=jnp.float32)
    diff = pos[:, None] - pos[None, :]
    mask = diff > 0 if strict else diff >= 0
    inner_decay = jnp.where(mask, jnp.exp(log_gamma[:, None, None] * jnp.maximum(diff, 0.0)), 0.0)
    q_decay = jnp.exp(log_gamma[:, None] * (pos + 1.0))[..., None]
    k_decay = jnp.exp(log_gamma[:, None] * (RET_CHUNK - 1.0 - pos))[..., None]
    chunk_decay = jnp.exp(log_gamma * RET_CHUNK)[:, None, None]

    def to_chunks(t):
        return jnp.moveaxis(t.astype(jnp.float32).reshape(bsz, nh, nc, RET_CHUNK, t.shape[-1]), 2, 0)

    def step(r_state, qkv):
        qc, kc, vc = qkv
        inner = jnp.einsum('bhnd,bhmd->bhnm', qc, kc) * inner_decay
        y = jnp.einsum('bhnm,bhmv->bhnv', inner, vc) + jnp.einsum('bhnd,bhdv->bhnv', qc * q_decay, r_state)
        r_state = r_state * chunk_decay + jnp.einsum('bhmd,bhmv->bhdv', kc * k_decay, vc)
        return r_state, y

    r_final, ys = lax.scan(step, state0, (to_chunks(q), to_chunks(k), to_chunks(v)))
    return jnp.moveaxis(ys, 0, 2).reshape(bsz, nh, n, dv), r_final


def bidirectional_retention(ctx_qkv, lat_qkv, log_gamma):
    bsz, nh, _, dk = ctx_qkv[0].shape
    dv = ctx_qkv[2].shape[-1]
    zero = jnp.zeros((bsz, nh, dk, dv), jnp.float32)
    y_ctx, y_lat = 0.0, 0.0
    for d in range(2):
        f = (lambda t: t[..., ::-1, :]) if d else (lambda t: t)
        yc, state = retention_scan(*[f(t) for t in ctx_qkv], log_gamma[d], zero, strict=bool(d))
        yl, _ = retention_scan(*[f(t) for t in lat_qkv], log_gamma[d], state, strict=bool(d))
        y_ctx = y_ctx + f(yc)
        y_lat = y_lat + f(yl)
    return y_ctx, y_lat


def centred_token_shift(p, mu):
    prev = jnp.pad(p[:, :-1], ((0, 0), (1, 0), (0, 0)))
    nxt = jnp.pad(p[:, 1:], ((0, 0), (0, 1), (0, 0)))
    return p + mu * (0.5 * (prev + nxt) - p)


def rwkv_inputs(p, w0, w2, a0, a2, k_k, k_a):
    bsz, n, _ = p.shape
    r, k, v, wd, ad, gd = split_cols(p, RWKV_WIDTHS)
    def heads(t):
        return t.reshape(bsz, n, RWKV_HEADS, RWKV_HEAD_DIM)
    wd = wd.reshape(bsz, n, 2, RWKV_W_LORA)
    ad = ad.reshape(bsz, n, 2, RWKV_A_LORA)
    kk = heads(k * k_k).astype(jnp.float32)
    kk = kk / jnp.maximum(jnp.sqrt(jnp.sum(kk * kk, axis=-1, keepdims=True)), 1e-12)
    per_dir = []
    for d in range(2):
        wl = (w0[d] + jnp.tanh(wd[:, :, d]) @ w2[d]).astype(jnp.float32)
        decay = jnp.exp(-jnp.exp(-jax.nn.softplus(-wl) - 0.5))
        a = jax.nn.sigmoid(a0[d] + ad[:, :, d] @ a2[d])
        kd = k * (1.0 + (a - 1.0) * k_a)
        per_dir.append((heads(r), heads(decay), heads(kd), heads(v), -kk, kk * heads(a).astype(jnp.float32)))
    return per_dir, (heads(r), heads(k), heads(v), gd)


def rwkv_scan(r, w, k, v, a, b, state0, read_before):
    def step(s, inp):
        rt, wt, kt, vt, at, bt = inp
        s_new = (s * wt[:, :, None, :]
                 + jnp.einsum('bhvk,bhk->bhv', s, at)[..., None] * bt[:, :, None, :]
                 + vt[..., None] * kt[:, :, None, :])
        y = jnp.einsum('bhvk,bhk->bhv', s if read_before else s_new, rt)
        return s_new, y
    xs = tuple(jnp.moveaxis(t.astype(jnp.float32), 1, 0) for t in (r, w, k, v, a, b))
    s_final, ys = lax.scan(step, state0, xs)
    return jnp.moveaxis(ys, 0, 1), s_final


def rwkv_branch(pc, pl, w0, w2, a0, a2, g2, k_k, k_a, r_k, ln_g, ln_b, need_ctx):
    ctx_dirs, ctx_extra = rwkv_inputs(pc, w0, w2, a0, a2, k_k, k_a)
    lat_dirs, lat_extra = rwkv_inputs(pl, w0, w2, a0, a2, k_k, k_a)
    bsz = pl.shape[0]
    zero = jnp.zeros((bsz, RWKV_HEADS, RWKV_HEAD_DIM, RWKV_HEAD_DIM), jnp.float32)
    y_ctx, y_lat = 0.0, 0.0
    for d in range(2):
        f = (lambda t: t[:, ::-1]) if d else (lambda t: t)
        yc, state = rwkv_scan(*[f(t) for t in ctx_dirs[d]], zero, read_before=bool(d))
        yl, _ = rwkv_scan(*[f(t) for t in lat_dirs[d]], state, read_before=bool(d))
        y_ctx = y_ctx + f(yc)
        y_lat = y_lat + f(yl)

    def finish(y, extra):
        r, k, v, gd = extra
        n = r.shape[1]
        y = head_layernorm(y, ln_g, ln_b, RWKV_LN_EPS).astype(r.dtype)
        bonus = jnp.sum(r * k * r_k, axis=-1, keepdims=True) * v
        return (y + bonus).reshape(bsz, n, RWKV_W) * (jax.nn.sigmoid(gd) @ g2)

    return (finish(y_ctx, ctx_extra) if need_ctx else None), finish(y_lat, lat_extra)


def even_mixer(hc, hl, rope_ret, rope_gqa, w_in, w_out, decay_exp, ret_g, q_g, k_g, need_ctx):
    bsz = hl.shape[0]
    log_gamma = jnp.log1p(-jnp.exp2(-decay_exp.astype(jnp.float32)))

    def project(h, rope_r, rope_a):
        n = h.shape[1]
        rq, rk, rv, rg, aq, ak, av = split_cols(h @ w_in, EVEN_WIDTHS)
        def heads(t, nh, d):
            return t.reshape(bsz, n, nh, d).transpose(0, 2, 1, 3)
        rq = heads(rq, RET_HEADS, RET_DK)
        rk = heads(rk, RET_HEADS, RET_DK) * RET_DK ** -0.5
        rv = heads(rv, RET_HEADS, RET_DV)
        aq = heads(rmsnorm(aq.reshape(bsz, n, GQA_Q_HEADS, GQA_HEAD_DIM), q_g), GQA_Q_HEADS, GQA_HEAD_DIM)
        ak = heads(rmsnorm(ak.reshape(bsz, n, GQA_KV_HEADS, GQA_HEAD_DIM), k_g), GQA_KV_HEADS, GQA_HEAD_DIM)
        av = heads(av, GQA_KV_HEADS, GQA_HEAD_DIM)
        if rope_r is not None:
            rq, rk = apply_rope(rq, *rope_r), apply_rope(rk, *rope_r)
            aq, ak = apply_rope(aq, *rope_a), apply_rope(ak, *rope_a)
        aq = aq.reshape(bsz, GQA_KV_HEADS, GQA_GROUP, n, GQA_HEAD_DIM)
        return (rq, rk, rv), rg, (aq, ak, av)

    ctx_ret, ctx_gate, (cq, ck, cv) = project(hc, None, None)
    lat_ret, lat_gate, (lq, lk, lv) = project(hl, rope_ret, rope_gqa)
    ret_ctx, ret_lat = bidirectional_retention(ctx_ret, lat_ret, log_gamma)

    def ret_out(y, gate):
        n = y.shape[2]
        y = rmsnorm(y.transpose(0, 2, 1, 3), ret_g.reshape(RET_HEADS, RET_DV))
        return y.reshape(bsz, n, RET_HEADS * RET_DV).astype(gate.dtype) * jax.nn.silu(gate)

    def gqa_out(o):
        n = o.shape[3]
        o = o.reshape(bsz, GQA_Q_HEADS, n, GQA_HEAD_DIM).transpose(0, 2, 1, 3)
        return o.reshape(bsz, n, GQA_Q_HEADS * GQA_HEAD_DIM)

    attn_lat = gqa_attend(lq, jnp.concatenate([ck, lk], axis=2), jnp.concatenate([cv, lv], axis=2))
    y_lat = jnp.concatenate([ret_out(ret_lat, lat_gate), gqa_out(attn_lat)], axis=-1) @ w_out
    y_ctx = None
    if need_ctx:
        y_ctx = jnp.concatenate([ret_out(ret_ctx, ctx_gate), gqa_out(gqa_attend(cq, ck, cv))], axis=-1) @ w_out
    return y_ctx, y_lat


def odd_mixer(hc, hl, rope_diff, w_in, w_out, lam_vec, subln_g, lam_init, mu, w0, w2, a0, a2, g2,
              k_k, k_a, r_k, ln_g, ln_b, need_ctx):
    bsz = hl.shape[0]
    lamv = lam_vec.astype(jnp.float32)
    lam = jnp.exp(jnp.sum(lamv[0] * lamv[1])) - jnp.exp(jnp.sum(lamv[2] * lamv[3])) + lam_init

    def project(h, rope):
        n = h.shape[1]
        dq, dk, dv, rw = split_cols(h @ w_in, ODD_WIDTHS)
        q = dq.reshape(bsz, n, DIFF_HEADS, 2, DIFF_HEAD_DIM).transpose(0, 2, 3, 1, 4)
        k = dk.reshape(bsz, n, DIFF_HEADS, 2, DIFF_HEAD_DIM).transpose(0, 2, 3, 1, 4)
        v = dv.reshape(bsz, n, DIFF_HEADS, DIFF_V_DIM).transpose(0, 2, 1, 3)
        if rope is not None:
            q, k = apply_rope(q, *rope), apply_rope(k, *rope)
        return (q, k, v), centred_token_shift(rw, mu)

    (cq, ck, cv), c_rw = project(hc, None)
    (lq, lk, lv), l_rw = project(hl, rope_diff)
    rwkv_ctx, rwkv_lat = rwkv_branch(c_rw, l_rw, w0, w2, a0, a2, g2, k_k, k_a, r_k, ln_g, ln_b, need_ctx)

    def diff_out(o):
        n = o.shape[2]
        o = rmsnorm(o.transpose(0, 2, 1, 3), subln_g) * (1.0 - lam_init)
        return o.reshape(bsz, n, DIFF_HEADS * DIFF_V_DIM)

    attn_lat = diff_attend(lq, jnp.concatenate([ck, lk], axis=3), jnp.concatenate([cv, lv], axis=2), lam)
    y_lat = jnp.concatenate([diff_out(attn_lat), rwkv_lat], axis=-1) @ w_out
    y_ctx = None
    if need_ctx:
        y_ctx = jnp.concatenate([diff_out(diff_attend(cq, ck, cv, lam)), rwkv_ctx], axis=-1) @ w_out
    return y_ctx, y_lat


def swiglu(h, wg, wu, wd):
    return (jax.nn.silu(h @ wg) * (h @ wu)) @ wd


def moe_swiglu(h, router, wg, wu, wd):
    logits = (h @ router).astype(jnp.float32)
    top_logits, top_idx = lax.top_k(logits, TOP_K)
    top_w = jax.nn.softmax(top_logits, axis=-1)
    gates = jnp.einsum('bske,bsk->bse', jax.nn.one_hot(top_idx, N_EXPERTS, dtype=jnp.float32), top_w).astype(h.dtype)
    out = jnp.zeros_like(h)
    for e in range(N_EXPERTS):
        out = out + gates[..., e:e + 1] * swiglu(h, wg[e], wu[e], wd[e])
    return out


def setup_inputs(seed: int = 0) -> dict:
    key = jax.random.key(seed)
    ks = iter(jax.random.split(key, 40))
    f32 = jnp.float32
    def nrm(shape, scale):
        return scale * jax.random.normal(next(ks), shape, f32)
    D = D_MODEL
    ramp = jnp.arange(RWKV_W, dtype=f32) / (RWKV_W - 1)
    return {
        'x': nrm((BATCH, SEQ, D), 1.0),
        'c': nrm((BATCH, D), 1.0),
        'ctx': nrm((BATCH, CTX_LEN, D), 1.0),
        'c_ctx': nrm((D,), 1.0),
        'mod_w': nrm((DEPTH, D, 6 * D), 0.5 * D ** -0.5),
        'mod_b': nrm((DEPTH, 6 * D), 0.02),
        'norm_g': 1.0 + nrm((DEPTH, 4, D), 0.05),
        'even_w_in': nrm((N_EVEN, D, EVEN_IN), D ** -0.5),
        'even_w_out': nrm((N_EVEN, EVEN_MIX, D), EVEN_MIX ** -0.5),
        'ret_decay_exp': 5.0 + jnp.arange(RET_HEADS, dtype=f32) + nrm((N_EVEN, 2, RET_HEADS), 0.1),
        'ret_norm_g': 1.0 + nrm((N_EVEN, RET_HEADS * RET_DV), 0.05),
        'gqa_q_norm': 1.0 + nrm((N_EVEN, GQA_HEAD_DIM), 0.05),
        'gqa_k_norm': 1.0 + nrm((N_EVEN, GQA_HEAD_DIM), 0.05),
        'ffn_w_gate': nrm((N_EVEN, D, FFN_HIDDEN), D ** -0.5),
        'ffn_w_up': nrm((N_EVEN, D, FFN_HIDDEN), D ** -0.5),
        'ffn_w_down': nrm((N_EVEN, FFN_HIDDEN, D), FFN_HIDDEN ** -0.5),
        'odd_w_in': nrm((N_ODD, D, ODD_IN), D ** -0.5),
        'odd_w_out': nrm((N_ODD, ODD_MIX, D), ODD_MIX ** -0.5),
        'diff_lambda': nrm((N_ODD, 4, DIFF_HEAD_DIM), 0.1),
        'diff_subln_g': 1.0 + nrm((N_ODD, DIFF_V_DIM), 0.05),
        'rwkv_mu': jax.random.uniform(next(ks), (N_ODD, RWKV_SHIFT_W), f32),
        'rwkv_w0': -6.0 + 5.0 * ramp ** 0.85 + nrm((N_ODD, 2, RWKV_W), 0.1),
        'rwkv_w2': nrm((N_ODD, 2, RWKV_W_LORA, RWKV_W), 0.5 * RWKV_W_LORA ** -0.5),
        'rwkv_a0': nrm((N_ODD, 2, RWKV_W), 0.1),
        'rwkv_a2': nrm((N_ODD, 2, RWKV_A_LORA, RWKV_W), 0.5 * RWKV_A_LORA ** -0.5),
        'rwkv_g2': nrm((N_ODD, RWKV_G_LORA, RWKV_W), RWKV_G_LORA ** -0.5),
        'rwkv_k_k': 0.85 + nrm((N_ODD, RWKV_W), 0.05),
        'rwkv_k_a': 1.0 + nrm((N_ODD, RWKV_W), 0.05),
        'rwkv_r_k': nrm((N_ODD, RWKV_HEADS, RWKV_HEAD_DIM), 0.1),
        'rwkv_ln_g': 1.0 + nrm((N_ODD, RWKV_W), 0.05),
        'rwkv_ln_b': nrm((N_ODD, RWKV_W), 0.02),
        'moe_router': nrm((N_ODD, D, N_EXPERTS), D ** -0.5),
        'moe_w_gate': nrm((N_ODD, N_EXPERTS, D, EXPERT_HIDDEN), D ** -0.5),
        'moe_w_up': nrm((N_ODD, N_EXPERTS, D, EXPERT_HIDDEN), D ** -0.5),
        'moe_w_down': nrm((N_ODD, N_EXPERTS, EXPERT_HIDDEN, D), EXPERT_HIDDEN ** -0.5),
    }


def reference(x, c, ctx, c_ctx, mod_w, mod_b, norm_g, even_w_in, even_w_out, ret_decay_exp, ret_norm_g,
              gqa_q_norm, gqa_k_norm, ffn_w_gate, ffn_w_up, ffn_w_down, odd_w_in, odd_w_out, diff_lambda,
              diff_subln_g, rwkv_mu, rwkv_w0, rwkv_w2, rwkv_a0, rwkv_a2, rwkv_g2, rwkv_k_k, rwkv_k_a, rwkv_r_k,
              rwkv_ln_g, rwkv_ln_b, moe_router, moe_w_gate, moe_w_up, moe_w_down):
    rows = x.shape[1] // GRID_W
    rope_ret = axial_rope_tables(rows, RET_DK)
    rope_gqa = axial_rope_tables(rows, GQA_HEAD_DIM)
    rope_diff = axial_rope_tables(rows, DIFF_HEAD_DIM)
    cond_lat = jax.nn.silu(c)
    cond_ctx = jax.nn.silu(c_ctx)

    for layer in range(DEPTH):
        i = layer // 2
        need_ctx = layer < DEPTH - 1
        l_sh1, l_sc1, l_g1, l_sh2, l_sc2, l_g2 = jnp.split((cond_lat @ mod_w[layer] + mod_b[layer])[:, None, :], 6, axis=-1)
        c_sh1, c_sc1, c_g1, c_sh2, c_sc2, c_g2 = jnp.split(cond_ctx @ mod_w[layer] + mod_b[layer], 6, axis=-1)

        hl = modulate(rmsnorm(x, norm_g[layer, 0]), l_sh1, l_sc1)
        hc = modulate(rmsnorm(ctx, norm_g[layer, 0]), c_sh1, c_sc1)
        if layer % 2 == 0:
            y_ctx, y_lat = even_mixer(hc, hl, rope_ret, rope_gqa, even_w_in[i], even_w_out[i], ret_decay_exp[i],
                                      ret_norm_g[i], gqa_q_norm[i], gqa_k_norm[i], need_ctx)
            ffn = lambda h: swiglu(h, ffn_w_gate[i], ffn_w_up[i], ffn_w_down[i])
        else:
            lam_init = 0.8 - 0.6 * math.exp(-0.3 * layer)
            y_ctx, y_lat = odd_mixer(hc, hl, rope_diff, odd_w_in[i], odd_w_out[i], diff_lambda[i], diff_subln_g[i],
                                     lam_init, rwkv_mu[i], rwkv_w0[i], rwkv_w2[i], rwkv_a0[i], rwkv_a2[i], rwkv_g2[i],
                                     rwkv_k_k[i], rwkv_k_a[i], rwkv_r_k[i], rwkv_ln_g[i], rwkv_ln_b[i], need_ctx)
            ffn = lambda h: moe_swiglu(h, moe_router[i], moe_w_gate[i], moe_w_up[i], moe_w_down[i])

        x = x + l_g1 * rmsnorm(y_lat, norm_g[layer, 1])
        x = x + l_g2 * rmsnorm(ffn(modulate(rmsnorm(x, norm_g[layer, 2]), l_sh2, l_sc2)), norm_g[layer, 3])
        if need_ctx:
            ctx = ctx + c_g1 * rmsnorm(y_ctx, norm_g[layer, 1])
            ctx = ctx + c_g2 * rmsnorm(ffn(modulate(rmsnorm(ctx, norm_g[layer, 2]), c_sh2, c_sc2)), norm_g[layer, 3])
    return x
```

```cpp
#include <hip/hip_runtime.h>
#include <cstdio>
#include <cstdint>
#ifndef MK_N_LAUNCHES
#define MK_N_LAUNCHES 23
#endif
namespace pg8 {
#define PG8_LAS __attribute__((address_space(3)))
typedef unsigned short bf16_t;
typedef short bf16x8 __attribute__((ext_vector_type(8)));
typedef float f32x4 __attribute__((ext_vector_type(4)));
typedef unsigned u32x4 __attribute__((ext_vector_type(4)));
constexpr int BM = 256, BK = 64, HALF = 128, HTB = HALF * BK * 2  , STAGE_BYTES = 8 * HTB, NXCD = 8, WGM = 8;

__host__ __device__ __forceinline__ int lds_byte(int r, int c) { const int st = (r >> 4) * 2 + (c >> 5), rr = r & 15, cc = c & 31, ob = rr * 64 + cc * 2; return st * 1024 + (ob ^ (((ob >> 9) & 1) << 5)); }
__host__ __device__ __forceinline__ void stage_rc(int b, int& R, int& C) { const int st = b / 1024, sb = b % 1024, swz = sb ^ (((sb >> 9) & 1) << 5); R = (st >> 1) * 16 + swz / 64; C = (st & 1) * 32 + (swz % 64) / 2; }
__host__ __device__ __forceinline__ int perm32(int rho) { const int n = rho >> 4, i = rho & 15; return 8 * (i >> 2) + 4 * n + (i & 3); }

struct Unit { int pm, pn; };
struct Gemm { const bf16_t* A; const bf16_t* Bt; int M, N, K; };

struct StaticOrder {
    int nM, nN, nwg, G, c;
    __host__ __device__ void init(int M, int N, int G_, int c_) { nM = M / BM; nN = N / BM; nwg = nM * nN; G = G_; c = c_; }
    __host__ __device__ bool next(int i, Unit& u) const {
        const long L = (long)i * G + c; if (L >= nwg) return false;
        int wgid = (int)L; { const int q = nwg / NXCD, r = nwg % NXCD, xcd = wgid % NXCD, off = wgid / NXCD; wgid = (xcd < r ? xcd * (q + 1) : r * (q + 1) + (xcd - r) * q) + off; }
        const int nig = WGM * nN, gid = wgid / nig, fm = gid * WGM, gsz = (nM - fm) < WGM ? (nM - fm) : WGM;
        u.pm = fm + ((wgid % nig) % gsz); u.pn = (wgid % nig) / gsz; return true;
    }
    __device__ __forceinline__ void a_ready(const Unit&) const {}
    __device__ __forceinline__ void done(const Unit&) const {}
};

__device__ __forceinline__ unsigned cvt_pk_bf16(float lo, float hi) { unsigned r; asm volatile("v_cvt_pk_bf16_f32 %0, %1, %2" : "=v"(r) : "v"(lo), "v"(hi)); return r; }
typedef float f32x2 __attribute__((ext_vector_type(2)));
__device__ __forceinline__ float bf2f(unsigned short h) { return __uint_as_float(((unsigned)h) << 16); }
__device__ __forceinline__ float silu_f(float x) { return x / (1.0f + __expf(-x)); }
__device__ __forceinline__ float sigmoid_f(float x) { return 1.0f / (1.0f + __expf(-x)); }
__device__ __forceinline__ u32x4 pack8(const f32x4 a, const f32x4 b) { u32x4 w; w.x = cvt_pk_bf16(a[0], a[1]); w.y = cvt_pk_bf16(a[2], a[3]); w.z = cvt_pk_bf16(b[0], b[1]); w.w = cvt_pk_bf16(b[2], b[3]); return w; }
__device__ __forceinline__ void unpack8(const u32x4 w, float (&f)[8]) {
    f[0] = __uint_as_float(w.x << 16); f[1] = __uint_as_float(w.x & 0xffff0000u); f[2] = __uint_as_float(w.y << 16); f[3] = __uint_as_float(w.y & 0xffff0000u);
    f[4] = __uint_as_float(w.z << 16); f[5] = __uint_as_float(w.z & 0xffff0000u); f[6] = __uint_as_float(w.w << 16); f[7] = __uint_as_float(w.w & 0xffff0000u); }

struct EpiStore {
    static constexpr bool PERM = true, AFTER_DRAIN = false;
    bf16_t* O; int ldc; int ncolt;
    __device__ __forceinline__ void operator()(const f32x4 (&acc)[2][2][4][2], const Unit& u, int wr, int wc, int fr, int fq) const {
        const int row0 = u.pm * BM + wr * 64 + fr, col0 = (u.pn % ncolt) * BM + wc * 32 + 8 * fq;
#pragma unroll
        for (int ai = 0; ai < 2; ++ai)
#pragma unroll
            for (int m = 0; m < 4; ++m) { bf16_t* rowp = O + (size_t)(row0 + ai * HALF + m * 16) * ldc + col0;
#pragma unroll
                for (int bj = 0; bj < 2; ++bj) *(u32x4*)(rowp + bj * HALF) = pack8(acc[ai][bj][m][0], acc[ai][bj][m][1]); }
    }
};
struct EpiSwiglu {
    static constexpr bool PERM = true, AFTER_DRAIN = false;
    bf16_t* O; int ldc; int ncolt;
    __device__ __forceinline__ void operator()(const f32x4 (&acc)[2][2][4][2], const Unit& u, int wr, int wc, int fr, int fq) const {
        const int row0 = u.pm * BM + wr * 64 + fr, col0 = (u.pn % ncolt) * HALF + wc * 32 + 8 * fq;
#pragma unroll
        for (int ai = 0; ai < 2; ++ai)
#pragma unroll
            for (int m = 0; m < 4; ++m) { bf16_t* rowp = O + (size_t)(row0 + ai * HALF + m * 16) * ldc + col0;
                f32x4 o0, o1;
#pragma unroll
                for (int j = 0; j < 4; ++j) { o0[j] = silu_f(acc[ai][0][m][0][j]) * acc[ai][1][m][0][j]; o1[j] = silu_f(acc[ai][0][m][1][j]) * acc[ai][1][m][1][j]; }
                *(u32x4*)rowp = pack8(o0, o1); }
    }
};
struct EpiSplit1 {
    static constexpr bool PERM = true, AFTER_DRAIN = false;
    bf16_t* KV; bf16_t* RWQ;
    __device__ __forceinline__ void operator()(const f32x4 (&acc)[2][2][4][2], const Unit& u, int wr, int wc, int fr, int fq) const {
        const int row0 = u.pm * BM + wr * 64 + fr; bf16_t* base; int ldc, colt;
        if (u.pn >= 2 && u.pn < 6) { base = KV; ldc = 1024; colt = (u.pn - 2) * BM; }
        else { base = RWQ; ldc = 2560; colt = (u.pn < 2 ? u.pn : u.pn - 4) * BM; }
        const int col0 = colt + wc * 32 + 8 * fq;
#pragma unroll
        for (int ai = 0; ai < 2; ++ai)
#pragma unroll
            for (int m = 0; m < 4; ++m) { bf16_t* rowp = base + (size_t)(row0 + ai * HALF + m * 16) * ldc + col0;
#pragma unroll
                for (int bj = 0; bj < 2; ++bj) *(u32x4*)(rowp + bj * HALF) = pack8(acc[ai][bj][m][0], acc[ai][bj][m][1]); }
    }
};
struct EpiLora {
    static constexpr bool PERM = true, AFTER_DRAIN = false;
    bf16_t* L0; bf16_t* L1; bf16_t* A0; bf16_t* A1; bf16_t* G;
    const float* w0; const float* a0;
    __device__ __forceinline__ void operator()(const f32x4 (&acc)[2][2][4][2], const Unit& u, int wr, int wc, int fr, int fq) const {
        const int row0 = u.pm * BM + wr * 64 + fr; const int blk = u.pn >> 1, col0 = (u.pn & 1) * BM + wc * 32 + 8 * fq;
        bf16_t* O = blk == 0 ? L0 : blk == 1 ? L1 : blk == 2 ? A0 : blk == 3 ? A1 : G;
        if (blk < 4) {
            const float* bsrc = (blk < 2 ? w0 + blk * 512 : a0 + (blk - 2) * 512) + col0; const float sc = blk < 2 ? 0.60653065971f : 1.0f;
#pragma unroll
            for (int bj = 0; bj < 2; ++bj) { const f32x4 b0 = *(const f32x4*)(bsrc + bj * HALF), b1 = *(const f32x4*)(bsrc + bj * HALF + 4);
#pragma unroll
                for (int ai = 0; ai < 2; ++ai)
#pragma unroll
                    for (int m = 0; m < 4; ++m) { f32x4 o0, o1;
#pragma unroll
                        for (int j = 0; j < 4; ++j) { o0[j] = sigmoid_f(acc[ai][bj][m][0][j] + b0[j]) * sc; o1[j] = sigmoid_f(acc[ai][bj][m][1][j] + b1[j]) * sc; }
                        *(u32x4*)(O + (size_t)(row0 + ai * HALF + m * 16) * 512 + col0 + bj * HALF) = pack8(o0, o1); } }
        } else {
#pragma unroll
            for (int ai = 0; ai < 2; ++ai)
#pragma unroll
                for (int m = 0; m < 4; ++m) { bf16_t* rowp = O + (size_t)(row0 + ai * HALF + m * 16) * 512 + col0;
#pragma unroll
                    for (int bj = 0; bj < 2; ++bj) *(u32x4*)(rowp + bj * HALF) = pack8(acc[ai][bj][m][0], acc[ai][bj][m][1]); }
        }
    }
};
struct MoeOrder {
    int nT, nN, G, c; const int* tile_e;
    __device__ __forceinline__ bool next(int i, Unit& u) const {
        const long L = (long)i * G + c; if (L >= (long)nT * nN) return false;
        const int t = (int)(L / nN), j = (int)(L % nN); u.pm = t; u.pn = tile_e[t] * nN + j; return true; }
    __device__ __forceinline__ void a_ready(const Unit&) const {}
    __device__ __forceinline__ void done(const Unit&) const {}
};

template <class Epi, class Sched, bool ALIGN_EPI = false, bool SP2 = false>
__device__ __forceinline__ void gemm_phase(PG8_LAS unsigned char* lds, const Gemm g, const Sched& S, const Epi& E) {
    const int tid = threadIdx.x, wid = __builtin_amdgcn_readfirstlane(tid >> 6), lane = tid & 63, wr = wid >> 2, wc = wid & 3, fr = lane & 15, fq = lane >> 4;
    const int K = g.K, nt = K / BK;
    unsigned voffA[2], voffB[2];
#pragma unroll
    for (int i = 0; i < 2; ++i) { int R, C; stage_rc(tid * 16 + i * 8192, R, C); const int Rb = Epi::PERM ? ((R & ~31) + perm32(R & 31)) : R;
        voffA[i] = (unsigned)(R * K + C) * 2u; voffB[i] = (unsigned)(Rb * K + C) * 2u; }
    const size_t kstep = (size_t)(BK * 2);
    const size_t hstep = (size_t)HALF * K * 2;
    const size_t tstep = 2 * hstep;
    const unsigned ldsw = (unsigned)wid * 1024u;
    const int aoff = lds_byte(wr * 64 + fr, fq * 8), boff = lds_byte(wc * 32 + fr, fq * 8);
#define PG8_SA(b, h) (((b) * 2 + (h)) * HTB)
#define PG8_SB(b, h) ((4 + (b) * 2 + (h)) * HTB)
#define PG8_STAGE(bufoff, gbase, voff) do { _Pragma("unroll") for (int _i = 0; _i < 2; ++_i) \
        __builtin_amdgcn_global_load_lds((const unsigned*)((const char*)(gbase) + (voff)[_i]), (PG8_LAS unsigned*)(lds + (bufoff) + ldsw + _i * 8192), 16, 0, 0); } while (0)
#define PG8_LDA(dst, b, h) do { _Pragma("unroll") for (int m = 0; m < 4; ++m) _Pragma("unroll") for (int k = 0; k < 2; ++k) dst[m][k] = *(const PG8_LAS bf16x8*)(lds + PG8_SA(b, h) + aoff + m * 2048 + k * 1024); } while (0)
#define PG8_LDB(dst, b, h) do { _Pragma("unroll") for (int n = 0; n < 2; ++n) _Pragma("unroll") for (int k = 0; k < 2; ++k) dst[n][k] = *(const PG8_LAS bf16x8*)(lds + PG8_SB(b, h) + boff + n * 2048 + k * 1024); } while (0)
#define PG8_MMA(ai, bj, At, Bt) do { __builtin_amdgcn_s_setprio(1); _Pragma("unroll") for (int m = 0; m < 4; ++m) _Pragma("unroll") for (int n = 0; n < 2; ++n) _Pragma("unroll") for (int k = 0; k < 2; ++k) \
        acc[ai][bj][m][n] = __builtin_amdgcn_mfma_f32_16x16x32_bf16(Bt[n][k], At[m][k], acc[ai][bj][m][n], 0, 0, 0); __builtin_amdgcn_s_setprio(0); } while (0)
#define PG8_WAIT_V(n) asm volatile("s_waitcnt vmcnt(" #n ")" ::: "memory")
#define PG8_WAIT_L(n) asm volatile("s_waitcnt lgkmcnt(" #n ")" ::: "memory")
#define PG8_BAR __builtin_amdgcn_s_barrier()
#define PG8_SCHED __builtin_amdgcn_sched_barrier(0)
    Unit cur, nxt; int ui = 0;
    if (!S.next(0, cur)) return;
    f32x4 acc[2][2][4][2];
#pragma unroll
    for (int a = 0; a < 2; ++a)
#pragma unroll
        for (int b = 0; b < 2; ++b)
#pragma unroll
            for (int m = 0; m < 4; ++m)
#pragma unroll
                for (int n = 0; n < 2; ++n) acc[a][b][m][n] = (f32x4){0.f, 0.f, 0.f, 0.f};
    bf16x8 At[4][2], B0[2][2], B1[2][2];
    const char* cA = (const char*)g.A + (size_t)cur.pm * tstep; const char* cB = (const char*)g.Bt + (size_t)cur.pn * tstep;
    S.a_ready(cur);
    if constexpr (SP2) {
        PG8_STAGE(PG8_SB(0, 0), cB, voffB); PG8_STAGE(PG8_SB(0, 1), cB + hstep, voffB); PG8_STAGE(PG8_SA(0, 0), cA, voffA); PG8_STAGE(PG8_SA(0, 1), cA + hstep, voffA);
        if (wr == 1) PG8_BAR;
        PG8_WAIT_V(2); PG8_BAR;
        PG8_STAGE(PG8_SB(1, 0), cB + kstep, voffB); PG8_STAGE(PG8_SA(1, 0), cA + kstep, voffA); PG8_STAGE(PG8_SB(1, 1), cB + hstep + kstep, voffB);
        PG8_WAIT_V(6); PG8_BAR;
    } else {
        PG8_STAGE(PG8_SB(0, 0), cB, voffB); PG8_STAGE(PG8_SA(0, 0), cA, voffA); PG8_STAGE(PG8_SB(0, 1), cB + hstep, voffB); PG8_STAGE(PG8_SA(0, 1), cA + hstep, voffA);
        if (wr == 1) PG8_BAR;
        PG8_WAIT_V(4); PG8_BAR;
        PG8_STAGE(PG8_SB(1, 0), cB + kstep, voffB); PG8_STAGE(PG8_SA(1, 0), cA + kstep, voffA); PG8_STAGE(PG8_SB(1, 1), cB + hstep + kstep, voffB);
        PG8_WAIT_V(6); PG8_BAR;
    }
    for (;;) {
        const bool has_next = S.next(ui + 1, nxt);
        const char* nA = has_next ? (const char*)g.A + (size_t)nxt.pm * tstep : cA; const char* nB = has_next ? (const char*)g.Bt + (size_t)nxt.pn * tstep : cB;
        for (int t = 0; t < nt; t += 2) {
            const bool last = (t == nt - 2);
            const char* a1 = cA + (size_t)(t + 1) * kstep;
            const char* a2 = last ? nA : cA + (size_t)(t + 2) * kstep; const char* b2 = last ? nB : cB + (size_t)(t + 2) * kstep;
            const char* a3 = a2 + kstep; const char* b3 = b2 + kstep;
            if (last && has_next) S.a_ready(nxt);
            if constexpr (SP2) {
            PG8_LDB(B0, 0, 0); PG8_LDB(B1, 0, 1); PG8_SCHED; PG8_LDA(At, 0, 0); PG8_STAGE(PG8_SA(1, 1), a1 + hstep, voffA);
            PG8_WAIT_V(8); PG8_WAIT_L(0); PG8_BAR; PG8_MMA(0, 0, At, B0); PG8_MMA(0, 1, At, B1); PG8_BAR; PG8_SCHED;
            PG8_LDA(At, 0, 1); PG8_STAGE(PG8_SB(0, 0), b2, voffB); PG8_STAGE(PG8_SB(0, 1), b2 + hstep, voffB); PG8_STAGE(PG8_SA(0, 0), a2, voffA);
            PG8_WAIT_V(8); PG8_WAIT_L(0); PG8_BAR; PG8_MMA(1, 0, At, B0); PG8_MMA(1, 1, At, B1); PG8_BAR; PG8_SCHED;
            PG8_LDB(B0, 1, 0); PG8_LDB(B1, 1, 1); PG8_SCHED; PG8_LDA(At, 1, 0); PG8_STAGE(PG8_SA(0, 1), a2 + hstep, voffA);
            PG8_WAIT_V(8); PG8_WAIT_L(0); PG8_BAR; PG8_MMA(0, 0, At, B0); PG8_MMA(0, 1, At, B1); PG8_BAR; PG8_SCHED;
            PG8_LDA(At, 1, 1); PG8_STAGE(PG8_SB(1, 0), b3, voffB); PG8_STAGE(PG8_SB(1, 1), b3 + hstep, voffB); PG8_STAGE(PG8_SA(1, 0), a3, voffA);
            PG8_WAIT_V(8); PG8_WAIT_L(0); PG8_BAR; PG8_MMA(1, 0, At, B0); PG8_MMA(1, 1, At, B1); PG8_BAR; PG8_SCHED;
            } else {
            PG8_LDB(B0, 0, 0); PG8_SCHED; PG8_LDA(At, 0, 0); PG8_STAGE(PG8_SA(1, 1), a1 + hstep, voffA);
            PG8_WAIT_L(8); PG8_BAR; PG8_WAIT_L(0); PG8_MMA(0, 0, At, B0); PG8_BAR; PG8_SCHED;
            PG8_LDB(B1, 0, 1); PG8_STAGE(PG8_SB(0, 0), b2, voffB);
            PG8_BAR; PG8_WAIT_L(0); PG8_MMA(0, 1, At, B1); PG8_BAR;
            PG8_LDA(At, 0, 1); PG8_STAGE(PG8_SA(0, 0), a2, voffA);
            PG8_BAR; PG8_WAIT_L(0); PG8_MMA(1, 0, At, B0); PG8_BAR; PG8_SCHED;
            PG8_STAGE(PG8_SB(0, 1), b2 + hstep, voffB);
            PG8_WAIT_V(6); PG8_BAR; PG8_MMA(1, 1, At, B1); PG8_BAR;
            PG8_LDB(B0, 1, 0); PG8_SCHED; PG8_LDA(At, 1, 0); PG8_STAGE(PG8_SA(0, 1), a2 + hstep, voffA);
            PG8_WAIT_L(8); PG8_BAR; PG8_WAIT_L(0); PG8_MMA(0, 0, At, B0); PG8_BAR; PG8_SCHED;
            PG8_LDB(B1, 1, 1); PG8_STAGE(PG8_SB(1, 0), b3, voffB);
            PG8_BAR; PG8_WAIT_L(0); PG8_MMA(0, 1, At, B1); PG8_BAR;
            PG8_LDA(At, 1, 1); PG8_STAGE(PG8_SA(1, 0), a3, voffA);
            PG8_BAR; PG8_WAIT_L(0); PG8_MMA(1, 0, At, B0); PG8_BAR; PG8_SCHED;
            PG8_STAGE(PG8_SB(1, 1), b3 + hstep, voffB);
            PG8_WAIT_V(6); PG8_BAR; PG8_MMA(1, 1, At, B1); PG8_BAR;
            }
        }
        if constexpr (ALIGN_EPI) { if (wr == 0) PG8_BAR; }
        if constexpr (!Epi::AFTER_DRAIN) { E(acc, cur, wr, wc, fr, fq); S.done(cur); }
        if (!has_next) break;
#pragma unroll
        for (int a = 0; a < 2; ++a)
#pragma unroll
            for (int b = 0; b < 2; ++b)
#pragma unroll
                for (int m = 0; m < 4; ++m)
#pragma unroll
                    for (int n = 0; n < 2; ++n) acc[a][b][m][n] = (f32x4){0.f, 0.f, 0.f, 0.f};
        cur = nxt; cA = nA; cB = nB; ++ui;
        if constexpr (ALIGN_EPI) { if (wr == 1) PG8_BAR; }
    }
    PG8_WAIT_V(0);
    if constexpr (!ALIGN_EPI) { if (wr == 0) PG8_BAR; }
    PG8_BAR;
    if constexpr (Epi::AFTER_DRAIN) { E.fused(acc, cur, wr, wc, fr, fq, lds, wid, lane); S.done(cur); }
#undef PG8_SA
#undef PG8_SB
#undef PG8_STAGE
#undef PG8_LDA
#undef PG8_LDB
#undef PG8_MMA
#undef PG8_WAIT_V
#undef PG8_WAIT_L
#undef PG8_BAR
#undef PG8_SCHED
}
}
namespace att {
using bf16 = unsigned short;
constexpr int   D = 128, NW = 8, QBLK = 32, KVBLK = 64;
constexpr float SCALE = 0.088388347648318440f;
constexpr float THR = 8.f;
constexpr int SDEPTH = 2;
constexpr size_t SHM_V = KVBLK * D * 2, SHM_K = KVBLK * D * 2, SHM_ATTN = 2 * SHM_V + 2 * SHM_K + NW * 64 * 4;
__device__ __forceinline__ unsigned short f2bf_rne(float f) { unsigned u = __builtin_bit_cast(unsigned, f); return (unsigned short)((u + 0x7fffu + ((u >> 16) & 1u)) >> 16); }
using bf16x8 = __attribute__((ext_vector_type(8))) short;
using s16x4  = __attribute__((ext_vector_type(4))) short;
using f32x16 = __attribute__((ext_vector_type(16))) float;
using f32x8  = __attribute__((ext_vector_type(8))) float;
using u32x4  = __attribute__((ext_vector_type(4))) unsigned;
#define KSWZ(row, colB) ((row) * 256 + ((colB) ^ (((row) & 7) << 4)))
#define SBAR() __builtin_amdgcn_sched_barrier(0)
__device__ __forceinline__ int crow(int r, int hi) { return (r & 3) + 8 * (r >> 2) + 4 * hi; }
__device__ __forceinline__ unsigned cvtpk(float lo, float hi) {
  unsigned r; asm volatile("v_cvt_pk_bf16_f32 %0, %1, %2" : "=v"(r) : "v"(lo), "v"(hi)); return r;
}
template <typename TIn> struct Stage;
template <> struct Stage<bf16>  { using T = bf16x8;
  __device__ static __forceinline__ T ld8(const bf16* p) { return *reinterpret_cast<const bf16x8*>(p); }
  __device__ static __forceinline__ bf16x8 tobf(T x) { return x; } };
template <> struct Stage<float> { using T = f32x8;
  __device__ static __forceinline__ T ld8(const float* p) { return *reinterpret_cast<const f32x8*>(p); }
  __device__ static __forceinline__ bf16x8 tobf(T x) {
    u32x4 w = {cvtpk(x[0], x[1]), cvtpk(x[2], x[3]), cvtpk(x[4], x[5]), cvtpk(x[6], x[7])}; return *reinterpret_cast<bf16x8*>(&w); } };

__device__ __forceinline__ void partialSM(f32x16& p0, f32x16& p1, float& m_reg, float& mn, float& alpha) {
  constexpr float C = SCALE * 1.4426950408889634f;
  float pmax = p0[0]; for (int r = 1; r < 16; ++r) pmax = fmaxf(pmax, p0[r]); for (int r = 0; r < 16; ++r) pmax = fmaxf(pmax, p1[r]);
  { auto rr = __builtin_amdgcn_permlane32_swap(__float_as_uint(pmax), __float_as_uint(pmax), false, false);
    pmax = fmaxf(__uint_as_float(rr[0]), __uint_as_float(rr[1])); }
  if (__builtin_expect(__all(pmax - m_reg <= THR / SCALE), 1)) { mn = m_reg; alpha = 1.f; }
  else { mn = fmaxf(m_reg, pmax); alpha = __builtin_amdgcn_exp2f((m_reg - mn) * C); m_reg = mn; }
  float mnC = -mn * C;
  for (int r = 0; r < 16; ++r) p0[r] = fmaf(p0[r], C, mnC); for (int r = 0; r < 16; ++r) p1[r] = fmaf(p1[r], C, mnC);
  for (int r = 0; r < 16; ++r) p0[r] = __builtin_amdgcn_exp2f(p0[r]);
}
__device__ __forceinline__ void finishSM(f32x16& p0, f32x16& p1, float alpha, float& l_reg, bf16x8& pa0, bf16x8& pa1, bf16x8& pa2, bf16x8& pa3) {
  for (int r = 0; r < 16; ++r) p1[r] = __builtin_amdgcn_exp2f(p1[r]);
  float ps = 0; for (int r = 0; r < 16; ++r) ps += p0[r]; for (int r = 0; r < 16; ++r) ps += p1[r];
  { auto rr = __builtin_amdgcn_permlane32_swap(__float_as_uint(ps), __float_as_uint(ps), false, false);
    ps = __uint_as_float(rr[0]) + __uint_as_float(rr[1]); }
  l_reg = l_reg * alpha + ps;
#define PK4(P, BASE, OUT) do { unsigned a0 = cvtpk(P[BASE + 0], P[BASE + 1]), a1 = cvtpk(P[BASE + 2], P[BASE + 3]);   \
    unsigned b0 = cvtpk(P[BASE + 4], P[BASE + 5]), b1 = cvtpk(P[BASE + 6], P[BASE + 7]);                              \
    auto r0 = __builtin_amdgcn_permlane32_swap(a0, b0, false, false); auto r1 = __builtin_amdgcn_permlane32_swap(a1, b1, false, false); \
    u32x4 w = {r0[0], r1[0], r0[1], r1[1]}; OUT = *reinterpret_cast<bf16x8*>(&w); } while (0)
  PK4(p0, 0, pa0); PK4(p0, 8, pa1); PK4(p1, 0, pa2); PK4(p1, 8, pa3);
#undef PK4
}
__device__ __forceinline__ void qkt(f32x16& p0, f32x16& p1, const bf16* Ks, const bf16x8* qr, int r32, int hi) {
  p0 = f32x16{}; p1 = f32x16{};
  for (int d0 = 0; d0 < 8; ++d0) { int cb = (d0 * 16 + hi * 8) * 2;
    bf16x8 b0 = *reinterpret_cast<const bf16x8*>((const char*)Ks + KSWZ(r32, cb));
    bf16x8 b1 = *reinterpret_cast<const bf16x8*>((const char*)Ks + KSWZ(32 + r32, cb));
    p0 = __builtin_amdgcn_mfma_f32_32x32x16_bf16(b0, qr[d0], p0, 0, 0, 0);
    p1 = __builtin_amdgcn_mfma_f32_32x32x16_bf16(b1, qr[d0], p1, 0, 0, 0); }
}
__device__ __forceinline__ int v_st(int k, int c) { const int kk = (k & ~0xC) | ((k & 4) << 1) | ((k & 8) >> 1); return ((kk >> 3) * 4 + (c >> 5)) * 512 + ((kk & 7) * 32 + (c & 31)) * 2; }
__device__ __forceinline__ int v_rd_base(int lane) { return ((lane & 3) << 3) | (((lane >> 2) & 3) << 6) | (((lane >> 4) & 1) << 5) | (((lane >> 5) & 1) << 8); }
constexpr int v_rd_off(int d0, int ks, int half) { return d0 * 512 + ks * 4096 + half * 2048; }
template <int OFF> __device__ __forceinline__ s16x4 tr_read(int vb) {
  s16x4 r; asm volatile("ds_read_b64_tr_b16 %0, %1 offset:%2" : "=&v"(r) : "v"(vb), "i"(OFF) : "memory"); return r;
}
template <int D0> __device__ __forceinline__ void pv_one(f32x16& od, int vb, bf16x8 pa0, bf16x8 pa1, bf16x8 pa2, bf16x8 pa3) {
  const s16x4 l0 = tr_read<v_rd_off(D0, 0, 0)>(vb), h0 = tr_read<v_rd_off(D0, 0, 1)>(vb), l1 = tr_read<v_rd_off(D0, 1, 0)>(vb), h1 = tr_read<v_rd_off(D0, 1, 1)>(vb);
  const s16x4 l2 = tr_read<v_rd_off(D0, 2, 0)>(vb), h2 = tr_read<v_rd_off(D0, 2, 1)>(vb), l3 = tr_read<v_rd_off(D0, 3, 0)>(vb), h3 = tr_read<v_rd_off(D0, 3, 1)>(vb);
  asm volatile("s_waitcnt lgkmcnt(0)" ::: "memory"); SBAR();
#define PK(L, H) (bf16x8){L[0], L[1], L[2], L[3], H[0], H[1], H[2], H[3]}
  od = __builtin_amdgcn_mfma_f32_32x32x16_bf16(pa0, PK(l0, h0), od, 0, 0, 0);
  od = __builtin_amdgcn_mfma_f32_32x32x16_bf16(pa1, PK(l1, h1), od, 0, 0, 0);
  od = __builtin_amdgcn_mfma_f32_32x32x16_bf16(pa2, PK(l2, h2), od, 0, 0, 0);
  od = __builtin_amdgcn_mfma_f32_32x32x16_bf16(pa3, PK(l3, h3), od, 0, 0, 0);
#undef PK
}
__device__ __forceinline__ void pv_d0(f32x16* o, int vb, bf16x8 pa0, bf16x8 pa1, bf16x8 pa2, bf16x8 pa3) {
  pv_one<0>(o[0], vb, pa0, pa1, pa2, pa3); pv_one<1>(o[1], vb, pa0, pa1, pa2, pa3); pv_one<2>(o[2], vb, pa0, pa1, pa2, pa3); pv_one<3>(o[3], vb, pa0, pa1, pa2, pa3);
}

template <int LDQ, int LDK, int LDO>
__device__ __forceinline__ void attn_dense_body(const bf16* __restrict__ Qb, const bf16* __restrict__ Kh, const bf16* __restrict__ Vh,
                                                bf16* __restrict__ Ob, int seq, char* lds) {
  using St = Stage<bf16>; using SQ = Stage<bf16>;
  const int tid = threadIdx.x, wid = tid >> 6, lane = tid & 63, r32 = lane & 31, hi = lane >> 5;
  bf16* V_lds = (bf16*)lds; bf16* K_lds = (bf16*)(lds + 2 * SHM_V);
  float* ws = (float*)(lds + 2 * SHM_V + 2 * SHM_K) + wid * 64; float* li_l = ws; float* al_l = ws + 32;
  float m_reg = -1e30f, l_reg = 0; f32x16 o[4] = {}; bf16x8 qr[8];
  const bf16* Qw = Qb + (long)(wid * QBLK + r32) * LDQ + hi * 8;
#pragma unroll
  for (int d0 = 0; d0 < 8; ++d0) qr[d0] = SQ::tobf(SQ::ld8(Qw + d0 * 16));
  const int sr = tid >> 4, sc = (tid & 15) * 8, vst0 = v_st(sr, sc), vst1 = v_st(32 + sr, sc);
  const int vb0 = (int)(uintptr_t)V_lds + v_rd_base(lane);
  struct { typename St::T vs0, vs1, ks0, ks1; } sr_[SDEPTH];
#define SLOAD(i, k0) do { sr_[i].vs0 = St::ld8(&Vh[(long)((k0) + sr) * LDK + sc]); sr_[i].vs1 = St::ld8(&Vh[(long)((k0) + 32 + sr) * LDK + sc]); \
    sr_[i].ks0 = St::ld8(&Kh[(long)((k0) + sr) * LDK + sc]); sr_[i].ks1 = St::ld8(&Kh[(long)((k0) + 32 + sr) * LDK + sc]); } while (0)
#define SWRITE(b, i) do { *(bf16x8*)((char*)V_lds + (b) * SHM_V + vst0) = St::tobf(sr_[i].vs0);          \
    *(bf16x8*)((char*)V_lds + (b) * SHM_V + vst1) = St::tobf(sr_[i].vs1); int kc = sc * 2;               \
    *(bf16x8*)((char*)K_lds + (b) * SHM_K + KSWZ(sr, kc)) = St::tobf(sr_[i].ks0);                       \
    *(bf16x8*)((char*)K_lds + (b) * SHM_K + KSWZ(32 + sr, kc)) = St::tobf(sr_[i].ks1); } while (0)
#define SWAIT() do { if constexpr (SDEPTH == 2) asm volatile("s_waitcnt vmcnt(4)" ::: "memory"); else asm volatile("s_waitcnt vmcnt(0)" ::: "memory"); } while (0)
#define RESC(a) do { if (__any((a) < 1.f)) { if (hi == 0) al_l[r32] = (a); asm volatile("s_waitcnt lgkmcnt(0)" ::: "memory"); \
    for (int d = 0; d < 4; ++d) for (int r = 0; r < 16; ++r) o[d][r] *= al_l[crow(r, hi)]; } } while (0)
  f32x16 pA0, pA1, pB0, pB1; float mnA, mnB, alA, alB; bf16x8 pa0, pa1, pa2, pa3; const int NT = seq / KVBLK;
  constexpr int SE = 0, SO = SDEPTH - 1;
  SLOAD(SE, 0); asm volatile("s_waitcnt vmcnt(0)" ::: "memory"); SWRITE(0, SE); __syncthreads();
  qkt(pA0, pA1, K_lds, qr, r32, hi); partialSM(pA0, pA1, m_reg, mnA, alA);
  SLOAD(SO, KVBLK); if constexpr (SDEPTH == 2) { if (2 < NT) SLOAD(SE, 2 * KVBLK); }
  SWAIT(); SWRITE(1, SO); __syncthreads();
  for (int j = 1; j + 1 < NT; j += 2) {
    SBAR(); qkt(pB0, pB1, (bf16*)((char*)K_lds + SHM_K), qr, r32, hi);
    finishSM(pA0, pA1, alA, l_reg, pa0, pa1, pa2, pa3); SBAR();
    SLOAD(SO, (j + SDEPTH) * KVBLK); SBAR();
    pv_d0(o, vb0, pa0, pa1, pa2, pa3); partialSM(pB0, pB1, m_reg, mnB, alB);
    __syncthreads(); SWAIT(); SWRITE(0, SE);
    RESC(alB); __syncthreads();
    SBAR(); qkt(pA0, pA1, K_lds, qr, r32, hi);
    finishSM(pB0, pB1, alB, l_reg, pa0, pa1, pa2, pa3); SBAR();
    if (SDEPTH == 1 || j + 3 < NT) SLOAD(SE, (j + 1 + SDEPTH) * KVBLK); SBAR();
    pv_d0(o, vb0 + (int)SHM_V, pa0, pa1, pa2, pa3); partialSM(pA0, pA1, m_reg, mnA, alA);
    __syncthreads(); SWAIT(); SWRITE(1, SO);
    RESC(alA); __syncthreads();
  }
  SBAR(); qkt(pB0, pB1, (bf16*)((char*)K_lds + SHM_K), qr, r32, hi);
  finishSM(pA0, pA1, alA, l_reg, pa0, pa1, pa2, pa3); SBAR();
  pv_d0(o, vb0, pa0, pa1, pa2, pa3); partialSM(pB0, pB1, m_reg, mnB, alB);
  __syncthreads(); RESC(alB);
  finishSM(pB0, pB1, alB, l_reg, pa0, pa1, pa2, pa3); SBAR();
  pv_d0(o, vb0 + (int)SHM_V, pa0, pa1, pa2, pa3);
  if (hi == 0) li_l[r32] = l_reg; asm volatile("s_waitcnt lgkmcnt(0)" ::: "memory");
  float rli[16];
#pragma unroll
  for (int r = 0; r < 16; ++r) rli[r] = __builtin_amdgcn_rcpf(li_l[crow(r, hi)]);
  bf16* Ow = Ob + (long)(wid * QBLK) * LDO;
#pragma unroll
  for (int r = 0; r < 16; ++r) { int orow = crow(r, hi);
    for (int d0 = 0; d0 < 4; ++d0) Ow[(long)orow * LDO + d0 * 32 + r32] = f2bf_rne(o[d0][r] * rli[r]); }
#undef SLOAD
#undef SWRITE
#undef SWAIT
#undef RESC
}
}

constexpr int NWAVES = 8;
constexpr int D = 1024, NB = 2, SL = 8192, CT = 256, TP = SL + CT, MR = NB * TP, ML = NB * SL;
constexpr int E_IN = 3072, O_IN = 3456, O_INP = 3584, FFH = 2816, NE = 8, EH = 3584;
constexpr int NCH = TP / 128;
constexpr int NPH = 23;
constexpr int N_LAUNCHES = MK_N_LAUNCHES;
constexpr float NORM_EPS = 1e-6f, RWKV_LN_EPS = 64e-5f;
constexpr float LAM_INIT = 0.3555090676f;
constexpr int MOE_ROWS = 2 * ML + NE * 256;

enum ScanArr { SA_R = 0, SA_V, SA_AN, SA_K, SA_L0, SA_L1, SA_A0, SA_A1, SA_G, SA_N };
constexpr size_t MiB = 1u << 20;
constexpr size_t WS_CTL = 0, CTL_ZERO_BYTES = 1 * MiB;
constexpr size_t WS_MODV = 1 * MiB;
constexpr size_t WS_ROUTE = 2 * MiB;
constexpr size_t WS_TILEE = 2 * MiB + 768 * 1024;
constexpr size_t WS_WL = 3 * MiB;
constexpr size_t WS_WIN0 = 5 * MiB, WS_WOUT0 = 11 * MiB, WS_WGU0 = 13 * MiB, WS_WD0 = 24 * MiB;
constexpr size_t WS_WIN1 = 30 * MiB, WS_WOUT1 = 37 * MiB;
constexpr size_t WS_XR = 39 * MiB;
constexpr size_t WS_H = 105 * MiB;
constexpr size_t WS_PRJ0 = 138 * MiB;
constexpr size_t WS_MIX0 = 237 * MiB;
constexpr size_t WS_UT = 270 * MiB;
constexpr size_t WS_Y0 = 270 * MiB;
constexpr size_t WS_ACT0 = 138 * MiB;
constexpr size_t WS_KV1 = 138 * MiB;
constexpr size_t WS_RWQ = 171 * MiB;
constexpr size_t WS_QD = 254 * MiB;
constexpr size_t WS_SCAN = 286 * MiB;
constexpr size_t SCAN_ARR = (size_t)MR * 512 * 2;
constexpr size_t WS_LIN = 468 * MiB;
constexpr size_t WS_OB = 171 * MiB;
constexpr size_t WS_YS = 203 * MiB;
constexpr size_t WS_Y1 = 138 * MiB;
constexpr size_t WS_H2 = 310 * MiB;
constexpr size_t WS_WMOE_GU = 349 * MiB, WS_WMOE_D = 461 * MiB;
constexpr size_t WS_AG = 242 * MiB;
constexpr size_t WS_ACT1 = 4 * MiB;
constexpr size_t WS_END = 517 * MiB;
static_assert(WS_WL + (size_t)2560 * 384 * 2 <= WS_WIN0 && WS_WD0 + (size_t)D * FFH * 2 <= WS_WIN1 && WS_WOUT1 + (size_t)D * D * 2 <= WS_XR, "ws map A");
static_assert(WS_XR + (size_t)MR * D * 4 <= WS_H && WS_H + (size_t)MR * D * 2 <= WS_PRJ0 && WS_PRJ0 + (size_t)MR * E_IN * 2 <= WS_MIX0 && WS_MIX0 + (size_t)MR * D * 2 <= WS_UT, "ws map B");
static_assert(WS_UT + (size_t)NB * 4 * NCH * 2 * 16384 * 4 <= WS_END && WS_ACT0 + (size_t)MR * FFH * 2 <= WS_MIX0, "ws map C");
static_assert((size_t)NB * 4 * NCH * 2 * 16384 * 2 <= (size_t)MR * D * 2, "ST fits in H");
static_assert(WS_KV1 + (size_t)MR * 1024 * 2 <= WS_RWQ && WS_RWQ + (size_t)MR * 2560 * 2 <= WS_QD && WS_QD + (size_t)ML * 1024 * 2 <= WS_SCAN && WS_SCAN + SA_N * SCAN_ARR <= WS_LIN && WS_LIN + (size_t)MR * 384 * 2 <= WS_END, "ws map D");
static_assert(WS_OB + (size_t)ML * 1024 * 2 <= WS_YS && WS_YS + (size_t)2 * ML * 512 * 2 <= WS_AG, "ws map E");
static_assert(WS_ACT1 + (size_t)MOE_ROWS * EH * 2 <= WS_AG && WS_AG + (size_t)MOE_ROWS * D * 2 <= WS_H2 && WS_H2 + (size_t)ML * D * 2 <= WS_WMOE_GU, "ws map F");
static_assert(WS_WMOE_GU + (size_t)NE * 2 * EH * D * 2 <= WS_WMOE_D && WS_WMOE_D + (size_t)NE * D * EH * 2 <= WS_END, "ws map G");
constexpr int CW_TMO = 0, CW_CODE = 1;
constexpr int CW_BAR = 4096;
constexpr int CW_QUEUE = 8192;
constexpr int CW_CNT = 8448;
static_assert((CW_CNT + 64 * NE) * 4 <= (int)CTL_ZERO_BYTES, "CTL");

constexpr int RING_OFF = 0, RING_BYTES = 131072;
constexpr int LDSCTL_OFF = RING_BYTES, MISC_OFF = LDSCTL_OFF + 320;
constexpr int LDS_BYTES = 147456;
static_assert(MISC_OFF + 128 <= LDS_BYTES, "LDS map");
#define GAS __attribute__((address_space(1)))
#define LAS __attribute__((address_space(3)))
typedef unsigned short bf16;
typedef unsigned v4u __attribute__((ext_vector_type(4)));
typedef float f32x4 __attribute__((ext_vector_type(4)));
typedef short bf16x8 __attribute__((ext_vector_type(8)));
typedef GAS unsigned gu32;
typedef GAS unsigned long long gu64;
#define RLX_AGENT __ATOMIC_RELAXED, __HIP_MEMORY_SCOPE_AGENT
#define LDS_WAIT() asm volatile("s_waitcnt lgkmcnt(0)" ::: "memory")
#define VM_WAIT() asm volatile("s_waitcnt vmcnt(0)" ::: "memory")
__device__ __forceinline__ unsigned long long rt() { return __builtin_amdgcn_s_memrealtime(); }
__device__ __forceinline__ unsigned f2bf(float f) { unsigned u = __builtin_bit_cast(unsigned, f); return (u + 0x7fffu + ((u >> 16) & 1u)) >> 16; }
__device__ __forceinline__ unsigned pk2(float lo, float hi) { return f2bf(lo) | (f2bf(hi) << 16); }

#define XB_TMO      128
#define XB_XCNT(j)  (256  + 64 * (j))
#define XB_XSUB(j)  (1280 + 64 * (j))
#define XB_XGEN(j)  (2304 + 64 * (j))
#define XB_TOP      3328
#define XB_TOPGEN   3392
#define XCD_BAR_WORDS 3456
#define XB_SPIN_CAP (1u << 18)

__device__ __forceinline__ unsigned xb_ld(unsigned* p)              { return __hip_atomic_load(p, __ATOMIC_RELAXED, __HIP_MEMORY_SCOPE_AGENT); }
__device__ __forceinline__ unsigned xb_add(unsigned* p, unsigned v) { return __hip_atomic_fetch_add(p, v, __ATOMIC_RELAXED, __HIP_MEMORY_SCOPE_AGENT); }
__device__ __forceinline__ unsigned xb_xcc_id() { return (unsigned)__builtin_amdgcn_s_getreg((3 << 11) | 20) & 0xFu; }
#define XB_SPIN(cond, bar) do { unsigned _sp = 0; while (cond) { __builtin_amdgcn_s_sleep(1); \
    if ((++_sp & 255u) == 0u) { if (xb_ld(&(bar)[XB_TMO])) break; if (_sp > XB_SPIN_CAP) { atomicAdd(&(bar)[XB_TMO], 1u); break; } } } } while (0)

struct XcdBarrier {
    unsigned* bar; unsigned x;
    volatile LAS unsigned* st;
};

__device__ __forceinline__ XcdBarrier xcd_barrier_post(unsigned* bar, volatile LAS unsigned* st) {
    XcdBarrier b; b.bar = bar; b.x = xb_xcc_id(); b.st = st;
    if (threadIdx.x == 0) (void)xb_add(&bar[XB_XCNT(b.x)], 1u);
    return b;
}
__device__ __forceinline__ void xcd_barrier_complete(unsigned* bar, unsigned x, unsigned& nloc, unsigned& nx) {
    const unsigned G = gridDim.x * gridDim.y * gridDim.z;
    unsigned sum, cnt, mine, sp = 0u;
    for (;;) {
        sum = 0u; cnt = 0u; mine = 0u;
#pragma unroll
        for (unsigned j = 0; j < 16; ++j) { const unsigned c = xb_ld(&bar[XB_XCNT(j)]); sum += c; cnt += (c > 0u) ? 1u : 0u; mine = (j == x) ? c : mine; }
        if (sum == G) break;
        __builtin_amdgcn_s_sleep(1);
        if ((++sp & 255u) == 0u) { if (xb_ld(&bar[XB_TMO])) break; if (sp > XB_SPIN_CAP) { atomicAdd(&bar[XB_TMO], 1u); break; } }
    }
    nloc = mine > 0u ? mine : 1u; nx = cnt > 0u ? cnt : 1u;
}

__device__ __forceinline__ void xcd_barrier(const XcdBarrier& b) {
    asm volatile("s_waitcnt vmcnt(0)" ::: "memory");
    __syncthreads();
    if (threadIdx.x == 0) {
        unsigned* bar = b.bar;
        __builtin_amdgcn_s_waitcnt(0);
        unsigned nloc = b.st[0], nx = b.st[1];
        if (nloc == 0u) { xcd_barrier_complete(bar, b.x, nloc, nx); b.st[0] = nloc; b.st[1] = nx; }
        const unsigned old = xb_add(&bar[XB_XSUB(b.x)], 1u);
        const unsigned gen = old / nloc;
        if (old + 1u == (gen + 1u) * nloc) {
            __builtin_amdgcn_fence(__ATOMIC_RELEASE, "agent");
            asm volatile("s_waitcnt vmcnt(0)" ::: "memory");
            const unsigned og = xb_add(&bar[XB_TOP], 1u);
            const unsigned tg = og / nx;
            if (og + 1u == (tg + 1u) * nx) xb_add(&bar[XB_TOPGEN], 1u);
            else XB_SPIN(xb_ld(&bar[XB_TOPGEN]) == tg, bar);
            __builtin_amdgcn_fence(__ATOMIC_ACQUIRE, "agent");
            xb_add(&bar[XB_XGEN(b.x)], 1u);
            asm volatile("s_waitcnt vmcnt(0)" ::: "memory");
        } else {
            XB_SPIN(xb_ld(&bar[XB_XGEN(b.x)]) == gen, bar);
            __builtin_amdgcn_fence(__ATOMIC_ACQUIRE, "agent");
            asm volatile("s_waitcnt vmcnt(0)" ::: "memory");
        }
    }
    __syncthreads();
}


struct Args { const float* in[35]; float* out; unsigned char* ws; int ph_lo, ph_hi; };
enum InIdx { I_X = 0, I_C, I_CTX, I_CCTX, I_MODW, I_MODB, I_NORMG, I_EWIN, I_EWOUT, I_RDEC, I_RNORMG, I_QNORM, I_KNORM, I_FWG, I_FWU, I_FWD, I_OWIN, I_OWOUT, I_DLAM, I_DSUBG,
             I_RMU, I_RW0, I_RW2, I_RA0, I_RA2, I_RG2, I_RKK, I_RKA, I_RRK, I_RLNG, I_RLNB, I_MROUTER, I_MWG, I_MWU, I_MWD };
struct Frame {
    LAS unsigned char* lds; char* ldsg;
    volatile LAS unsigned* MISC; gu32* ctl;
    int tid, lane, wave, vcu, G, gw, NGW;
    unsigned char* ws;
};
typedef float f32x2v __attribute__((ext_vector_type(2)));
typedef unsigned v2u __attribute__((ext_vector_type(2)));
typedef float f32x16 __attribute__((ext_vector_type(16)));
__device__ __forceinline__ float bf2f(unsigned short h) { return __uint_as_float(((unsigned)h) << 16); }
__device__ __forceinline__ float wave_sum(float v) {
#pragma unroll
    for (int o = 1; o < 64; o <<= 1) v += __shfl_xor(v, o);
    return v;
}
__device__ __forceinline__ void unpack8(const v4u w, float (&f)[8]) {
    f[0] = __uint_as_float(w.x << 16); f[1] = __uint_as_float(w.x & 0xffff0000u); f[2] = __uint_as_float(w.y << 16); f[3] = __uint_as_float(w.y & 0xffff0000u);
    f[4] = __uint_as_float(w.z << 16); f[5] = __uint_as_float(w.z & 0xffff0000u); f[6] = __uint_as_float(w.w << 16); f[7] = __uint_as_float(w.w & 0xffff0000u); }
__device__ __forceinline__ v4u pack8(const float (&f)[8]) { v4u w; w.x = pk2(f[0], f[1]); w.y = pk2(f[2], f[3]); w.z = pk2(f[4], f[5]); w.w = pk2(f[6], f[7]); return w; }
__device__ __forceinline__ f32x4 ld_bf4(const bf16* p) { const v2u w = *(const v2u*)p; return (f32x4){__uint_as_float(w.x << 16), __uint_as_float(w.x & 0xffff0000u), __uint_as_float(w.y << 16), __uint_as_float(w.y & 0xffff0000u)}; }
__device__ __forceinline__ void st_bf4(bf16* p, const f32x4 v) { v2u w; w.x = pk2(v[0], v[1]); w.y = pk2(v[2], v[3]); *(v2u*)p = w; }
__device__ __forceinline__ float sigmoidf_(float x) { return 1.0f / (1.0f + __expf(-x)); }
__device__ __forceinline__ float siluf_(float x) { return x / (1.0f + __expf(-x)); }
__device__ __forceinline__ float sq4(const f32x4 v) { return (v[0] * v[0] + v[1] * v[1]) + (v[2] * v[2] + v[3] * v[3]); }

__device__ __forceinline__ void tr_item(const float* W, int ldw, int k0, int nsrc0, bf16* WT, int ldt, int ndst0, LAS float* scr, int lane) {
#pragma unroll 8
    for (int i = 0; i < 32; ++i) { const int kk = 2 * i + (lane >> 5); scr[kk * 33 + (lane & 31)] = W[(size_t)(k0 + kk) * ldw + nsrc0 + (lane & 31)]; }
    LDS_WAIT(); asm volatile("" ::: "memory");
    const int c = lane & 7;
#pragma unroll
    for (int j = 0; j < 4; ++j) { const int n = (lane >> 3) + 8 * j; const LAS float* s = scr + (8 * c) * 33 + n;
        v4u o; o.x = pk2(s[0 * 33], s[1 * 33]); o.y = pk2(s[2 * 33], s[3 * 33]); o.z = pk2(s[4 * 33], s[5 * 33]); o.w = pk2(s[6 * 33], s[7 * 33]);
        *(GAS v4u*)(WT + (size_t)(ndst0 + n) * ldt + k0 + 8 * c) = o; }
    LDS_WAIT(); asm volatile("" ::: "memory");
}
__device__ __forceinline__ void tr_plain(const float* W, int K, int N, bf16* WT, LAS float* scr, int item, int lane) {
    const int nblk = N / 32, kb = item / nblk, nb = item % nblk; tr_item(W, N, 64 * kb, 32 * nb, WT, K, 32 * nb, scr, lane);
}
__device__ __forceinline__ void tr_gu(const float* Wg, const float* Wu, int K, int HID, bf16* WT, LAS float* scr, int item, int lane) {
    const int nblk = 2 * HID / 32, kb = item / nblk, nb = item % nblk, nd = 32 * nb, t = nd / 256, w = nd % 256;
    const bool up = w >= 128; tr_item(up ? Wu : Wg, HID, 64 * kb, 128 * t + (up ? w - 128 : w), WT, K, nd, scr, lane);
}
__device__ __forceinline__ void p0_prologue(const Frame& F, const Args& A) {
    LAS float* scr = (LAS float*)(F.lds + RING_OFF + F.wave * 16384);
    unsigned char* ws = F.ws;
    for (int it = F.gw; it < 192; it += F.NGW) {
        const int l = it / 96, cb = it % 96, col = 64 * cb + F.lane;
        for (int k = F.lane; k < 1024; k += 64) { scr[k] = siluf_(A.in[I_C][k]); scr[1024 + k] = siluf_(A.in[I_C][1024 + k]); scr[2048 + k] = siluf_(A.in[I_CCTX][k]); }
        LDS_WAIT(); asm volatile("" ::: "memory");
        const float* W = A.in[I_MODW] + (size_t)l * D * 6144 + col;
        float a0 = 0.f, a1 = 0.f, a2 = 0.f;
#pragma unroll 8
        for (int k = 0; k < 1024; ++k) { const float w = W[(size_t)k * 6144]; a0 += scr[k] * w; a1 += scr[1024 + k] * w; a2 += scr[2048 + k] * w; }
        const float bb = A.in[I_MODB][l * 6144 + col];
        float* mv = (float*)(ws + WS_MODV) + (size_t)l * 3 * 6144 + col;
        mv[0] = a0 + bb; mv[6144] = a1 + bb; mv[2 * 6144] = a2 + bb;
        LDS_WAIT(); asm volatile("" ::: "memory");
    }
    constexpr int I0 = (D / 64) * (E_IN / 32), I1 = (D / 64) * (D / 32), I2 = (D / 64) * (2 * FFH / 32), I3 = (FFH / 64) * (D / 32), I4 = (D / 64) * (O_IN / 32), I5 = I1;
    constexpr int NITEMS = I0 + I1 + I2 + I3 + I4 + I5;
    for (int it = F.gw; it < NITEMS; it += F.NGW) {
        int r = it;
        if (r < I0) { tr_plain(A.in[I_EWIN], D, E_IN, (bf16*)(ws + WS_WIN0), scr, r, F.lane); continue; } r -= I0;
        if (r < I1) { tr_plain(A.in[I_EWOUT], D, D, (bf16*)(ws + WS_WOUT0), scr, r, F.lane); continue; } r -= I1;
        if (r < I2) { tr_gu(A.in[I_FWG], A.in[I_FWU], D, FFH, (bf16*)(ws + WS_WGU0), scr, r, F.lane); continue; } r -= I2;
        if (r < I3) { tr_plain(A.in[I_FWD], FFH, D, (bf16*)(ws + WS_WD0), scr, r, F.lane); continue; } r -= I3;
        if (r < I4) { tr_plain(A.in[I_OWIN], D, O_IN, (bf16*)(ws + WS_WIN1), scr, r, F.lane); continue; } r -= I4;
        tr_plain(A.in[I_OWOUT], D, D, (bf16*)(ws + WS_WOUT1), scr, r, F.lane);
    }
    const int gt = F.vcu * (NWAVES * 64) + F.tid, NGT = F.G * NWAVES * 64;
    { bf16* z = (bf16*)(ws + WS_WIN1) + (size_t)O_IN * D; for (int i = gt; i < (O_INP - O_IN) * D / 8; i += NGT) *(v4u*)(z + (size_t)i * 8) = (v4u){0u, 0u, 0u, 0u}; }
    { bf16* wl = (bf16*)(ws + WS_WL);
      for (int i = gt; i < 2560 * 384; i += NGT) {
          const int n = i / 384, k = i % 384, blk = n / 512, nn = n % 512; float v = 0.f;
          if (blk < 2) { const int kk = k - 64 * blk; if (kk >= 0 && kk < 64) v = A.in[I_RW2][((size_t)blk * 64 + kk) * 512 + nn]; }
          else if (blk < 4) { const int d = blk - 2, kk = k - 128 - 64 * d; if (kk >= 0 && kk < 64) v = A.in[I_RA2][((size_t)d * 64 + kk) * 512 + nn]; }
          else { const int kk = k - 256; if (kk >= 0) v = A.in[I_RG2][(size_t)kk * 512 + nn]; }
          wl[i] = (bf16)f2bf(v); } }
}
__device__ __forceinline__ void moe_weights(const Frame& F, const Args& A) {
    LAS float* scr = (LAS float*)(F.lds + RING_OFF + F.wave * 16384);
    constexpr int IG = (D / 64) * (2 * EH / 32), ID = (EH / 64) * (D / 32);
    for (int it = F.gw; it < NE * (IG + ID); it += F.NGW) {
        const int e = it / (IG + ID); int r = it % (IG + ID);
        if (r < IG) tr_gu(A.in[I_MWG] + (size_t)e * D * EH, A.in[I_MWU] + (size_t)e * D * EH, D, EH, (bf16*)(F.ws + WS_WMOE_GU) + (size_t)e * 2 * EH * D, scr, r, F.lane);
        else tr_plain(A.in[I_MWD] + (size_t)e * EH * D, EH, D, (bf16*)(F.ws + WS_WMOE_D) + (size_t)e * D * EH, scr, r - IG, F.lane);
    }
}

__device__ __forceinline__ const float* modv(const Frame& F, int layer, int r) { const int b = r / TP, p = r % TP; return (const float*)(F.ws + WS_MODV) + (size_t)(layer * 3 + (p < CT ? 2 : b)) * 6144; }
__device__ __forceinline__ void p1_first_h(const Frame& F, const Args& A) {
    float* XR = (float*)(F.ws + WS_XR); bf16* H = (bf16*)(F.ws + WS_H); const float* ng = A.in[I_NORMG];
    for (int r = F.gw; r < MR; r += F.NGW) {
        const int b = r / TP, p = r % TP;
        const float* src = p < CT ? A.in[I_CTX] + (size_t)(b * CT + p) * D : A.in[I_X] + (size_t)(b * SL + p - CT) * D;
        const float* mv = modv(F, 0, r);
        f32x4 v[4]; float ss = 0.f;
#pragma unroll
        for (int j = 0; j < 4; ++j) { v[j] = *(const f32x4*)(src + 4 * F.lane + 256 * j); ss += sq4(v[j]); *(f32x4*)(XR + (size_t)r * D + 4 * F.lane + 256 * j) = v[j]; }
        const float rs = rsqrtf(wave_sum(ss) * (1.f / D) + NORM_EPS);
#pragma unroll
        for (int j = 0; j < 4; ++j) { const int c = 4 * F.lane + 256 * j; const f32x4 g = *(const f32x4*)(ng + c), sh = *(const f32x4*)(mv + c), sc = *(const f32x4*)(mv + 1024 + c);
            st_bf4(H + (size_t)r * D + c, (v[j] * rs * g) * (sc + 1.0f) + sh); }
    }
}
__device__ __forceinline__ void resid_norm(const Frame& F, const bf16* yrow, const float* xin, float* xout, const float* gate, const float* ngA, const float* ngB, const float* sh, const float* sc, bf16* hrow, f32x4 (&h)[4]) {
    f32x4 y[4]; float ss = 0.f;
#pragma unroll
    for (int j = 0; j < 4; ++j) { y[j] = ld_bf4(yrow + 4 * F.lane + 256 * j); ss += sq4(y[j]); }
    const float rs = rsqrtf(wave_sum(ss) * (1.f / D) + NORM_EPS);
    f32x4 x[4]; float s2 = 0.f;
#pragma unroll
    for (int j = 0; j < 4; ++j) { const int c = 4 * F.lane + 256 * j;
        x[j] = *(const f32x4*)(xin + c) + *(const f32x4*)(gate + c) * (y[j] * rs * *(const f32x4*)(ngA + c)); *(f32x4*)(xout + c) = x[j]; s2 += sq4(x[j]); }
    const float r2 = rsqrtf(wave_sum(s2) * (1.f / D) + NORM_EPS);
#pragma unroll
    for (int j = 0; j < 4; ++j) { const int c = 4 * F.lane + 256 * j;
        h[j] = (x[j] * r2 * *(const f32x4*)(ngB + c)) * (*(const f32x4*)(sc + c) + 1.0f) + *(const f32x4*)(sh + c); st_bf4(hrow + c, h[j]); }
}
__device__ __forceinline__ void p_resid_all(const Frame& F, const Args& A, const bf16* Y, int layer, int which  ) {
    float* XR = (float*)(F.ws + WS_XR); bf16* H = (bf16*)(F.ws + WS_H); const float* ng = A.in[I_NORMG];
    for (int r = F.gw; r < MR; r += F.NGW) {
        const float* mv = modv(F, layer, r); f32x4 h[4];
        if (which == 0) resid_norm(F, Y + (size_t)r * D, XR + (size_t)r * D, XR + (size_t)r * D, mv + 2 * 1024, ng + (layer * 4 + 1) * D, ng + (layer * 4 + 2) * D, mv + 3 * 1024, mv + 4 * 1024, H + (size_t)r * D, h);
        else { const float* mn = modv(F, layer + 1, r);
            resid_norm(F, Y + (size_t)r * D, XR + (size_t)r * D, XR + (size_t)r * D, mv + 5 * 1024, ng + (layer * 4 + 3) * D, ng + ((layer + 1) * 4 + 0) * D, mn + 0 * 1024, mn + 1 * 1024, H + (size_t)r * D, h); }
    }
}
template <int NP> __device__ __forceinline__ void rope_cs(int lane, int t, float (&cs)[8], float (&sn)[8]) {
    const float rowp = (float)(t / 64), colp = (float)(t % 64);
#pragma unroll
    for (int e = 0; e < 8; ++e) { const int i = 8 * (lane & (NP / 8 - 1)) + e, fi = i & (NP / 2 - 1);
        const float f = exp2f(-(float)fi * (13.287712379549449f / (float)(NP / 2))); const float ang = ((i < NP / 2) ? rowp : colp) * f;
        cs[e] = __cosf(ang); sn[e] = __sinf(ang); }
}
template <int XORD> __device__ __forceinline__ void rope_apply(float (&v)[8], const float (&cs)[8], const float (&sn)[8], bool first) {
#pragma unroll
    for (int e = 0; e < 8; ++e) { const float p = __shfl_xor(v[e], XORD); v[e] = first ? v[e] * cs[e] - p * sn[e] : p * sn[e] + v[e] * cs[e]; }
}
__device__ __forceinline__ void p3_post0(const Frame& F, const Args& A) {
    bf16* P = (bf16*)(F.ws + WS_PRJ0); const int l = F.lane;
    float qg[8], kg[8];
#pragma unroll
    for (int e = 0; e < 8; ++e) { qg[e] = A.in[I_QNORM][8 * (l & 15) + e]; kg[e] = A.in[I_KNORM][8 * (l & 15) + e]; }
    for (int r = F.gw; r < MR; r += F.NGW) {
        const int p = r % TP; const bool lat = p >= CT; bf16* row = P + (size_t)r * E_IN;
        float cs[8], sn[8];
#pragma unroll
        for (int e = 0; e < 8; ++e) { cs[e] = 1.f; sn[e] = 0.f; }
        if (lat) rope_cs<64>(l, p - CT, cs, sn);
        const bool first = (l & 8) == 0;
        float v[8];
        unpack8(*(const v4u*)(row + 8 * l), v); rope_apply<8>(v, cs, sn, first); *(v4u*)(row + 8 * l) = pack8(v);
        unpack8(*(const v4u*)(row + 512 + 8 * l), v);
#pragma unroll
        for (int e = 0; e < 8; ++e) v[e] *= 0.088388347648318440f;
        rope_apply<8>(v, cs, sn, first); *(v4u*)(row + 512 + 8 * l) = pack8(v);
        { unpack8(*(const v4u*)(row + 2048 + 8 * l), v); float ss = 0.f;
#pragma unroll
          for (int e = 0; e < 8; ++e) ss += v[e] * v[e];
          ss += __shfl_xor(ss, 1); ss += __shfl_xor(ss, 2); ss += __shfl_xor(ss, 4); ss += __shfl_xor(ss, 8);
          const float rs = rsqrtf(ss * (1.f / 128.f) + NORM_EPS);
#pragma unroll
          for (int e = 0; e < 8; ++e) v[e] = v[e] * rs * qg[e];
          rope_apply<8>(v, cs, sn, first); *(v4u*)(row + 2048 + 8 * l) = pack8(v); }
        { unpack8(*(const v4u*)(row + 2560 + 8 * l), v); float ss = 0.f;
#pragma unroll
          for (int e = 0; e < 8; ++e) ss += v[e] * v[e];
          ss += __shfl_xor(ss, 1); ss += __shfl_xor(ss, 2); ss += __shfl_xor(ss, 4); ss += __shfl_xor(ss, 8);
          const float rs = rsqrtf(ss * (1.f / 128.f) + NORM_EPS);
#pragma unroll
          for (int e = 0; e < 8; ++e) v[e] = v[e] * rs * kg[e];
          rope_apply<8>(v, cs, sn, first); if (l < 32) *(v4u*)(row + 2560 + 8 * l) = pack8(v); }
    }
}

typedef LAS unsigned short lbf16;
typedef short bf16x8 __attribute__((ext_vector_type(8)));
__device__ __forceinline__ float ret_lg(const Args& A, int d, int h) { return log2f(1.0f - exp2f(-A.in[I_RDEC][d * 4 + h])); }
template <int NOUT> __device__ __forceinline__ void stage_T(const bf16* src, int ld, lbf16* T0, lbf16* T1, int tid, float lg0, float lg1) {
    const int m = tid >> 2, q = tid & 3;
    const float s0 = NOUT == 2 ? exp2f(lg0 * (float)(127 - m)) : 1.f, s1 = NOUT == 2 ? exp2f(lg1 * (float)m) : 1.f;
#pragma unroll
    for (int c = 0; c < 4; ++c) { float f[8]; unpack8(*(const v4u*)(src + (size_t)m * ld + q * 32 + c * 8), f);
#pragma unroll
        for (int e = 0; e < 8; ++e) { const int col = q * 32 + c * 8 + e; T0[col * 136 + m] = (unsigned short)f2bf(f[e] * s0); if (NOUT == 2) T1[col * 136 + m] = (unsigned short)f2bf(f[e] * s1); } }
}
__device__ __forceinline__ void ret_u_unit(const Frame& F, const Args& A, int unit) {
    const int b = unit / (4 * NCH), h = (unit / NCH) % 4, g = unit % NCH, r0 = b * TP + g * 128;
    const bf16* P = (const bf16*)(F.ws + WS_PRJ0) + (size_t)r0 * E_IN;
    lbf16* KT0 = (lbf16*)(F.lds); lbf16* KT1 = KT0 + 128 * 136; lbf16* VT = KT1 + 128 * 136;
    const float lg0 = ret_lg(A, 0, h), lg1 = ret_lg(A, 1, h);
    stage_T<2>(P + 512 + h * 128, E_IN, KT0, KT1, F.tid, lg0, lg1);
    stage_T<1>(P + 1024 + h * 128, E_IN, VT, VT, F.tid, 0.f, 0.f);
    __syncthreads();
    const int rb = F.wave >> 1, ch = F.wave & 1, r32 = F.lane & 31, hi = F.lane >> 5;
#pragma unroll
    for (int d = 0; d < 2; ++d) {
        const lbf16* KT = d ? KT1 : KT0; f32x16 acc[2] = {};
#pragma unroll
        for (int ks = 0; ks < 8; ++ks) { const bf16x8 a = *(const LAS bf16x8*)(KT + (32 * rb + r32) * 136 + 16 * ks + 8 * hi);
#pragma unroll
            for (int dt = 0; dt < 2; ++dt) { const bf16x8 bb = *(const LAS bf16x8*)(VT + (64 * ch + 32 * dt + r32) * 136 + 16 * ks + 8 * hi);
                acc[dt] = __builtin_amdgcn_mfma_f32_32x32x16_bf16(a, bb, acc[dt], 0, 0, 0); } }
        float* U = (float*)(F.ws + WS_UT) + ((size_t)((b * 4 + h) * NCH + g) * 2 + d) * 16384;
#pragma unroll
        for (int dt = 0; dt < 2; ++dt) { const int dv = 64 * ch + 32 * dt + r32;
#pragma unroll
            for (int g4 = 0; g4 < 4; ++g4) *(f32x4*)(U + dv * 128 + 32 * rb + 8 * g4 + 4 * hi) = (f32x4){acc[dt][4 * g4], acc[dt][4 * g4 + 1], acc[dt][4 * g4 + 2], acc[dt][4 * g4 + 3]}; }
    }
    __syncthreads();
}
__device__ __forceinline__ void ret_prefix(const Frame& F, const Args& A) {
    const float* UT = (const float*)(F.ws + WS_UT); bf16* ST = (bf16*)(F.ws + WS_H);
    const int gt = F.vcu * (NWAVES * 64) + F.tid, NGT = F.G * NWAVES * 64;
    for (int idx = gt; idx < 16 * 16384; idx += NGT) {
        const int sc = idx >> 14, el = idx & 16383, b = sc >> 3, h = (sc >> 1) & 3, d = sc & 1;
        const float cd = exp2f(ret_lg(A, d, h) * 128.f); float s = 0.f;
#pragma unroll 6
        for (int i = 0; i < NCH; ++i) { const int g = d == 0 ? i : (i < 2 ? 1 - i : NCH + 1 - i);
            const size_t off = ((size_t)((b * 4 + h) * NCH + g) * 2 + d) * 16384 + el; ST[off] = (bf16)f2bf(s); s = s * cd + UT[off]; }
    }
}
__device__ __forceinline__ bf16x8 scale_frag(const bf16x8 q, float s) { float f[8]; unpack8(__builtin_bit_cast(v4u, q), f);
#pragma unroll
    for (int e = 0; e < 8; ++e) f[e] *= s;
    return __builtin_bit_cast(bf16x8, pack8(f)); }
__device__ __forceinline__ void ret_out_unit(const Frame& F, const Args& A, int unit) {
    const int b = unit / (4 * NCH), h = (unit / NCH) % 4, g = unit % NCH, r0 = b * TP + g * 128;
    const bf16* P = (const bf16*)(F.ws + WS_PRJ0) + (size_t)r0 * E_IN;
    lbf16* VT = (lbf16*)(F.lds); LAS float* YS = (LAS float*)(F.lds + 128 * 136 * 2);
    const float lg0 = ret_lg(A, 0, h), lg1 = ret_lg(A, 1, h);
    stage_T<1>(P + 1024 + h * 128, E_IN, VT, VT, F.tid, 0.f, 0.f);
    const int rb = F.wave >> 1, ch = F.wave & 1, r32 = F.lane & 31, hi = F.lane >> 5;
    const int n = 32 * rb + r32;
    bf16x8 qf[8];
#pragma unroll
    for (int ks = 0; ks < 8; ++ks) qf[ks] = *(const bf16x8*)(P + (size_t)n * E_IN + h * 128 + 16 * ks + 8 * hi);
    __syncthreads();
    f32x16 Y[2] = {};
    const lbf16* vrow0 = VT + (64 * ch + r32) * 136;
#pragma unroll
    for (int mt = 0; mt < 4; ++mt) {
        f32x16 X = {};
#pragma unroll
        for (int ks = 0; ks < 8; ++ks) { const bf16x8 kf = *(const bf16x8*)(P + (size_t)(32 * mt + r32) * E_IN + 512 + h * 128 + 16 * ks + 8 * hi);
            X = __builtin_amdgcn_mfma_f32_32x32x16_bf16(kf, qf[ks], X, 0, 0, 0); }
        float xs[16];
#pragma unroll
        for (int r = 0; r < 16; ++r) { const int m = 32 * mt + (r & 3) + 8 * (r >> 2) + 4 * hi; const float dl = (float)(n - m);
            xs[r] = X[r] * (dl >= 0.f ? exp2f(lg0 * dl) : exp2f(-lg1 * dl)); }
#pragma unroll
        for (int s = 0; s < 2; ++s) { v4u w; w.x = pk2(xs[8 * s], xs[8 * s + 1]); w.y = pk2(xs[8 * s + 2], xs[8 * s + 3]); w.z = pk2(xs[8 * s + 4], xs[8 * s + 5]); w.w = pk2(xs[8 * s + 6], xs[8 * s + 7]);
            const bf16x8 pa = __builtin_bit_cast(bf16x8, w);
#pragma unroll
            for (int dt = 0; dt < 2; ++dt) { const lbf16* vrow = vrow0 + 32 * dt * 136;
                const v2u lo = *(const LAS v2u*)(vrow + 32 * mt + 16 * s + 4 * hi), hh = *(const LAS v2u*)(vrow + 32 * mt + 16 * s + 8 + 4 * hi);
                const v4u wv = {lo.x, lo.y, hh.x, hh.y};
                Y[dt] = __builtin_amdgcn_mfma_f32_32x32x16_bf16(pa, __builtin_bit_cast(bf16x8, wv), Y[dt], 0, 0, 0); } }
        asm volatile("" ::: "memory");
    }
#pragma unroll
    for (int d = 0; d < 2; ++d) {
        const float qd = d == 0 ? exp2f(lg0 * (float)(n + 1)) : exp2f(lg1 * (float)(128 - n));
        const bf16* S = (const bf16*)(F.ws + WS_H) + ((size_t)((b * 4 + h) * NCH + g) * 2 + d) * 16384;
#pragma unroll
        for (int ks = 0; ks < 8; ++ks) { const bf16x8 qs = scale_frag(qf[ks], qd);
#pragma unroll
            for (int dt = 0; dt < 2; ++dt) { const bf16x8 sf = *(const bf16x8*)(S + (size_t)(64 * ch + 32 * dt + r32) * 128 + 16 * ks + 8 * hi);
                Y[dt] = __builtin_amdgcn_mfma_f32_32x32x16_bf16(qs, sf, Y[dt], 0, 0, 0); }
            asm volatile("" ::: "memory"); }
    }
#pragma unroll
    for (int dt = 0; dt < 2; ++dt)
#pragma unroll
        for (int r = 0; r < 16; ++r) YS[(32 * rb + (r & 3) + 8 * (r >> 2) + 4 * hi) * 132 + 64 * ch + 32 * dt + r32] = Y[dt][r];
    __syncthreads();
    bf16* MIX = (bf16*)(F.ws + WS_MIX0);
    const float g0 = A.in[I_RNORMG][h * 128 + 2 * F.lane], g1 = A.in[I_RNORMG][h * 128 + 2 * F.lane + 1];
#pragma unroll 4
    for (int i = 0; i < 16; ++i) { const int row = 16 * F.wave + i; const f32x2v y = *(const LAS f32x2v*)(YS + row * 132 + 2 * F.lane);
        const float rs = rsqrtf(wave_sum(y.x * y.x + y.y * y.y) * (1.f / 128.f) + NORM_EPS);
        const unsigned gw2 = *(const unsigned*)(P + (size_t)row * E_IN + 1536 + h * 128 + 2 * F.lane);
        const float ga = __uint_as_float(gw2 << 16), gb = __uint_as_float(gw2 & 0xffff0000u);
        *(unsigned*)(MIX + (size_t)(r0 + row) * D + h * 128 + 2 * F.lane) = pk2(y.x * rs * g0 * siluf_(ga), y.y * rs * g1 * siluf_(gb)); }
    __syncthreads();
}

__device__ __forceinline__ void attn0_unit(const Frame& F, int unit) {
    const att::bf16* P = (const att::bf16*)(F.ws + WS_PRJ0); att::bf16* MIX = (att::bf16*)(F.ws + WS_MIX0);
    int b, qh, qrow0, seq;
    if (unit < 256) { b = unit >> 7; qh = (unit >> 5) & 3; qrow0 = b * TP + CT + (unit & 31) * 256; seq = TP; }
    else { const int u = unit - 256; b = u >> 2; qh = u & 3; qrow0 = b * TP; seq = CT; }
    const int kvh = qh >> 1;
    att::attn_dense_body<E_IN, E_IN, D>(P + (size_t)qrow0 * E_IN + 2048 + qh * 128, P + (size_t)b * TP * E_IN + 2560 + kvh * 128, P + (size_t)b * TP * E_IN + 2816 + kvh * 128,
                                        MIX + (size_t)qrow0 * D + 512 + qh * 128, seq, F.ldsg);
    __syncthreads();
}
__device__ __forceinline__ void attn1_unit(const Frame& F, int unit) {
    const int b = unit >> 8, qh = (unit >> 5) & 7, qb = unit & 31, kvh = qh >> 1;
    const att::bf16* KV = (const att::bf16*)(F.ws + WS_KV1) + (size_t)b * TP * 1024;
    const size_t qoff = (size_t)(b * SL + qb * 256) * 1024 + qh * 128;
    att::attn_dense_body<1024, 1024, 1024>((const att::bf16*)(F.ws + WS_QD) + qoff, KV + kvh * 128, KV + 512 + kvh * 128, (att::bf16*)(F.ws + WS_OB) + qoff, TP, F.ldsg);
    __syncthreads();
}

__device__ __forceinline__ void p13_prep1(const Frame& F, const Args& A) {
    const int l = F.lane; unsigned char* ws = F.ws;
    bf16* KV = (bf16*)(ws + WS_KV1); const bf16* RWQ = (const bf16*)(ws + WS_RWQ); bf16* QD = (bf16*)(ws + WS_QD); bf16* LIN = (bf16*)(ws + WS_LIN);
    bf16* SR = (bf16*)(ws + WS_SCAN + SA_R * SCAN_ARR); bf16* SV = (bf16*)(ws + WS_SCAN + SA_V * SCAN_ARR); bf16* SAN = (bf16*)(ws + WS_SCAN + SA_AN * SCAN_ARR); bf16* SK = (bf16*)(ws + WS_SCAN + SA_K * SCAN_ARR);
    const float* mu = A.in[I_RMU];
    float kkg[8];
#pragma unroll
    for (int e = 0; e < 8; ++e) kkg[e] = A.in[I_RKK][8 * l + e];
    for (int r = F.gw; r < MR; r += F.NGW) {
        const int b = r / TP, p = r % TP; const bool lat = p >= CT;
        const bf16* row = RWQ + (size_t)r * 2560;
        if (lat) {
            float cs[8], sn[8]; rope_cs<32>(l, p - CT, cs, sn); const bool first = (l & 4) == 0; float v[8];
            unpack8(*(const v4u*)(row + 8 * l), v); rope_apply<4>(v, cs, sn, first);
#pragma unroll
            for (int e = 0; e < 8; ++e) v[e] *= 1.41421356237f;
            { const int qh = l >> 3, m = qh & 1; bf16* q = QD + (size_t)(b * SL + p - CT) * 1024 + qh * 128;
              *(v4u*)(q + m * 64 + 8 * (l & 7)) = pack8(v); *(v4u*)(q + (1 - m) * 64 + 8 * (l & 7)) = (v4u){0u, 0u, 0u, 0u}; }
            bf16* kr = KV + (size_t)r * 1024 + 8 * l; unpack8(*(const v4u*)kr, v); rope_apply<4>(v, cs, sn, first); *(v4u*)kr = pack8(v);
        }
        const bool hasp = lat ? (p > CT) : (p > 0), hasn = lat ? (p < TP - 1) : (p < CT - 1);
        float pv[4][8];
#pragma unroll
        for (int j = 0; j < 4; ++j) {
            const int c = 8 * l + 512 * j; const bool on = (j < 3) || (l < 48);
            float x[8], xp[8], xn[8];
#pragma unroll
            for (int e = 0; e < 8; ++e) { x[e] = 0.f; xp[e] = 0.f; xn[e] = 0.f; }
            if (on) { unpack8(*(const v4u*)(row + 512 + c), x); if (hasp) unpack8(*(const v4u*)(row - 2560 + 512 + c), xp); if (hasn) unpack8(*(const v4u*)(row + 2560 + 512 + c), xn); }
#pragma unroll
            for (int e = 0; e < 8; ++e) { const float m_ = on ? mu[c + e] : 0.f; pv[j][e] = x[e] + m_ * (0.5f * (xp[e] + xn[e]) - x[e]); }
        }
        const size_t so = (size_t)r * 512 + 8 * l;
        *(v4u*)(SR + so) = pack8(pv[0]); *(v4u*)(SK + so) = pack8(pv[1]); *(v4u*)(SV + so) = pack8(pv[2]);
        { float kk[8]; float ss = 0.f;
#pragma unroll
          for (int e = 0; e < 8; ++e) { kk[e] = pv[1][e] * kkg[e]; ss += kk[e] * kk[e]; }
          ss += __shfl_xor(ss, 1); ss += __shfl_xor(ss, 2); ss += __shfl_xor(ss, 4);
          const float inv = -1.0f / fmaxf(sqrtf(ss), 1e-12f);
#pragma unroll
          for (int e = 0; e < 8; ++e) kk[e] *= inv;
          *(v4u*)(SAN + so) = pack8(kk); }
        if (l < 48) { float o[8];
#pragma unroll
            for (int e = 0; e < 8; ++e) o[e] = l < 16 ? tanhf(pv[3][e]) : (l < 32 ? pv[3][e] : sigmoidf_(pv[3][e]));
            *(v4u*)(LIN + (size_t)r * 384 + 8 * l) = pack8(o); }
    }
}

__device__ __forceinline__ float dpp_add16(float x) {
    x += __builtin_bit_cast(float, __builtin_amdgcn_update_dpp(0, __builtin_bit_cast(int, x), 0xB1, 0xF, 0xF, true));
    x += __builtin_bit_cast(float, __builtin_amdgcn_update_dpp(0, __builtin_bit_cast(int, x), 0x4E, 0xF, 0xF, true));
    x += __builtin_bit_cast(float, __builtin_amdgcn_update_dpp(0, __builtin_bit_cast(int, x), 0x141, 0xF, 0xF, true));
    x += __builtin_bit_cast(float, __builtin_amdgcn_update_dpp(0, __builtin_bit_cast(int, x), 0x140, 0xF, 0xF, true));
    return x;
}
constexpr int SC_TOK = 32, SC_STRIDE = 352;
__device__ __forceinline__ int scan_row(int b, int d, int i) { return b * TP + (d == 0 ? i : (i < CT ? CT - 1 - i : CT + (TP - 1 - i))); }
__device__ __forceinline__ void rwkv_scan(const Frame& F, const Args& A, int sid) {
    const int b = sid >> 5, h = (sid >> 2) & 7, d = (sid >> 1) & 1, half = sid & 1;
    unsigned char* ws = F.ws;
    const bf16* aL = (const bf16*)(ws + WS_SCAN + (size_t)(d ? SA_L1 : SA_L0) * SCAN_ARR); const bf16* aAN = (const bf16*)(ws + WS_SCAN + (size_t)SA_AN * SCAN_ARR);
    const bf16* aA = (const bf16*)(ws + WS_SCAN + (size_t)(d ? SA_A1 : SA_A0) * SCAN_ARR); const bf16* aK = (const bf16*)(ws + WS_SCAN + (size_t)SA_K * SCAN_ARR);
    const bf16* aR = (const bf16*)(ws + WS_SCAN + (size_t)SA_R * SCAN_ARR); const bf16* aV = (const bf16*)(ws + WS_SCAN + (size_t)SA_V * SCAN_ARR);
    bf16* YO = (bf16*)(ws + WS_YS) + (size_t)d * ML * 512;
    LAS float* buf = (LAS float*)F.lds;
    const int stok = F.tid < 256 ? (F.tid >> 3) : ((F.tid - 256) >> 2), sc8 = F.tid < 256 ? 8 * (F.tid & 7) : 8 * ((F.tid - 256) & 3);
    const bool sMain = F.tid < 256, sV = F.tid >= 256 && F.tid < 384;
    float ka8[8];
#pragma unroll
    for (int e = 0; e < 8; ++e) ka8[e] = A.in[I_RKA][h * 64 + (sc8 & 63) + e];
    v4u st[5];
#define SC_LOAD(ch) do { const size_t ro = (size_t)scan_row(b, d, (ch) * SC_TOK + stok) * 512 + h * 64; \
        if (sMain) { st[0] = *(const v4u*)(aL + ro + sc8); st[1] = *(const v4u*)(aAN + ro + sc8); st[2] = *(const v4u*)(aA + ro + sc8); st[3] = *(const v4u*)(aK + ro + sc8); st[4] = *(const v4u*)(aR + ro + sc8); } \
        else if (sV) { st[0] = *(const v4u*)(aV + ro + half * 32 + sc8); } } while (0)
#define SC_ST8(dst, f) do { *(LAS f32x4*)(dst) = (f32x4){f[0], f[1], f[2], f[3]}; *(LAS f32x4*)((dst) + 4) = (f32x4){f[4], f[5], f[6], f[7]}; } while (0)
#define SC_WRITE(bi) do { LAS float* tb_ = buf + (bi) * (SC_TOK * SC_STRIDE) + stok * SC_STRIDE; \
        if (sMain) { float fl[8], fn[8], fa[8], fk[8], fr[8], o[8]; unpack8(st[0], fl); unpack8(st[1], fn); unpack8(st[2], fa); unpack8(st[3], fk); unpack8(st[4], fr); \
            _Pragma("unroll") for (int e = 0; e < 8; ++e) o[e] = __expf(-fl[e]); SC_ST8(tb_ + sc8, o); SC_ST8(tb_ + 64 + sc8, fn); \
            _Pragma("unroll") for (int e = 0; e < 8; ++e) o[e] = -fn[e] * fa[e]; SC_ST8(tb_ + 128 + sc8, o); \
            _Pragma("unroll") for (int e = 0; e < 8; ++e) o[e] = fk[e] * (1.0f + (fa[e] - 1.0f) * ka8[e]); SC_ST8(tb_ + 192 + sc8, o); SC_ST8(tb_ + 256 + sc8, fr); } \
        else if (sV) { float fv[8]; unpack8(st[0], fv); SC_ST8(tb_ + 320 + sc8, fv); } } while (0)
    const int rowl = F.wave * 4 + (F.lane >> 4), ks = F.lane & 15;
    f32x4 s = {0.f, 0.f, 0.f, 0.f};
    SC_LOAD(0); SC_WRITE(0); __syncthreads();
    constexpr int NCHK = TP / SC_TOK;
    for (int ch = 0; ch < NCHK; ++ch) {
        if (ch + 1 < NCHK) SC_LOAD(ch + 1);
        const LAS float* tb = buf + (ch & 1) * (SC_TOK * SC_STRIDE);
#pragma unroll 4
        for (int t = 0; t < SC_TOK; ++t, tb += SC_STRIDE) {
            const f32x4 w = *(const LAS f32x4*)(tb + 4 * ks), a = *(const LAS f32x4*)(tb + 64 + 4 * ks), bb = *(const LAS f32x4*)(tb + 128 + 4 * ks),
                        kk = *(const LAS f32x4*)(tb + 192 + 4 * ks), rr = *(const LAS f32x4*)(tb + 256 + 4 * ks);
            const float vv = tb[320 + rowl];
            float sa = (s[0] * a[0] + s[1] * a[1]) + (s[2] * a[2] + s[3] * a[3]);
            const float yo = (s[0] * rr[0] + s[1] * rr[1]) + (s[2] * rr[2] + s[3] * rr[3]);
            sa = dpp_add16(sa);
            s = s * w + bb * sa + kk * vv;
            float y = d ? yo : (s[0] * rr[0] + s[1] * rr[1]) + (s[2] * rr[2] + s[3] * rr[3]);
            y = dpp_add16(y);
            const int i = ch * SC_TOK + t;
            if (ks == 0 && i >= CT) { const int lt = d == 0 ? i - CT : (TP - 1 - i); YO[(size_t)(b * SL + lt) * 512 + h * 64 + half * 32 + rowl] = (bf16)f2bf(y); }
        }
        if (ch + 1 < NCHK) SC_WRITE((ch + 1) & 1);
        __syncthreads();
    }
#undef SC_LOAD
#undef SC_WRITE
#undef SC_ST8
}
__device__ __forceinline__ void p15_finish1(const Frame& F, const Args& A) {
    const int l = F.lane; unsigned char* ws = F.ws;
    const bf16* OB = (const bf16*)(ws + WS_OB); const bf16* Y0 = (const bf16*)(ws + WS_YS); const bf16* Y1 = Y0 + (size_t)ML * 512; bf16* MIX = (bf16*)(ws + WS_H);
    const bf16* SR = (const bf16*)(ws + WS_SCAN + SA_R * SCAN_ARR); const bf16* SV = (const bf16*)(ws + WS_SCAN + SA_V * SCAN_ARR); const bf16* SK = (const bf16*)(ws + WS_SCAN + SA_K * SCAN_ARR); const bf16* SG = (const bf16*)(ws + WS_SCAN + SA_G * SCAN_ARR);
    const float* lv = A.in[I_DLAM];
    const float lam = __expf(wave_sum(lv[l] * lv[64 + l])) - __expf(wave_sum(lv[128 + l] * lv[192 + l])) + LAM_INIT;
    float sg[8], rk[8], lg[8], lb[8];
#pragma unroll
    for (int e = 0; e < 8; ++e) { sg[e] = A.in[I_DSUBG][8 * (l & 15) + e] * (1.0f - LAM_INIT); rk[e] = A.in[I_RRK][8 * l + e]; lg[e] = A.in[I_RLNG][8 * l + e]; lb[e] = A.in[I_RLNB][8 * l + e]; }
    for (int t = F.gw; t < ML; t += F.NGW) {
        const int b = t / SL, r = b * TP + CT + (t % SL);
#pragma unroll
        for (int j = 0; j < 2; ++j) {
            float o[8]; unpack8(*(const v4u*)(OB + (size_t)t * 1024 + 512 * j + 8 * l), o); float ss = 0.f;
#pragma unroll
            for (int e = 0; e < 8; ++e) { const float o2 = __shfl_xor(o[e], 16); o[e] = o[e] - lam * o2; ss += o[e] * o[e]; }
            ss += __shfl_xor(ss, 1); ss += __shfl_xor(ss, 2); ss += __shfl_xor(ss, 4); ss += __shfl_xor(ss, 8);
            const float rs = rsqrtf(ss * (1.f / 128.f) + NORM_EPS);
#pragma unroll
            for (int e = 0; e < 8; ++e) o[e] = o[e] * rs * sg[e];
            if ((l & 16) == 0) *(v4u*)(MIX + (size_t)r * D + ((l >> 5) + 2 * j) * 128 + 8 * (l & 15)) = pack8(o);
        }
        { float y0[8], y1[8], rr[8], kk[8], vv[8], gg[8];
          unpack8(*(const v4u*)(Y0 + (size_t)t * 512 + 8 * l), y0); unpack8(*(const v4u*)(Y1 + (size_t)t * 512 + 8 * l), y1);
          unpack8(*(const v4u*)(SR + (size_t)r * 512 + 8 * l), rr); unpack8(*(const v4u*)(SK + (size_t)r * 512 + 8 * l), kk); unpack8(*(const v4u*)(SV + (size_t)r * 512 + 8 * l), vv); unpack8(*(const v4u*)(SG + (size_t)r * 512 + 8 * l), gg);
          float sm = 0.f, bs = 0.f;
#pragma unroll
          for (int e = 0; e < 8; ++e) { y0[e] += y1[e]; sm += y0[e]; bs += rr[e] * kk[e] * rk[e]; }
          sm += __shfl_xor(sm, 1); sm += __shfl_xor(sm, 2); sm += __shfl_xor(sm, 4); bs += __shfl_xor(bs, 1); bs += __shfl_xor(bs, 2); bs += __shfl_xor(bs, 4);
          const float mean = sm * (1.f / 64.f); float vs = 0.f;
#pragma unroll
          for (int e = 0; e < 8; ++e) { y0[e] -= mean; vs += y0[e] * y0[e]; }
          vs += __shfl_xor(vs, 1); vs += __shfl_xor(vs, 2); vs += __shfl_xor(vs, 4);
          const float rs = rsqrtf(vs * (1.f / 64.f) + RWKV_LN_EPS);
#pragma unroll
          for (int e = 0; e < 8; ++e) y0[e] = ((y0[e] * rs * lg[e] + lb[e]) + bs * vv[e]) * gg[e];
          *(v4u*)(MIX + (size_t)r * D + 512 + 8 * l) = pack8(y0); }
    }
}
__device__ __forceinline__ void p17_route(const Frame& F, const Args& A) {
    const float* XR = (const float*)(F.ws + WS_XR); const bf16* Y = (const bf16*)(F.ws + WS_Y1); bf16* H2 = (bf16*)(F.ws + WS_H2); const float* ng = A.in[I_NORMG];
    const float* RT = A.in[I_MROUTER];
    for (int t = F.gw; t < ML; t += F.NGW) {
        const int b = t / SL, r = b * TP + CT + (t % SL); const float* mv = modv(F, 1, r); f32x4 h[4];
        resid_norm(F, Y + (size_t)r * D, XR + (size_t)r * D, A.out + (size_t)t * D, mv + 2 * 1024, ng + (4 + 1) * D, ng + (4 + 2) * D, mv + 3 * 1024, mv + 4 * 1024, H2 + (size_t)t * D, h);
        float lg[8];
#pragma unroll
        for (int e = 0; e < 8; ++e) lg[e] = 0.f;
#pragma unroll
        for (int j = 0; j < 4; ++j)
#pragma unroll
            for (int i = 0; i < 4; ++i) { const float* rr = RT + (size_t)(4 * F.lane + 256 * j + i) * 8; const f32x4 ra = *(const f32x4*)rr, rb = *(const f32x4*)(rr + 4); const float hv = h[j][i];
                lg[0] += hv * ra[0]; lg[1] += hv * ra[1]; lg[2] += hv * ra[2]; lg[3] += hv * ra[3]; lg[4] += hv * rb[0]; lg[5] += hv * rb[1]; lg[6] += hv * rb[2]; lg[7] += hv * rb[3]; }
#pragma unroll
        for (int e = 0; e < 8; ++e) lg[e] = wave_sum(lg[e]);
        int e0 = 0; float l0 = lg[0];
#pragma unroll
        for (int e = 1; e < 8; ++e) if (lg[e] > l0) { l0 = lg[e]; e0 = e; }
        int e1 = -1; float l1 = -3.0e38f;
#pragma unroll
        for (int e = 0; e < 8; ++e) if (e != e0 && lg[e] > l1) { l1 = lg[e]; e1 = e; }
        if (F.lane == 0) {
            const float w0 = 1.0f / (1.0f + __expf(l1 - l0));
            const int p0 = (int)__hip_atomic_fetch_add((unsigned*)(F.ctl + CW_CNT + 64 * e0), 1u, RLX_AGENT), p1 = (int)__hip_atomic_fetch_add((unsigned*)(F.ctl + CW_CNT + 64 * e1), 1u, RLX_AGENT);
            int* rec = (int*)(F.ws + WS_ROUTE) + (size_t)t * 8; rec[0] = e0; rec[1] = e1; rec[2] = p0; rec[3] = p1; ((float*)rec)[4] = w0; ((float*)rec)[5] = 1.0f - w0;
        }
    }
}
__device__ __forceinline__ int moe_offsets(const Frame& F, int (&off)[NE + 1]) {
    int o = 0;
#pragma unroll
    for (int e = 0; e < NE; ++e) { off[e] = o; const int c = (int)__hip_atomic_load((unsigned*)(F.ctl + CW_CNT + 64 * e), RLX_AGENT); o += ((c + 255) >> 8) << 8; }
    off[NE] = o; return o >> 8;
}
__device__ __forceinline__ void p18_gather(const Frame& F, const Args& A) {
    int off[NE + 1]; const int nT = moe_offsets(F, off);
    if (blockIdx.x == 0 && F.tid < 256) { int e = 0;
#pragma unroll
        for (int k = 1; k < NE; ++k) if (F.tid * 256 >= off[k]) e = k;
        ((int*)(F.ws + WS_TILEE))[F.tid] = (F.tid < nT) ? e : 0; }
    const bf16* H2 = (const bf16*)(F.ws + WS_H2); bf16* AG = (bf16*)(F.ws + WS_AG);
    for (int t = F.gw; t < ML; t += F.NGW) {
        const int* rec = (const int*)(F.ws + WS_ROUTE) + (size_t)t * 8; const int e0 = rec[0], e1 = rec[1], p0 = rec[2], p1 = rec[3];
        int o0 = 0, o1 = 0;
#pragma unroll
        for (int k = 0; k < NE; ++k) { if (k == e0) o0 = off[k]; if (k == e1) o1 = off[k]; }
        const v4u a = *(const v4u*)(H2 + (size_t)t * D + 8 * F.lane), c = *(const v4u*)(H2 + (size_t)t * D + 512 + 8 * F.lane);
        bf16* d0 = AG + (size_t)(o0 + p0) * D; bf16* d1 = AG + (size_t)(o1 + p1) * D;
        *(v4u*)(d0 + 8 * F.lane) = a; *(v4u*)(d0 + 512 + 8 * F.lane) = c; *(v4u*)(d1 + 8 * F.lane) = a; *(v4u*)(d1 + 512 + 8 * F.lane) = c;
    }
    moe_weights(F, A);
}
__device__ __forceinline__ void p21_final(const Frame& F, const Args& A) {
    int off[NE + 1]; (void)moe_offsets(F, off);
    const bf16* Y2 = (const bf16*)(F.ws + WS_AG); const float* ng = A.in[I_NORMG] + (4 + 3) * D;
    for (int t = F.gw; t < ML; t += F.NGW) {
        const int b = t / SL, r = b * TP + CT + (t % SL); const float* mv = modv(F, 1, r) + 5 * 1024;
        const int* rec = (const int*)(F.ws + WS_ROUTE) + (size_t)t * 8; const int e0 = rec[0], e1 = rec[1], p0 = rec[2], p1 = rec[3]; const float w0 = ((const float*)rec)[4], w1 = ((const float*)rec)[5];
        int o0 = 0, o1 = 0;
#pragma unroll
        for (int k = 0; k < NE; ++k) { if (k == e0) o0 = off[k]; if (k == e1) o1 = off[k]; }
        const bf16* ya = Y2 + (size_t)(o0 + p0) * D; const bf16* yb = Y2 + (size_t)(o1 + p1) * D;
        f32x4 m[4]; float ss = 0.f;
#pragma unroll
        for (int j = 0; j < 4; ++j) { const int c = 4 * F.lane + 256 * j; m[j] = ld_bf4(ya + c) * w0 + ld_bf4(yb + c) * w1; ss += sq4(m[j]); }
        const float rs = rsqrtf(wave_sum(ss) * (1.f / D) + NORM_EPS);
        float* o = A.out + (size_t)t * D;
#pragma unroll
        for (int j = 0; j < 4; ++j) { const int c = 4 * F.lane + 256 * j; *(f32x4*)(o + c) = *(const f32x4*)(o + c) + *(const f32x4*)(mv + c) * (m[j] * rs * *(const f32x4*)(ng + c)); }
    }
}

__global__ void __launch_bounds__(NWAVES * 64, 2) hyb_fwd(Args args) {
    extern __shared__ __attribute__((aligned(16))) unsigned char lds[];
    Frame F;
    F.lds = (LAS unsigned char*)lds; F.ldsg = (char*)lds;
    F.MISC = (volatile LAS unsigned*)(F.lds + MISC_OFF);
    F.tid = threadIdx.x; F.lane = F.tid & 63; F.wave = __builtin_amdgcn_readfirstlane(F.tid >> 6);
    F.G = gridDim.x; { const int bx = blockIdx.x; F.vcu = (F.G % 8 == 0) ? (bx % 8) * (F.G / 8) + bx / 8 : bx; }
    F.gw = F.vcu * NWAVES + F.wave; F.NGW = F.G * NWAVES;
    F.ws = args.ws; F.ctl = (gu32*)(args.ws + WS_CTL);
    unsigned char* ws = args.ws;
    for (int u = F.tid; u < (LDS_BYTES - LDSCTL_OFF) / 4; u += NWAVES * 64) ((LAS unsigned*)(F.lds + LDSCTL_OFF))[u] = 0u;
    __syncthreads();
    XcdBarrier bar; bar.bar = (unsigned*)(F.ctl + CW_BAR); bar.x = 0; bar.st = nullptr;
    if (N_LAUNCHES == 1) bar = xcd_barrier_post((unsigned*)(F.ctl + CW_BAR), F.MISC + 8);
#define GRID_BAR() do { if (N_LAUNCHES == 1) xcd_barrier(bar); } while (0)
    const int lo = args.ph_lo, hi = args.ph_hi;
#ifndef PHMASK
#define PHMASK 0x7fffffu
#endif
#define IN(k) ((((PHMASK) >> (k)) & 1u) && lo <= (k) && (k) < hi)
#define SEAM(k) do { if (IN(k) && IN((k) + 1)) GRID_BAR(); } while (0)
    const int cb = (int)blockIdx.x;
#define OPQ(x) ({ int v_ = (x); asm volatile("" : "+s"(v_)); v_; })

    if (IN(0)) { p0_prologue(F, args); } SEAM(0);
    if (IN(1)) { p1_first_h(F, args); } SEAM(1);
    if (IN(2)) {
        pg8::Gemm g{(const pg8::bf16_t*)(ws + WS_H), (const pg8::bf16_t*)(ws + WS_WIN0), MR, E_IN, OPQ(D)}; pg8::StaticOrder S; S.init(MR, E_IN, F.G, cb);
        pg8::EpiStore E{(pg8::bf16_t*)(ws + WS_PRJ0), E_IN, E_IN / 256};
        pg8::gemm_phase<pg8::EpiStore, pg8::StaticOrder, true, true>(F.lds + RING_OFF, g, S, E);
    } SEAM(2);
    if (IN(3)) { p3_post0(F, args); } SEAM(3);
    if (IN(4)) { for (int u = F.vcu; u < NB * 4 * NCH; u += F.G) ret_u_unit(F, args, u); } SEAM(4);
    if (IN(5)) { ret_prefix(F, args); } SEAM(5);
    if (IN(6)) {
#ifndef NO_ATT0
        for (int i = cb; i < 264; i += F.G) attn0_unit(F, i);
#endif
#ifndef NO_RET0
        for (int i = cb + ((264 + F.G - 1 - cb) / F.G) * F.G; i < 264 + NB * 4 * NCH; i += F.G) ret_out_unit(F, args, i - 264);
#endif
    } SEAM(6);
    if (IN(7)) {
        pg8::Gemm g{(const pg8::bf16_t*)(ws + WS_MIX0), (const pg8::bf16_t*)(ws + WS_WOUT0), MR, D, OPQ(D)}; pg8::StaticOrder S; S.init(MR, D, F.G, cb);
        pg8::EpiStore E{(pg8::bf16_t*)(ws + WS_Y0), D, D / 256};
        pg8::gemm_phase<pg8::EpiStore, pg8::StaticOrder, true, true>(F.lds + RING_OFF, g, S, E);
    } SEAM(7);
    if (IN(8)) { p_resid_all(F, args, (const bf16*)(ws + WS_Y0), 0, 0); } SEAM(8);
    if (IN(9)) {
        pg8::Gemm g{(const pg8::bf16_t*)(ws + WS_H), (const pg8::bf16_t*)(ws + WS_WGU0), MR, 2 * FFH, OPQ(D)}; pg8::StaticOrder S; S.init(MR, 2 * FFH, F.G, cb);
        pg8::EpiSwiglu E{(pg8::bf16_t*)(ws + WS_ACT0), FFH, 2 * FFH / 256};
        pg8::gemm_phase<pg8::EpiSwiglu, pg8::StaticOrder, true, true>(F.lds + RING_OFF, g, S, E);
    } SEAM(9);
    if (IN(10)) {
        pg8::Gemm g{(const pg8::bf16_t*)(ws + WS_ACT0), (const pg8::bf16_t*)(ws + WS_WD0), MR, D, OPQ(FFH)}; pg8::StaticOrder S; S.init(MR, D, F.G, cb);
        pg8::EpiStore E{(pg8::bf16_t*)(ws + WS_Y0), D, D / 256};
        pg8::gemm_phase<pg8::EpiStore, pg8::StaticOrder, true, true>(F.lds + RING_OFF, g, S, E);
    } SEAM(10);
    if (IN(11)) { p_resid_all(F, args, (const bf16*)(ws + WS_Y0), 0, 1); } SEAM(11);
    if (IN(12)) {
        pg8::Gemm g{(const pg8::bf16_t*)(ws + WS_H), (const pg8::bf16_t*)(ws + WS_WIN1), MR, O_INP, OPQ(D)}; pg8::StaticOrder S; S.init(MR, O_INP, F.G, cb);
        pg8::EpiSplit1 E{(pg8::bf16_t*)(ws + WS_KV1), (pg8::bf16_t*)(ws + WS_RWQ)};
        pg8::gemm_phase<pg8::EpiSplit1, pg8::StaticOrder, true, true>(F.lds + RING_OFF, g, S, E);
    } SEAM(12);
    if (IN(13)) { p13_prep1(F, args); } SEAM(13);
    if (IN(14)) {
        pg8::Gemm g{(const pg8::bf16_t*)(ws + WS_LIN), (const pg8::bf16_t*)(ws + WS_WL), MR, 2560, OPQ(384)}; pg8::StaticOrder S; S.init(MR, 2560, F.G, cb);
        pg8::EpiLora E{(pg8::bf16_t*)(ws + WS_SCAN + SA_L0 * SCAN_ARR), (pg8::bf16_t*)(ws + WS_SCAN + SA_L1 * SCAN_ARR), (pg8::bf16_t*)(ws + WS_SCAN + SA_A0 * SCAN_ARR), (pg8::bf16_t*)(ws + WS_SCAN + SA_A1 * SCAN_ARR),
                       (pg8::bf16_t*)(ws + WS_SCAN + SA_G * SCAN_ARR), args.in[I_RW0], args.in[I_RA0]};
        pg8::gemm_phase<pg8::EpiLora, pg8::StaticOrder, true, true>(F.lds + RING_OFF, g, S, E);
    } SEAM(14);
    if (IN(15)) {
        if (cb < 64) { rwkv_scan(F, args, cb); __syncthreads(); }
        for (;;) {
            if (F.tid == 0) F.MISC[0] = __hip_atomic_fetch_add((unsigned*)(F.ctl + CW_QUEUE), 1u, RLX_AGENT);
            __syncthreads(); const unsigned u = F.MISC[0]; __syncthreads();
            if (u >= 512u) break;
            attn1_unit(F, (int)u);
        }
    } SEAM(15);
    if (IN(16)) { p15_finish1(F, args); } SEAM(16);
    if (IN(17)) {
        pg8::Gemm g{(const pg8::bf16_t*)(ws + WS_H), (const pg8::bf16_t*)(ws + WS_WOUT1), MR, D, OPQ(D)}; pg8::StaticOrder S; S.init(MR, D, F.G, cb);
        pg8::EpiStore E{(pg8::bf16_t*)(ws + WS_Y1), D, D / 256};
        pg8::gemm_phase<pg8::EpiStore, pg8::StaticOrder, true, true>(F.lds + RING_OFF, g, S, E);
    } SEAM(17);
    if (IN(18)) { p17_route(F, args); } SEAM(18);
    if (IN(19)) { p18_gather(F, args); } SEAM(19);
    if (IN(20)) {
        int off[NE + 1]; const int nT = moe_offsets(F, off);
        pg8::Gemm g{(const pg8::bf16_t*)(ws + WS_AG), (const pg8::bf16_t*)(ws + WS_WMOE_GU), nT * 256, 2 * EH, OPQ(D)};
        pg8::MoeOrder S{nT, 2 * EH / 256, F.G, cb, (const int*)(ws + WS_TILEE)};
        pg8::EpiSwiglu E{(pg8::bf16_t*)(ws + WS_ACT1), EH, 2 * EH / 256};
        pg8::gemm_phase<pg8::EpiSwiglu, pg8::MoeOrder, true, true>(F.lds + RING_OFF, g, S, E);
    } SEAM(20);
    if (IN(21)) {
        int off[NE + 1]; const int nT = moe_offsets(F, off);
        pg8::Gemm g{(const pg8::bf16_t*)(ws + WS_ACT1), (const pg8::bf16_t*)(ws + WS_WMOE_D), nT * 256, D, OPQ(EH)};
        pg8::MoeOrder S{nT, D / 256, F.G, cb, (const int*)(ws + WS_TILEE)};
        pg8::EpiStore E{(pg8::bf16_t*)(ws + WS_AG), D, D / 256};
        pg8::gemm_phase<pg8::EpiStore, pg8::MoeOrder, true, true>(F.lds + RING_OFF, g, S, E);
    } SEAM(21);
    if (IN(22)) { p21_final(F, args); }
#undef IN
#undef SEAM
#undef GRID_BAR
}

extern "C" void kernel_launch(void* const* d_in, const int* in_sizes, int n_in, void* d_out, int out_size, void* d_ws, size_t ws_size, hipStream_t stream) {
    static int grid = 0;
    if (grid == 0) {
        if (n_in != 35 || in_sizes[0] != ML * D || out_size != ML * D || ws_size < WS_END) {
            fprintf(stderr, "kernel_launch: shape mismatch: n_in %d in0 %d out %d ws %zu (need >= %zu); nothing launched\n", n_in, n_in > 0 ? in_sizes[0] : -1, out_size, ws_size, (size_t)WS_END); grid = -1; return; }
        int dev = 0, cus = 0, per_cu = 0;
        if (hipGetDevice(&dev) != hipSuccess || hipDeviceGetAttribute(&cus, hipDeviceAttributeMultiprocessorCount, dev) != hipSuccess) { grid = -1; return; }
        if (hipFuncSetAttribute((const void*)hyb_fwd, hipFuncAttributeMaxDynamicSharedMemorySize, LDS_BYTES) != hipSuccess) { fprintf(stderr, "kernel_launch: hipFuncSetAttribute failed\n"); grid = -1; return; }
        if (hipOccupancyMaxActiveBlocksPerMultiprocessor(&per_cu, (const void*)hyb_fwd, NWAVES * 64, LDS_BYTES) != hipSuccess || per_cu < 1)
            fprintf(stderr, "kernel_launch: note: occupancy query reports %d workgroups per CU\n", per_cu);
        (void)hipGetLastError();
        grid = cus;
    }
    if (grid < 0) return;
    if (hipMemsetAsync((char*)d_ws + WS_CTL, 0, CTL_ZERO_BYTES, stream) != hipSuccess) return;
    Args a{};
    for (int i = 0; i < 35; ++i) a.in[i] = (const float*)d_in[i];
    a.out = (float*)d_out; a.ws = (unsigned char*)d_ws;
    if (N_LAUNCHES == 1) { a.ph_lo = 0; a.ph_hi = NPH; hipLaunchKernelGGL(hyb_fwd, dim3(grid), dim3(NWAVES * 64), LDS_BYTES, stream, a); }
    else { for (int li = 0; li < NPH; ++li) { a.ph_lo = li; a.ph_hi = li + 1; hipLaunchKernelGGL(hyb_fwd, dim3(grid), dim3(NWAVES * 64), LDS_BYTES, stream, a); } }
    const hipError_t le = hipPeekAtLastError();
    if (le != hipSuccess) fprintf(stderr, "kernel_launch: launch failed: %s\n", hipGetErrorName(le));
}
```

```cpp
#include <hip/hip_runtime.h>
#include <cstdio>
#include <cstdint>
#ifndef MK_N_LAUNCHES
#define MK_N_LAUNCHES 1
#endif
namespace pg8 {
#define PG8_LAS __attribute__((address_space(3)))
typedef unsigned short bf16_t;
typedef short bf16x8 __attribute__((ext_vector_type(8)));
typedef float f32x4 __attribute__((ext_vector_type(4)));
typedef unsigned u32x4 __attribute__((ext_vector_type(4)));
constexpr int BM = 256, BK = 64, HALF = 128, HTB = HALF * BK * 2  , STAGE_BYTES = 8 * HTB, NXCD = 8, WGM = 8;

__host__ __device__ __forceinline__ int lds_byte(int r, int c) { const int st = (r >> 4) * 2 + (c >> 5), rr = r & 15, cc = c & 31, ob = rr * 64 + cc * 2; return st * 1024 + (ob ^ (((ob >> 9) & 1) << 5)); }
__host__ __device__ __forceinline__ void stage_rc(int b, int& R, int& C) { const int st = b / 1024, sb = b % 1024, swz = sb ^ (((sb >> 9) & 1) << 5); R = (st >> 1) * 16 + swz / 64; C = (st & 1) * 32 + (swz % 64) / 2; }
__host__ __device__ __forceinline__ int perm32(int rho) { const int n = rho >> 4, i = rho & 15; return 8 * (i >> 2) + 4 * n + (i & 3); }

struct Unit { int pm, pn; int ko = 0, kt = 0; };
struct Gemm { const bf16_t* A; const bf16_t* Bt; int M, N, K; int ld = 0; };

struct StaticOrder {
    int nM, nN, nwg, G, c;
    __host__ __device__ void init(int M, int N, int G_, int c_) { nM = M / BM; nN = N / BM; nwg = nM * nN; G = G_; c = c_; }
    __host__ __device__ bool next(int i, Unit& u) const {
        const long L = (long)i * G + c; if (L >= nwg) return false;
        int wgid = (int)L; { const int q = nwg / NXCD, r = nwg % NXCD, xcd = wgid % NXCD, off = wgid / NXCD; wgid = (xcd < r ? xcd * (q + 1) : r * (q + 1) + (xcd - r) * q) + off; }
        const int nig = WGM * nN, gid = wgid / nig, fm = gid * WGM, gsz = (nM - fm) < WGM ? (nM - fm) : WGM;
        u.pm = fm + ((wgid % nig) % gsz); u.pn = (wgid % nig) / gsz; return true;
    }
    __device__ __forceinline__ void a_ready(const Unit&) const {}
    __device__ __forceinline__ void done(const Unit&) const {}
};

__device__ __forceinline__ unsigned cvt_pk_bf16(float lo, float hi) { unsigned r; asm volatile("v_cvt_pk_bf16_f32 %0, %1, %2" : "=v"(r) : "v"(lo), "v"(hi)); return r; }
typedef float f32x2 __attribute__((ext_vector_type(2)));
__device__ __forceinline__ float bf2f(unsigned short h) { return __uint_as_float(((unsigned)h) << 16); }
__device__ __forceinline__ float silu_f(float x) { return x * __builtin_amdgcn_rcpf(1.0f + __builtin_amdgcn_exp2f(-1.44269504089f * x)); }
__device__ __forceinline__ float sigmoid_f(float x) { return __builtin_amdgcn_rcpf(1.0f + __builtin_amdgcn_exp2f(-1.44269504089f * x)); }
__device__ __forceinline__ u32x4 pack8(const f32x4 a, const f32x4 b) { u32x4 w; w.x = cvt_pk_bf16(a[0], a[1]); w.y = cvt_pk_bf16(a[2], a[3]); w.z = cvt_pk_bf16(b[0], b[1]); w.w = cvt_pk_bf16(b[2], b[3]); return w; }
__device__ __forceinline__ void unpack8(const u32x4 w, float (&f)[8]) {
    f[0] = __uint_as_float(w.x << 16); f[1] = __uint_as_float(w.x & 0xffff0000u); f[2] = __uint_as_float(w.y << 16); f[3] = __uint_as_float(w.y & 0xffff0000u);
    f[4] = __uint_as_float(w.z << 16); f[5] = __uint_as_float(w.z & 0xffff0000u); f[6] = __uint_as_float(w.w << 16); f[7] = __uint_as_float(w.w & 0xffff0000u); }

struct EpiStore {
    static constexpr bool PERM = true, AFTER_DRAIN = false;
    bf16_t* O; int ldc; int ncolt;
    __device__ __forceinline__ void operator()(const f32x4 (&acc)[2][2][4][2], const Unit& u, int wr, int wc, int fr, int fq) const {
        const int row0 = u.pm * BM + wr * 64 + fr, col0 = (u.pn % ncolt) * BM + wc * 32 + 8 * fq;
#pragma unroll
        for (int ai = 0; ai < 2; ++ai)
#pragma unroll
            for (int m = 0; m < 4; ++m) { bf16_t* rowp = O + (size_t)(row0 + ai * HALF + m * 16) * ldc + col0;
#pragma unroll
                for (int bj = 0; bj < 2; ++bj) *(u32x4*)(rowp + bj * HALF) = pack8(acc[ai][bj][m][0], acc[ai][bj][m][1]); }
    }
};
struct EpiSwiglu {
    static constexpr bool PERM = true, AFTER_DRAIN = false;
    bf16_t* O; int ldc; int ncolt;
    __device__ __forceinline__ void operator()(const f32x4 (&acc)[2][2][4][2], const Unit& u, int wr, int wc, int fr, int fq) const {
        const int row0 = u.pm * BM + wr * 64 + fr, col0 = (u.pn % ncolt) * HALF + wc * 32 + 8 * fq;
#pragma unroll
        for (int ai = 0; ai < 2; ++ai)
#pragma unroll
            for (int m = 0; m < 4; ++m) { bf16_t* rowp = O + (size_t)(row0 + ai * HALF + m * 16) * ldc + col0;
                f32x4 o0, o1;
#pragma unroll
                for (int j = 0; j < 4; ++j) { o0[j] = silu_f(acc[ai][0][m][0][j]) * acc[ai][1][m][0][j]; o1[j] = silu_f(acc[ai][0][m][1][j]) * acc[ai][1][m][1][j]; }
                *(u32x4*)rowp = pack8(o0, o1); }
    }
};
struct EpiSplit1 {
    static constexpr bool PERM = true, AFTER_DRAIN = false;
    bf16_t* KV; bf16_t* RWQ;
    __device__ __forceinline__ void operator()(const f32x4 (&acc)[2][2][4][2], const Unit& u, int wr, int wc, int fr, int fq) const {
        const int row0 = u.pm * BM + wr * 64 + fr; bf16_t* base; int ldc, colt;
        if (u.pn >= 2 && u.pn < 6) { base = KV; ldc = 1024; colt = (u.pn - 2) * BM; }
        else { base = RWQ; ldc = 2560; colt = (u.pn < 2 ? u.pn : u.pn - 4) * BM; }
        const int col0 = colt + wc * 32 + 8 * fq;
#pragma unroll
        for (int ai = 0; ai < 2; ++ai)
#pragma unroll
            for (int m = 0; m < 4; ++m) { bf16_t* rowp = base + (size_t)(row0 + ai * HALF + m * 16) * ldc + col0;
#pragma unroll
                for (int bj = 0; bj < 2; ++bj) *(u32x4*)(rowp + bj * HALF) = pack8(acc[ai][bj][m][0], acc[ai][bj][m][1]); }
    }
};
struct EpiLora {
    static constexpr bool PERM = true, AFTER_DRAIN = false;
    bf16_t* L0; bf16_t* L1; bf16_t* A0; bf16_t* A1; bf16_t* G;
    const float* w0; const float* a0;
    __device__ __forceinline__ void operator()(const f32x4 (&acc)[2][2][4][2], const Unit& u, int wr, int wc, int fr, int fq) const {
        const int row0 = u.pm * BM + wr * 64 + fr; const int blk = u.pn >> 1, col0 = (u.pn & 1) * BM + wc * 32 + 8 * fq;
        bf16_t* O = blk == 0 ? L0 : blk == 1 ? L1 : blk == 2 ? A0 : blk == 3 ? A1 : G;
        if (blk < 4) {
            const float* bsrc = (blk < 2 ? w0 + blk * 512 : a0 + (blk - 2) * 512) + col0; const float sc = blk < 2 ? 0.60653065971f * 1.44269504089f : 1.0f;
#pragma unroll
            for (int bj = 0; bj < 2; ++bj) { const f32x4 b0 = *(const f32x4*)(bsrc + bj * HALF), b1 = *(const f32x4*)(bsrc + bj * HALF + 4);
#pragma unroll
                for (int ai = 0; ai < 2; ++ai)
#pragma unroll
                    for (int m = 0; m < 4; ++m) { f32x4 o0, o1;
#pragma unroll
                        for (int j = 0; j < 4; ++j) { o0[j] = sigmoid_f(acc[ai][bj][m][0][j] + b0[j]) * sc; o1[j] = sigmoid_f(acc[ai][bj][m][1][j] + b1[j]) * sc; }
                        *(u32x4*)(O + (size_t)(row0 + ai * HALF + m * 16) * 512 + col0 + bj * HALF) = pack8(o0, o1); } }
        } else {
#pragma unroll
            for (int ai = 0; ai < 2; ++ai)
#pragma unroll
                for (int m = 0; m < 4; ++m) { bf16_t* rowp = O + (size_t)(row0 + ai * HALF + m * 16) * 512 + col0;
#pragma unroll
                    for (int bj = 0; bj < 2; ++bj) *(u32x4*)(rowp + bj * HALF) = pack8(acc[ai][bj][m][0], acc[ai][bj][m][1]); }
        }
    }
};
struct LatOrder : StaticOrder {
    __device__ __forceinline__ bool next(int i, Unit& u) const { if (!StaticOrder::next(i, u)) return false; u.pm = u.pm < 32 ? u.pm + 1 : u.pm + 2; return true; }
};
struct EpiAtomic {
    static constexpr bool PERM = true, AFTER_DRAIN = false;
    float* O; int ldc; int ncolt; int rowtile0;
    __device__ __forceinline__ void operator()(const f32x4 (&acc)[2][2][4][2], const Unit& u, int wr, int wc, int fr, int fq) const {
        const int row0 = (u.pm - rowtile0) * BM + wr * 64 + fr, col0 = (u.pn % ncolt) * BM + wc * 32 + 8 * fq;
#pragma unroll
        for (int ai = 0; ai < 2; ++ai)
#pragma unroll
            for (int m = 0; m < 4; ++m) { float* rowp = O + (size_t)(row0 + ai * HALF + m * 16) * ldc + col0;
#pragma unroll
                for (int bj = 0; bj < 2; ++bj)
#pragma unroll
                    for (int n = 0; n < 2; ++n)
#pragma unroll
                        for (int j = 0; j < 4; ++j) __hip_atomic_fetch_add(rowp + bj * HALF + 4 * n + j, acc[ai][bj][m][n][j], __ATOMIC_RELAXED, __HIP_MEMORY_SCOPE_AGENT); }
    }
};
struct CtxSplitOrder {
    int nks, kslice, G, c;
    __device__ __forceinline__ bool next(int i, Unit& u) const {
        const int L = i * G + c; if (L >= 8 * nks) return false;
        const int rt = L / (4 * nks), j = (L / nks) & 3, ks = L % nks; u.pm = rt ? 33 : 0; u.pn = j; u.ko = ks * kslice; return true; }
    __device__ __forceinline__ void a_ready(const Unit&) const {}
    __device__ __forceinline__ void done(const Unit&) const {}
};
struct EpiAtomicCtx {
    static constexpr bool PERM = true, AFTER_DRAIN = false;
    float* O; int kslice;
    __device__ __forceinline__ void operator()(const f32x4 (&acc)[2][2][4][2], const Unit& u, int wr, int wc, int fr, int fq) const {
        const int row0 = (u.pm ? BM : 0) + wr * 64 + fr, col0 = u.pn * BM + wc * 32 + 8 * fq; float* Os = O + (size_t)(u.ko / kslice) * 512 * 1024;
#pragma unroll
        for (int ai = 0; ai < 2; ++ai)
#pragma unroll
            for (int m = 0; m < 4; ++m) { float* rowp = Os + (size_t)(row0 + ai * HALF + m * 16) * 1024 + col0;
#pragma unroll
                for (int bj = 0; bj < 2; ++bj)
#pragma unroll
                    for (int n = 0; n < 2; ++n) *(f32x4*)(rowp + bj * HALF + 4 * n) = acc[ai][bj][m][n]; }
    }
};
struct LatCtxOrder {
    StaticOrder S; int nks, first;
    __device__ __forceinline__ bool next(int i, Unit& u) const {
        const int nmain = S.nwg, mine = (nmain - S.c + S.G - 1) / S.G;
        if (i < (S.c < nmain ? mine : 0)) { const bool ok = S.next(i, u); u.pm = u.pm < 32 ? u.pm + 1 : u.pm + 2; u.ko = 0; u.kt = 0; return ok; }
        const int c2 = (S.c - first + S.G) % S.G, L = (i - (S.c < nmain ? mine : 0)) * S.G + c2; if (L >= 2 * S.nN * nks) return false;
        const int rt = L / (S.nN * nks), j = (L / nks) % S.nN, ks = L % nks; u.pm = rt ? 33 : 0; u.pn = j; u.ko = ks * 256; u.kt = 4; return true; }
    __device__ __forceinline__ void a_ready(const Unit&) const {}
    __device__ __forceinline__ void done(const Unit&) const {}
};
struct EpiStoreCtx {
    static constexpr bool PERM = true, AFTER_DRAIN = false;
    bf16_t* O; float* P; int ldc;
    __device__ __forceinline__ void operator()(const f32x4 (&acc)[2][2][4][2], const Unit& u, int wr, int wc, int fr, int fq) const {
        const int col0 = u.pn * BM + wc * 32 + 8 * fq;
        if (u.kt == 0) { const int row0 = u.pm * BM + wr * 64 + fr;
#pragma unroll
            for (int ai = 0; ai < 2; ++ai)
#pragma unroll
                for (int m = 0; m < 4; ++m) { bf16_t* rowp = O + (size_t)(row0 + ai * HALF + m * 16) * ldc + col0;
#pragma unroll
                    for (int bj = 0; bj < 2; ++bj) *(u32x4*)(rowp + bj * HALF) = pack8(acc[ai][bj][m][0], acc[ai][bj][m][1]); }
        } else { const int row0 = (u.pm ? BM : 0) + wr * 64 + fr; float* Os = P + (size_t)(u.ko >> 8) * 512 * ldc;
#pragma unroll
            for (int ai = 0; ai < 2; ++ai)
#pragma unroll
                for (int m = 0; m < 4; ++m) { float* rowp = Os + (size_t)(row0 + ai * HALF + m * 16) * ldc + col0;
#pragma unroll
                    for (int bj = 0; bj < 2; ++bj)
#pragma unroll
                        for (int n = 0; n < 2; ++n) *(f32x4*)(rowp + bj * HALF + 4 * n) = acc[ai][bj][m][n]; }
        }
    }
};
struct LoraOrder : StaticOrder {
    __device__ __forceinline__ bool next(int i, Unit& u) const { if (!StaticOrder::next(i, u)) return false; u.ko = u.pn >= 8 ? 128 : 0; u.kt = 4; return true; }
};
struct MoeOrder {
    int nT, nN, G, c; const int* tile_e;
    __device__ __forceinline__ bool next(int i, Unit& u) const {
        if ((G & 7) || (nN & 3) || (G >> 3) < 32) { const long L = (long)i * G + c; if (L >= (long)nT * nN) return false; const int t = (int)(L / nN), j = (int)(L % nN); u.pm = t; u.pn = tile_e[t] * nN + j; return true; }
        const int ncg = nN >> 2, nrb = (nT + 7) >> 3, wpx = G >> 3, x = c & 7, w = c >> 3;
        const int per = wpx >> 5;
        const long su = ((long)i * per + (w >> 5)) * 8 + x; if (per == 0 || su >= (long)nrb * ncg) return false;
        const int rb = (int)(su / ncg), cg = (int)(su % ncg), t = 8 * rb + (w & 7), j = 4 * cg + ((w >> 3) & 3);
        if (t >= nT) { u.pm = nT - 1; u.pn = tile_e[nT - 1] * nN + j; return true; }
        u.pm = t; u.pn = tile_e[t] * nN + j; return true; }
    __device__ __forceinline__ void a_ready(const Unit&) const {}
    __device__ __forceinline__ void done(const Unit&) const {}
};
struct EpiPartial {
    static constexpr bool PERM = true, AFTER_DRAIN = false;
    float* O; int rowtile0; int kq; int rows;
    __device__ __forceinline__ void operator()(const f32x4 (&acc)[2][2][4][2], const Unit& u, int wr, int wc, int fr, int fq) const {
        const int row0 = (u.pm - rowtile0) * BM + wr * 64 + fr, col0 = (u.pn & 3) * BM + wc * 32 + 8 * fq; float* Os = O + (size_t)(u.ko / kq) * rows * 1024;
#pragma unroll
        for (int ai = 0; ai < 2; ++ai)
#pragma unroll
            for (int m = 0; m < 4; ++m) { float* rowp = Os + (size_t)(row0 + ai * HALF + m * 16) * 1024 + col0;
#pragma unroll
                for (int bj = 0; bj < 2; ++bj)
#pragma unroll
                    for (int n = 0; n < 2; ++n) *(f32x4*)(rowp + bj * HALF + 4 * n) = acc[ai][bj][m][n]; }
    }
};
struct MoeDownOrder {
    MoeOrder M; int nT, kq;
    __device__ __forceinline__ bool next(int i, Unit& u) const {
        const int nrb = (M.nT + 7) >> 3, x = M.c & 7, mine = x < nrb ? (nrb - x + 7) >> 3 : 0;
        if (i < mine) { const bool ok = M.next(i, u); u.ko = 0; u.kt = 0; return ok; }
        const long L = (long)(i - mine) * M.G + M.c; if (L >= (long)(nT - M.nT) * 16) return false;
        const int t = M.nT + (int)(L >> 4), j = (int)(L >> 2) & 3; u.pm = t; u.pn = M.tile_e[t] * 4 + j; u.ko = (int)(L & 3) * kq; u.kt = kq / BK; return true; }
    __device__ __forceinline__ void a_ready(const Unit&) const {}
    __device__ __forceinline__ void done(const Unit&) const {}
};
struct EpiDown {
    static constexpr bool PERM = true, AFTER_DRAIN = false;
    bf16_t* O; float* P; int rowtile0; int kq; int rows;
    __device__ __forceinline__ void operator()(const f32x4 (&acc)[2][2][4][2], const Unit& u, int wr, int wc, int fr, int fq) const {
        const int col0 = (u.pn & 3) * BM + wc * 32 + 8 * fq;
        if (u.kt == 0) { const int row0 = u.pm * BM + wr * 64 + fr;
#pragma unroll
            for (int ai = 0; ai < 2; ++ai)
#pragma unroll
                for (int m = 0; m < 4; ++m) { bf16_t* rowp = O + (size_t)(row0 + ai * HALF + m * 16) * 1024 + col0;
#pragma unroll
                    for (int bj = 0; bj < 2; ++bj) *(u32x4*)(rowp + bj * HALF) = pack8(acc[ai][bj][m][0], acc[ai][bj][m][1]); }
        } else { const int row0 = (u.pm - rowtile0) * BM + wr * 64 + fr; float* Os = P + (size_t)(u.ko / kq) * rows * 1024;
#pragma unroll
            for (int ai = 0; ai < 2; ++ai)
#pragma unroll
                for (int m = 0; m < 4; ++m) { float* rowp = Os + (size_t)(row0 + ai * HALF + m * 16) * 1024 + col0;
#pragma unroll
                    for (int bj = 0; bj < 2; ++bj)
#pragma unroll
                        for (int n = 0; n < 2; ++n) *(f32x4*)(rowp + bj * HALF + 4 * n) = acc[ai][bj][m][n]; }
        }
    }
};
struct MoeTailOrder {
    int t0, nT, G, c, kq; const int* tile_e;
    __device__ __forceinline__ bool next(int i, Unit& u) const {
        const long L = (long)i * G + c; if (L >= (long)(nT - t0) * 16) return false;
        const int t = t0 + (int)(L >> 4), j = (int)(L >> 2) & 3; u.pm = t; u.pn = tile_e[t] * 4 + j; u.ko = (int)(L & 3) * kq; return true; }
    __device__ __forceinline__ void a_ready(const Unit&) const {}
    __device__ __forceinline__ void done(const Unit&) const {}
};

template <class Epi, class Sched, bool ALIGN_EPI = false, bool SP2 = false>
__device__ __forceinline__ void gemm_phase(PG8_LAS unsigned char* lds, const Gemm g, const Sched& S, const Epi& E) {
    const int tid = threadIdx.x, wid = __builtin_amdgcn_readfirstlane(tid >> 6), lane = tid & 63, wr = wid >> 2, wc = wid & 3, fr = lane & 15, fq = lane >> 4;
    const int nt = g.K / BK, K = g.ld ? g.ld : g.K;
    unsigned voffA[2], voffB[2];
#pragma unroll
    for (int i = 0; i < 2; ++i) { int R, C; stage_rc(tid * 16 + i * 8192, R, C); const int Rb = Epi::PERM ? ((R & ~31) + perm32(R & 31)) : R;
        voffA[i] = (unsigned)(R * K + C) * 2u; voffB[i] = (unsigned)(Rb * K + C) * 2u; }
    const size_t kstep = (size_t)(BK * 2);
    const size_t hstep = (size_t)HALF * K * 2;
    const size_t tstep = 2 * hstep;
    const unsigned ldsw = (unsigned)wid * 1024u;
    const int aoff = lds_byte(wr * 64 + fr, fq * 8), boff = lds_byte(wc * 32 + fr, fq * 8);
#define PG8_SA(b, h) (((b) * 2 + (h)) * HTB)
#define PG8_SB(b, h) ((4 + (b) * 2 + (h)) * HTB)
#define PG8_STAGE(bufoff, gbase, voff) do { _Pragma("unroll") for (int _i = 0; _i < 2; ++_i) \
        __builtin_amdgcn_global_load_lds((const unsigned*)((const char*)(gbase) + (voff)[_i]), (PG8_LAS unsigned*)(lds + (bufoff) + ldsw + _i * 8192), 16, 0, 0); } while (0)
#define PG8_LDA(dst, b, h) do { _Pragma("unroll") for (int m = 0; m < 4; ++m) _Pragma("unroll") for (int k = 0; k < 2; ++k) dst[m][k] = *(const PG8_LAS bf16x8*)(lds + PG8_SA(b, h) + aoff + m * 2048 + k * 1024); } while (0)
#define PG8_LDB(dst, b, h) do { _Pragma("unroll") for (int n = 0; n < 2; ++n) _Pragma("unroll") for (int k = 0; k < 2; ++k) dst[n][k] = *(const PG8_LAS bf16x8*)(lds + PG8_SB(b, h) + boff + n * 2048 + k * 1024); } while (0)
#define PG8_MMA(ai, bj, At, Bt) do { __builtin_amdgcn_s_setprio(1); _Pragma("unroll") for (int m = 0; m < 4; ++m) _Pragma("unroll") for (int n = 0; n < 2; ++n) _Pragma("unroll") for (int k = 0; k < 2; ++k) \
        acc[ai][bj][m][n] = __builtin_amdgcn_mfma_f32_16x16x32_bf16(Bt[n][k], At[m][k], acc[ai][bj][m][n], 0, 0, 0); __builtin_amdgcn_s_setprio(0); } while (0)
#define PG8_WAIT_V(n) asm volatile("s_waitcnt vmcnt(" #n ")" ::: "memory")
#define PG8_WAIT_L(n) asm volatile("s_waitcnt lgkmcnt(" #n ")" ::: "memory")
#define PG8_BAR __builtin_amdgcn_s_barrier()
#define PG8_SCHED __builtin_amdgcn_sched_barrier(0)
    Unit cur, nxt; int ui = 0;
    if (!S.next(0, cur)) return;
    f32x4 acc[2][2][4][2];
#pragma unroll
    for (int a = 0; a < 2; ++a)
#pragma unroll
        for (int b = 0; b < 2; ++b)
#pragma unroll
            for (int m = 0; m < 4; ++m)
#pragma unroll
                for (int n = 0; n < 2; ++n) acc[a][b][m][n] = (f32x4){0.f, 0.f, 0.f, 0.f};
    bf16x8 At[4][2], B0[2][2], B1[2][2];
    const char* cA = (const char*)g.A + (size_t)cur.pm * tstep + (size_t)cur.ko * 2; const char* cB = (const char*)g.Bt + (size_t)cur.pn * tstep + (size_t)cur.ko * 2;
    S.a_ready(cur);
    if constexpr (SP2) {
        PG8_STAGE(PG8_SB(0, 0), cB, voffB); PG8_STAGE(PG8_SB(0, 1), cB + hstep, voffB); PG8_STAGE(PG8_SA(0, 0), cA, voffA); PG8_STAGE(PG8_SA(0, 1), cA + hstep, voffA);
        if (wr == 1) PG8_BAR;
        PG8_WAIT_V(2); PG8_BAR;
        PG8_STAGE(PG8_SB(1, 0), cB + kstep, voffB); PG8_STAGE(PG8_SA(1, 0), cA + kstep, voffA); PG8_STAGE(PG8_SB(1, 1), cB + hstep + kstep, voffB);
        PG8_WAIT_V(6); PG8_BAR;
    } else {
        PG8_STAGE(PG8_SB(0, 0), cB, voffB); PG8_STAGE(PG8_SA(0, 0), cA, voffA); PG8_STAGE(PG8_SB(0, 1), cB + hstep, voffB); PG8_STAGE(PG8_SA(0, 1), cA + hstep, voffA);
        if (wr == 1) PG8_BAR;
        PG8_WAIT_V(4); PG8_BAR;
        PG8_STAGE(PG8_SB(1, 0), cB + kstep, voffB); PG8_STAGE(PG8_SA(1, 0), cA + kstep, voffA); PG8_STAGE(PG8_SB(1, 1), cB + hstep + kstep, voffB);
        PG8_WAIT_V(6); PG8_BAR;
    }
    for (;;) {
        const bool has_next = S.next(ui + 1, nxt);
        const char* nA = has_next ? (const char*)g.A + (size_t)nxt.pm * tstep + (size_t)nxt.ko * 2 : cA; const char* nB = has_next ? (const char*)g.Bt + (size_t)nxt.pn * tstep + (size_t)nxt.ko * 2 : cB;
        const int ntu = cur.kt ? cur.kt : nt;
        for (int t = 0; t < ntu; t += 2) {
            const bool last = (t == ntu - 2);
            const char* a1 = cA + (size_t)(t + 1) * kstep;
            const char* a2 = last ? nA : cA + (size_t)(t + 2) * kstep; const char* b2 = last ? nB : cB + (size_t)(t + 2) * kstep;
            const char* a3 = a2 + kstep; const char* b3 = b2 + kstep;
            if (last && has_next) S.a_ready(nxt);
            if constexpr (SP2) {
            PG8_LDB(B0, 0, 0); PG8_LDB(B1, 0, 1); PG8_SCHED; PG8_LDA(At, 0, 0); PG8_STAGE(PG8_SA(1, 1), a1 + hstep, voffA);
            PG8_WAIT_V(8); PG8_WAIT_L(0); PG8_BAR; PG8_MMA(0, 0, At, B0); PG8_MMA(0, 1, At, B1); PG8_BAR; PG8_SCHED;
            PG8_LDA(At, 0, 1); PG8_STAGE(PG8_SB(0, 0), b2, voffB); PG8_STAGE(PG8_SB(0, 1), b2 + hstep, voffB); PG8_STAGE(PG8_SA(0, 0), a2, voffA);
            PG8_WAIT_V(8); PG8_WAIT_L(0); PG8_BAR; PG8_MMA(1, 0, At, B0); PG8_MMA(1, 1, At, B1); PG8_BAR; PG8_SCHED;
            PG8_LDB(B0, 1, 0); PG8_LDB(B1, 1, 1); PG8_SCHED; PG8_LDA(At, 1, 0); PG8_STAGE(PG8_SA(0, 1), a2 + hstep, voffA);
            PG8_WAIT_V(8); PG8_WAIT_L(0); PG8_BAR; PG8_MMA(0, 0, At, B0); PG8_MMA(0, 1, At, B1); PG8_BAR; PG8_SCHED;
            PG8_LDA(At, 1, 1); PG8_STAGE(PG8_SB(1, 0), b3, voffB); PG8_STAGE(PG8_SB(1, 1), b3 + hstep, voffB); PG8_STAGE(PG8_SA(1, 0), a3, voffA);
            PG8_WAIT_V(8); PG8_WAIT_L(0); PG8_BAR; PG8_MMA(1, 0, At, B0); PG8_MMA(1, 1, At, B1); PG8_BAR; PG8_SCHED;
            } else {
            PG8_LDB(B0, 0, 0); PG8_SCHED; PG8_LDA(At, 0, 0); PG8_STAGE(PG8_SA(1, 1), a1 + hstep, voffA);
            PG8_WAIT_L(8); PG8_BAR; PG8_WAIT_L(0); PG8_MMA(0, 0, At, B0); PG8_BAR; PG8_SCHED;
            PG8_LDB(B1, 0, 1); PG8_STAGE(PG8_SB(0, 0), b2, voffB);
            PG8_BAR; PG8_WAIT_L(0); PG8_MMA(0, 1, At, B1); PG8_BAR;
            PG8_LDA(At, 0, 1); PG8_STAGE(PG8_SA(0, 0), a2, voffA);
            PG8_BAR; PG8_WAIT_L(0); PG8_MMA(1, 0, At, B0); PG8_BAR; PG8_SCHED;
            PG8_STAGE(PG8_SB(0, 1), b2 + hstep, voffB);
            PG8_WAIT_V(6); PG8_BAR; PG8_MMA(1, 1, At, B1); PG8_BAR;
            PG8_LDB(B0, 1, 0); PG8_SCHED; PG8_LDA(At, 1, 0); PG8_STAGE(PG8_SA(0, 1), a2 + hstep, voffA);
            PG8_WAIT_L(8); PG8_BAR; PG8_WAIT_L(0); PG8_MMA(0, 0, At, B0); PG8_BAR; PG8_SCHED;
            PG8_LDB(B1, 1, 1); PG8_STAGE(PG8_SB(1, 0), b3, voffB);
            PG8_BAR; PG8_WAIT_L(0); PG8_MMA(0, 1, At, B1); PG8_BAR;
            PG8_LDA(At, 1, 1); PG8_STAGE(PG8_SA(1, 0), a3, voffA);
            PG8_BAR; PG8_WAIT_L(0); PG8_MMA(1, 0, At, B0); PG8_BAR; PG8_SCHED;
            PG8_STAGE(PG8_SB(1, 1), b3 + hstep, voffB);
            PG8_WAIT_V(6); PG8_BAR; PG8_MMA(1, 1, At, B1); PG8_BAR;
            }
        }
        if constexpr (ALIGN_EPI) { if (wr == 0) PG8_BAR; }
        if constexpr (!Epi::AFTER_DRAIN) { E(acc, cur, wr, wc, fr, fq); S.done(cur); }
        if (!has_next) break;
#pragma unroll
        for (int a = 0; a < 2; ++a)
#pragma unroll
            for (int b = 0; b < 2; ++b)
#pragma unroll
                for (int m = 0; m < 4; ++m)
#pragma unroll
                    for (int n = 0; n < 2; ++n) acc[a][b][m][n] = (f32x4){0.f, 0.f, 0.f, 0.f};
        cur = nxt; cA = nA; cB = nB; ++ui;
        if constexpr (ALIGN_EPI) { if (wr == 1) PG8_BAR; }
    }
    PG8_WAIT_V(0);
    if constexpr (!ALIGN_EPI) { if (wr == 0) PG8_BAR; }
    PG8_BAR;
    if constexpr (Epi::AFTER_DRAIN) { E.fused(acc, cur, wr, wc, fr, fq, lds, wid, lane); S.done(cur); }
#undef PG8_SA
#undef PG8_SB
#undef PG8_STAGE
#undef PG8_LDA
#undef PG8_LDB
#undef PG8_MMA
#undef PG8_WAIT_V
#undef PG8_WAIT_L
#undef PG8_BAR
#undef PG8_SCHED
}
}
namespace att {
using bf16 = unsigned short;
constexpr int   D = 128, NW = 8, QBLK = 32, KVBLK = 64;
constexpr float SCALE = 0.088388347648318440f;
constexpr float THR = 8.f;
constexpr int SDEPTH = 2;
constexpr size_t SHM_V = KVBLK * D * 2, SHM_K = KVBLK * D * 2, SHM_ATTN = 3 * SHM_V + 3 * SHM_K + NW * 64 * 4;
__device__ __forceinline__ unsigned short f2bf_rne(float f) { unsigned u = __builtin_bit_cast(unsigned, f); return (unsigned short)((u + 0x7fffu + ((u >> 16) & 1u)) >> 16); }
using bf16x8 = __attribute__((ext_vector_type(8))) short;
using s16x4  = __attribute__((ext_vector_type(4))) short;
using f32x16 = __attribute__((ext_vector_type(16))) float;
using f32x8  = __attribute__((ext_vector_type(8))) float;
using u32x4  = __attribute__((ext_vector_type(4))) unsigned;
#define KSWZ(row, colB) ((row) * 256 + ((colB) ^ (((row) & 7) << 4)))
#define SBAR() __builtin_amdgcn_sched_barrier(0)
__device__ __forceinline__ int crow(int r, int hi) { return (r & 3) + 8 * (r >> 2) + 4 * hi; }
__device__ __forceinline__ unsigned cvtpk(float lo, float hi) {
  unsigned r; asm volatile("v_cvt_pk_bf16_f32 %0, %1, %2" : "=v"(r) : "v"(lo), "v"(hi)); return r;
}
template <typename TIn> struct Stage;
template <> struct Stage<bf16>  { using T = bf16x8;
  __device__ static __forceinline__ T ld8(const bf16* p) { return *reinterpret_cast<const bf16x8*>(p); }
  __device__ static __forceinline__ bf16x8 tobf(T x) { return x; } };
template <> struct Stage<float> { using T = f32x8;
  __device__ static __forceinline__ T ld8(const float* p) { return *reinterpret_cast<const f32x8*>(p); }
  __device__ static __forceinline__ bf16x8 tobf(T x) {
    u32x4 w = {cvtpk(x[0], x[1]), cvtpk(x[2], x[3]), cvtpk(x[4], x[5]), cvtpk(x[6], x[7])}; return *reinterpret_cast<bf16x8*>(&w); } };

__device__ __forceinline__ void partialSM(f32x16& p0, f32x16& p1, float& m_reg, float& mn, float& alpha) {
  constexpr float C = SCALE * 1.4426950408889634f;
  float pmax = p0[0]; for (int r = 1; r < 16; ++r) pmax = fmaxf(pmax, p0[r]); for (int r = 0; r < 16; ++r) pmax = fmaxf(pmax, p1[r]);
  { auto rr = __builtin_amdgcn_permlane32_swap(__float_as_uint(pmax), __float_as_uint(pmax), false, false);
    pmax = fmaxf(__uint_as_float(rr[0]), __uint_as_float(rr[1])); }
  if (__builtin_expect(__all(pmax - m_reg <= THR / SCALE), 1)) { mn = m_reg; alpha = 1.f; }
  else { mn = fmaxf(m_reg, pmax); alpha = __builtin_amdgcn_exp2f((m_reg - mn) * C); m_reg = mn; }
  float mnC = -mn * C;
  for (int r = 0; r < 16; ++r) p0[r] = fmaf(p0[r], C, mnC); for (int r = 0; r < 16; ++r) p1[r] = fmaf(p1[r], C, mnC);
  for (int r = 0; r < 16; ++r) p0[r] = __builtin_amdgcn_exp2f(p0[r]);
}
__device__ __forceinline__ void finishSM(f32x16& p0, f32x16& p1, float alpha, float& l_reg, bf16x8& pa0, bf16x8& pa1, bf16x8& pa2, bf16x8& pa3) {
  for (int r = 0; r < 16; ++r) p1[r] = __builtin_amdgcn_exp2f(p1[r]);
  float ps = 0; for (int r = 0; r < 16; ++r) ps += p0[r]; for (int r = 0; r < 16; ++r) ps += p1[r];
  { auto rr = __builtin_amdgcn_permlane32_swap(__float_as_uint(ps), __float_as_uint(ps), false, false);
    ps = __uint_as_float(rr[0]) + __uint_as_float(rr[1]); }
  l_reg = l_reg * alpha + ps;
#define PK4(P, BASE, OUT) do { unsigned a0 = cvtpk(P[BASE + 0], P[BASE + 1]), a1 = cvtpk(P[BASE + 2], P[BASE + 3]);   \
    unsigned b0 = cvtpk(P[BASE + 4], P[BASE + 5]), b1 = cvtpk(P[BASE + 6], P[BASE + 7]);                              \
    auto r0 = __builtin_amdgcn_permlane32_swap(a0, b0, false, false); auto r1 = __builtin_amdgcn_permlane32_swap(a1, b1, false, false); \
    u32x4 w = {r0[0], r1[0], r0[1], r1[1]}; OUT = *reinterpret_cast<bf16x8*>(&w); } while (0)
  PK4(p0, 0, pa0); PK4(p0, 8, pa1); PK4(p1, 0, pa2); PK4(p1, 8, pa3);
#undef PK4
}
template <int NS> __device__ __forceinline__ void qkt(f32x16& p0, f32x16& p1, const bf16* Ks, const bf16x8* qr, int r32, int hi, int d0off) {
  p0 = f32x16{}; p1 = f32x16{};
#pragma unroll
  for (int d0 = 0; d0 < NS; ++d0) { int cb = ((d0 + d0off) * 16 + hi * 8) * 2;
    bf16x8 b0 = *reinterpret_cast<const bf16x8*>((const char*)Ks + KSWZ(r32, cb));
    bf16x8 b1 = *reinterpret_cast<const bf16x8*>((const char*)Ks + KSWZ(32 + r32, cb));
    p0 = __builtin_amdgcn_mfma_f32_32x32x16_bf16(b0, qr[d0], p0, 0, 0, 0);
    p1 = __builtin_amdgcn_mfma_f32_32x32x16_bf16(b1, qr[d0], p1, 0, 0, 0); }
}
__device__ __forceinline__ int v_st(int k, int c) { const int kk = (k & ~0xC) | ((k & 4) << 1) | ((k & 8) >> 1); return ((kk >> 3) * 4 + (c >> 5)) * 512 + ((kk & 7) * 32 + (c & 31)) * 2; }
__device__ __forceinline__ int v_rd_base(int lane) { return ((lane & 3) << 3) | (((lane >> 2) & 3) << 6) | (((lane >> 4) & 1) << 5) | (((lane >> 5) & 1) << 8); }
constexpr int v_rd_off(int d0, int ks, int half) { return d0 * 512 + ks * 4096 + half * 2048; }
template <int OFF> __device__ __forceinline__ s16x4 tr_read(int vb) {
  s16x4 r; asm volatile("ds_read_b64_tr_b16 %0, %1 offset:%2" : "=&v"(r) : "v"(vb), "i"(OFF) : "memory"); return r;
}
template <int D0> __device__ __forceinline__ void pv_one(f32x16& od, int vb, bf16x8 pa0, bf16x8 pa1, bf16x8 pa2, bf16x8 pa3) {
  const s16x4 l0 = tr_read<v_rd_off(D0, 0, 0)>(vb), h0 = tr_read<v_rd_off(D0, 0, 1)>(vb), l1 = tr_read<v_rd_off(D0, 1, 0)>(vb), h1 = tr_read<v_rd_off(D0, 1, 1)>(vb);
  const s16x4 l2 = tr_read<v_rd_off(D0, 2, 0)>(vb), h2 = tr_read<v_rd_off(D0, 2, 1)>(vb), l3 = tr_read<v_rd_off(D0, 3, 0)>(vb), h3 = tr_read<v_rd_off(D0, 3, 1)>(vb);
  asm volatile("s_waitcnt lgkmcnt(0)" ::: "memory"); SBAR();
#define PK(L, H) (bf16x8){L[0], L[1], L[2], L[3], H[0], H[1], H[2], H[3]}
  od = __builtin_amdgcn_mfma_f32_32x32x16_bf16(pa0, PK(l0, h0), od, 0, 0, 0);
  od = __builtin_amdgcn_mfma_f32_32x32x16_bf16(pa1, PK(l1, h1), od, 0, 0, 0);
  od = __builtin_amdgcn_mfma_f32_32x32x16_bf16(pa2, PK(l2, h2), od, 0, 0, 0);
  od = __builtin_amdgcn_mfma_f32_32x32x16_bf16(pa3, PK(l3, h3), od, 0, 0, 0);
#undef PK
}
__device__ __forceinline__ void pv_d0(f32x16* o, int vb, bf16x8 pa0, bf16x8 pa1, bf16x8 pa2, bf16x8 pa3) {
  pv_one<0>(o[0], vb, pa0, pa1, pa2, pa3); pv_one<1>(o[1], vb, pa0, pa1, pa2, pa3); pv_one<2>(o[2], vb, pa0, pa1, pa2, pa3); pv_one<3>(o[3], vb, pa0, pa1, pa2, pa3);
}

template <int LDQ, int LDK, int LDO, int NS, bool PAIR = false, bool RING3 = false>
__device__ __forceinline__ void attn_dense_body(const bf16* __restrict__ Qb, const bf16* __restrict__ Kh, const bf16* __restrict__ Vh,
                                                bf16* __restrict__ Ob, int seq, char* lds, int d0off, float* __restrict__ stats = nullptr) {
  using St = Stage<bf16>; using SQ = Stage<bf16>;
  const int tid = threadIdx.x, wid = tid >> 6, lane = tid & 63, r32 = lane & 31, hi = lane >> 5;
  bf16* V_lds = (bf16*)lds; bf16* K_lds = (bf16*)(lds + (RING3 ? 3 : 2) * SHM_V);
  float* ws = (float*)(lds + (RING3 ? 3 : 2) * (SHM_V + SHM_K)) + wid * 64; float* li_l = ws; float* al_l = ws + 32;
  float m_reg = -1e30f, l_reg = 0; f32x16 o[4] = {}; bf16x8 qr[NS];
  const int wrow = PAIR ? (wid & 3) : wid, comp = PAIR ? (wid >> 2) : 0; if (PAIR) d0off = 4 * comp;
  const bf16* Qw = Qb + comp * 128 + (long)(wrow * QBLK + r32) * LDQ + hi * 8;
#pragma unroll
  for (int d0 = 0; d0 < NS; ++d0) qr[d0] = SQ::tobf(SQ::ld8(Qw + (d0 + d0off) * 16));
  const int sr = tid >> 4, sc = (tid & 15) * 8, vst0 = v_st(sr, sc), vst1 = v_st(32 + sr, sc);
  const int vb0 = (int)(uintptr_t)V_lds + v_rd_base(lane);
  struct { typename St::T vs0, vs1, ks0, ks1; } sr_[SDEPTH];
#define SLOAD(i, k0) do { sr_[i].vs0 = St::ld8(&Vh[(long)((k0) + sr) * LDK + sc]); sr_[i].vs1 = St::ld8(&Vh[(long)((k0) + 32 + sr) * LDK + sc]); \
    sr_[i].ks0 = St::ld8(&Kh[(long)((k0) + sr) * LDK + sc]); sr_[i].ks1 = St::ld8(&Kh[(long)((k0) + 32 + sr) * LDK + sc]); } while (0)
#define SWRITE(b, i) do { *(bf16x8*)((char*)V_lds + (b) * SHM_V + vst0) = St::tobf(sr_[i].vs0);          \
    *(bf16x8*)((char*)V_lds + (b) * SHM_V + vst1) = St::tobf(sr_[i].vs1); int kc = sc * 2;               \
    *(bf16x8*)((char*)K_lds + (b) * SHM_K + KSWZ(sr, kc)) = St::tobf(sr_[i].ks0);                       \
    *(bf16x8*)((char*)K_lds + (b) * SHM_K + KSWZ(32 + sr, kc)) = St::tobf(sr_[i].ks1); } while (0)
#define SWAIT() do { if constexpr (SDEPTH == 2) asm volatile("s_waitcnt vmcnt(4)" ::: "memory"); else asm volatile("s_waitcnt vmcnt(0)" ::: "memory"); } while (0)
#define RESC(a) do { if (__any((a) < 1.f)) { if (hi == 0) al_l[r32] = (a); asm volatile("s_waitcnt lgkmcnt(0)" ::: "memory"); \
    for (int d = 0; d < 4; ++d) for (int r = 0; r < 16; ++r) o[d][r] *= al_l[crow(r, hi)]; } } while (0)
  f32x16 pA0, pA1, pB0, pB1; float mnA, mnB, alA, alB; bf16x8 pa0, pa1, pa2, pa3; const int NT = seq / KVBLK;
  constexpr int SE = 0, SO = SDEPTH - 1;
  if constexpr (RING3) {
  SLOAD(SE, 0); asm volatile("s_waitcnt vmcnt(0)" ::: "memory"); SWRITE(0, SE); __syncthreads();
  qkt<NS>(pA0, pA1, K_lds, qr, r32, hi, d0off); partialSM(pA0, pA1, m_reg, mnA, alA);
  SLOAD(SO, KVBLK); if constexpr (SDEPTH == 2) { if (2 < NT) SLOAD(SE, 2 * KVBLK); }
  SWAIT(); SWRITE(1, SO); __syncthreads();
  int bp = 0, bq = 1, bw = 2;
  for (int j = 1; j + 1 < NT; j += 2) {
    SBAR(); qkt<NS>(pB0, pB1, (bf16*)((char*)K_lds + bq * SHM_K), qr, r32, hi, d0off);
    finishSM(pA0, pA1, alA, l_reg, pa0, pa1, pa2, pa3); SBAR();
    SLOAD(SO, (j + SDEPTH) * KVBLK); SBAR();
    pv_d0(o, vb0 + bp * (int)SHM_V, pa0, pa1, pa2, pa3); partialSM(pB0, pB1, m_reg, mnB, alB);
    SWAIT(); SWRITE(bw, SE);
    RESC(alB); __syncthreads();
    { const int t_ = bp; bp = bq; bq = bw; bw = t_; }
    SBAR(); qkt<NS>(pA0, pA1, (bf16*)((char*)K_lds + bq * SHM_K), qr, r32, hi, d0off);
    finishSM(pB0, pB1, alB, l_reg, pa0, pa1, pa2, pa3); SBAR();
    if (SDEPTH == 1 || j + 3 < NT) SLOAD(SE, (j + 1 + SDEPTH) * KVBLK); SBAR();
    pv_d0(o, vb0 + bp * (int)SHM_V, pa0, pa1, pa2, pa3); partialSM(pA0, pA1, m_reg, mnA, alA);
    SWAIT(); SWRITE(bw, SO);
    RESC(alA); __syncthreads();
    { const int t_ = bp; bp = bq; bq = bw; bw = t_; }
  }
  SBAR(); qkt<NS>(pB0, pB1, (bf16*)((char*)K_lds + bq * SHM_K), qr, r32, hi, d0off);
  finishSM(pA0, pA1, alA, l_reg, pa0, pa1, pa2, pa3); SBAR();
  pv_d0(o, vb0 + bp * (int)SHM_V, pa0, pa1, pa2, pa3); partialSM(pB0, pB1, m_reg, mnB, alB);
  RESC(alB);
  finishSM(pB0, pB1, alB, l_reg, pa0, pa1, pa2, pa3); SBAR();
  pv_d0(o, vb0 + bq * (int)SHM_V, pa0, pa1, pa2, pa3);
  } else {
  SLOAD(SE, 0); asm volatile("s_waitcnt vmcnt(0)" ::: "memory"); SWRITE(0, SE); __syncthreads();
  qkt<NS>(pA0, pA1, K_lds, qr, r32, hi, d0off); partialSM(pA0, pA1, m_reg, mnA, alA);
  SLOAD(SO, KVBLK); if constexpr (SDEPTH == 2) { if (2 < NT) SLOAD(SE, 2 * KVBLK); }
  SWAIT(); SWRITE(1, SO); __syncthreads();
  for (int j = 1; j + 1 < NT; j += 2) {
    SBAR(); qkt<NS>(pB0, pB1, (bf16*)((char*)K_lds + SHM_K), qr, r32, hi, d0off);
    finishSM(pA0, pA1, alA, l_reg, pa0, pa1, pa2, pa3); SBAR();
    SLOAD(SO, (j + SDEPTH) * KVBLK); SBAR();
    pv_d0(o, vb0, pa0, pa1, pa2, pa3); partialSM(pB0, pB1, m_reg, mnB, alB);
    __syncthreads(); SWAIT(); SWRITE(0, SE);
    RESC(alB); __syncthreads();
    SBAR(); qkt<NS>(pA0, pA1, K_lds, qr, r32, hi, d0off);
    finishSM(pB0, pB1, alB, l_reg, pa0, pa1, pa2, pa3); SBAR();
    if (SDEPTH == 1 || j + 3 < NT) SLOAD(SE, (j + 1 + SDEPTH) * KVBLK); SBAR();
    pv_d0(o, vb0 + (int)SHM_V, pa0, pa1, pa2, pa3); partialSM(pA0, pA1, m_reg, mnA, alA);
    __syncthreads(); SWAIT(); SWRITE(1, SO);
    RESC(alA); __syncthreads();
  }
  SBAR(); qkt<NS>(pB0, pB1, (bf16*)((char*)K_lds + SHM_K), qr, r32, hi, d0off);
  finishSM(pA0, pA1, alA, l_reg, pa0, pa1, pa2, pa3); SBAR();
  pv_d0(o, vb0, pa0, pa1, pa2, pa3); partialSM(pB0, pB1, m_reg, mnB, alB);
  __syncthreads(); RESC(alB);
  finishSM(pB0, pB1, alB, l_reg, pa0, pa1, pa2, pa3); SBAR();
  pv_d0(o, vb0 + (int)SHM_V, pa0, pa1, pa2, pa3);
  }
  if (stats && hi == 0) { stats[(comp * 128 + wrow * QBLK + r32) * 2] = m_reg; stats[(comp * 128 + wrow * QBLK + r32) * 2 + 1] = l_reg; }
  if (hi == 0) li_l[r32] = l_reg; asm volatile("s_waitcnt lgkmcnt(0)" ::: "memory");
  float rli[16];
#pragma unroll
  for (int r = 0; r < 16; ++r) rli[r] = __builtin_amdgcn_rcpf(li_l[crow(r, hi)]);
  bf16* Ow = Ob + comp * 128 + (long)(wrow * QBLK) * LDO;
#pragma unroll
  for (int r = 0; r < 16; ++r) { int orow = crow(r, hi);
    for (int d0 = 0; d0 < 4; ++d0) Ow[(long)orow * LDO + d0 * 32 + r32] = f2bf_rne(o[d0][r] * rli[r]); }
#undef SLOAD
#undef SWRITE
#undef SWAIT
#undef RESC
}
}

constexpr int NWAVES = 8;
constexpr int D = 1024, NB = 2, SL = 8192, CT = 256, TP = SL + CT, MR = NB * TP, ML = NB * SL;
constexpr int E_IN = 3072, O_IN = 3456, O_INP = 3584, FFH = 2816, NE = 8, EH = 3584;
constexpr int NCH = TP / 128;
constexpr int NPH = 24;
constexpr int N_LAUNCHES = MK_N_LAUNCHES;
constexpr float NORM_EPS = 1e-6f, RWKV_LN_EPS = 64e-5f;
constexpr float LAM_INIT = 0.3555090676f;
constexpr int MOE_ROWS = 2 * ML + NE * 256;

enum ScanArr { SA_R = 0, SA_V, SA_K, SA_G, SA_AN, SA_L0, SA_L1, SA_A0, SA_A1, SA_N };
constexpr size_t MiB = 1u << 20;
constexpr size_t WS_CTL = 0, CTL_ZERO_BYTES = 20 * 1024;
constexpr size_t WS_MODV = 1 * MiB;
constexpr size_t WS_ROUTE = 2 * MiB;
constexpr size_t WS_TILEE = 2 * MiB + 768 * 1024;
constexpr size_t WS_WL = 3 * MiB;
constexpr size_t WS_WIN0 = 5 * MiB, WS_WOUT0 = 11 * MiB, WS_WGU0 = 13 * MiB, WS_WD0 = 24 * MiB;
constexpr size_t WS_WIN1 = 30 * MiB, WS_WOUT1 = 37 * MiB;
constexpr size_t WS_XR = 39 * MiB;
constexpr size_t WS_H = 105 * MiB;
constexpr size_t WS_PRJ0 = 138 * MiB;
constexpr size_t WS_MIX0 = 237 * MiB;
constexpr size_t WS_UT = 270 * MiB;
constexpr size_t WS_Y0 = 270 * MiB;
constexpr size_t WS_ACT0 = 138 * MiB;
constexpr size_t WS_KV1 = 138 * MiB;
constexpr size_t WS_RWQ = 171 * MiB;
constexpr size_t WS_QD = 254 * MiB;
constexpr size_t WS_SCAN = 286 * MiB;
constexpr size_t SCAN_ARR = (size_t)MR * 512 * 2;
constexpr size_t WS_LIN = 468 * MiB;
constexpr size_t WS_OB = 171 * MiB;
constexpr size_t WS_YS = 203 * MiB;
constexpr size_t WS_Y1 = 138 * MiB;
constexpr size_t WS_H2 = 310 * MiB;
constexpr size_t WS_WMOE_GU = 349 * MiB, WS_WMOE_D = 461 * MiB;
constexpr size_t WS_AG = 242 * MiB;
constexpr size_t WS_ACT1 = 4 * MiB;
constexpr size_t WS_CKP0 = 105 * MiB, WS_CKQ = 435 * MiB, WS_CKRT = 468 * MiB, WS_CKC4A = 5 * MiB, WS_CKC4B = 235 * MiB, WS_CKGAM = 22 * MiB;
constexpr size_t WS_OB2 = 352 * MiB, WS_ASTAT = 384 * MiB;
constexpr size_t WS_Y2F = 310 * MiB;
constexpr size_t WS_Y0F = 340 * MiB;
constexpr size_t WS_PRJF = 364 * MiB;
constexpr size_t WS_END = 517 * MiB;
static_assert(WS_OB2 >= WS_SCAN + 4 * SCAN_ARR && WS_ASTAT + (size_t)1024 * 256 * 8 <= WS_SCAN + SA_N * SCAN_ARR, "split-KV buffers");
static_assert(WS_CKQ + (size_t)4224 * 8192 <= WS_CKRT && WS_CKRT + (size_t)4224 * 8192 <= WS_END && WS_CKC4A + (size_t)2112 * 8192 <= WS_CKGAM && WS_CKGAM + (size_t)4224 * 256 <= WS_WIN1 && WS_CKC4B + (size_t)2112 * 8192 <= WS_QD && WS_CKC4B >= WS_YS + (size_t)2 * ML * 512 * 2, "ck map");
static_assert(WS_WL + (size_t)2560 * 384 * 2 <= WS_WIN0 && WS_WD0 + (size_t)D * FFH * 2 <= WS_WIN1 && WS_WOUT1 + (size_t)D * D * 2 <= WS_XR, "ws map A");
static_assert(WS_XR + (size_t)MR * D * 4 <= WS_H && WS_H + (size_t)MR * D * 2 <= WS_PRJ0 && WS_PRJ0 + (size_t)MR * E_IN * 2 <= WS_MIX0 && WS_MIX0 + (size_t)MR * D * 2 <= WS_UT, "ws map B");
static_assert(WS_UT + (size_t)NB * 4 * NCH * 2 * 16384 * 4 <= WS_END && WS_ACT0 + (size_t)MR * FFH * 2 <= WS_MIX0, "ws map C");
static_assert((size_t)NB * 4 * NCH * 2 * 16384 * 2 <= (size_t)MR * D * 2, "ST fits in H");
static_assert(WS_KV1 + (size_t)MR * 1024 * 2 <= WS_RWQ && WS_RWQ + (size_t)MR * 2560 * 2 <= WS_QD && WS_QD + (size_t)ML * 1024 * 2 <= WS_SCAN && WS_SCAN + SA_N * SCAN_ARR <= WS_LIN && WS_LIN + (size_t)MR * 384 * 2 <= WS_END, "ws map D");
static_assert(WS_OB + (size_t)ML * 1024 * 2 <= WS_YS && WS_YS + (size_t)2 * ML * 512 * 2 <= WS_AG, "ws map E");
static_assert(WS_ACT1 + (size_t)MOE_ROWS * EH * 2 <= WS_AG && WS_AG + (size_t)MOE_ROWS * D * 2 <= WS_H2 && WS_H2 + (size_t)ML * D * 2 <= WS_WMOE_GU, "ws map F");
static_assert(WS_WMOE_GU + (size_t)NE * 2 * EH * D * 2 <= WS_WMOE_D && WS_WMOE_D + (size_t)NE * D * EH * 2 <= WS_END, "ws map G");
constexpr int CW_TMO = 0, CW_CODE = 1;
constexpr int CW_BAR = 64;
constexpr int CW_QUEUE = 3584;
constexpr int CW_CNT = 3712;
static_assert((CW_CNT + 64 * NE) * 4 <= (int)CTL_ZERO_BYTES, "CTL");

constexpr int RING_OFF = 0, RING_BYTES = 155648;
constexpr int LDSCTL_OFF = RING_BYTES, MISC_OFF = LDSCTL_OFF + 320;
constexpr int LDS_BYTES = 156672;
static_assert(MISC_OFF + 128 <= LDS_BYTES, "LDS map");
#define GAS __attribute__((address_space(1)))
#define LAS __attribute__((address_space(3)))
typedef unsigned short bf16;
typedef unsigned v4u __attribute__((ext_vector_type(4)));
typedef float f32x4 __attribute__((ext_vector_type(4)));
typedef short bf16x8 __attribute__((ext_vector_type(8)));
typedef GAS unsigned gu32;
typedef GAS unsigned long long gu64;
#define RLX_AGENT __ATOMIC_RELAXED, __HIP_MEMORY_SCOPE_AGENT
#define LDS_WAIT() asm volatile("s_waitcnt lgkmcnt(0)" ::: "memory")
#define VM_WAIT() asm volatile("s_waitcnt vmcnt(0)" ::: "memory")
__device__ __forceinline__ unsigned long long rt() { return __builtin_amdgcn_s_memrealtime(); }
__device__ __forceinline__ unsigned f2bf(float f) { unsigned u = __builtin_bit_cast(unsigned, f); return (u + 0x7fffu + ((u >> 16) & 1u)) >> 16; }
__device__ __forceinline__ unsigned pk2_sw(float lo, float hi) { return f2bf(lo) | (f2bf(hi) << 16); }
typedef float f32x2c_t __attribute__((ext_vector_type(2))); typedef __bf16 bf16x2c_t __attribute__((ext_vector_type(2)));
__device__ __forceinline__ unsigned pk2(float lo, float hi) { const f32x2c_t v = {lo, hi}; const bf16x2c_t b = __builtin_convertvector(v, bf16x2c_t); return __builtin_bit_cast(unsigned, b); }

#define XB_TMO      128
#define XB_XCNT(j)  (256  + 64 * (j))
#define XB_XSUB(j)  (1280 + 64 * (j))
#define XB_XGEN(j)  (2304 + 64 * (j))
#define XB_TOP      3328
#define XB_TOPGEN   3392
#define XCD_BAR_WORDS 3456
#define XB_SPIN_CAP (1u << 18)

__device__ __forceinline__ unsigned xb_ld(unsigned* p)              { return __hip_atomic_load(p, __ATOMIC_RELAXED, __HIP_MEMORY_SCOPE_AGENT); }
__device__ __forceinline__ unsigned xb_add(unsigned* p, unsigned v) { return __hip_atomic_fetch_add(p, v, __ATOMIC_RELAXED, __HIP_MEMORY_SCOPE_AGENT); }
__device__ __forceinline__ unsigned xb_xcc_id() { return (unsigned)__builtin_amdgcn_s_getreg((3 << 11) | 20) & 0xFu; }
#define XB_SPIN(cond, bar) do { unsigned _sp = 0; while (cond) { __builtin_amdgcn_s_sleep(1); \
    if ((++_sp & 255u) == 0u) { if (xb_ld(&(bar)[XB_TMO])) break; if (_sp > XB_SPIN_CAP) { atomicAdd(&(bar)[XB_TMO], 1u); break; } } } } while (0)

struct XcdBarrier {
    unsigned* bar; unsigned x;
    volatile LAS unsigned* st;
};

__device__ __forceinline__ XcdBarrier xcd_barrier_post(unsigned* bar, volatile LAS unsigned* st) {
    XcdBarrier b; b.bar = bar; b.x = xb_xcc_id(); b.st = st;
    if (threadIdx.x == 0) (void)xb_add(&bar[XB_XCNT(b.x)], 1u);
    return b;
}
__device__ __forceinline__ void xcd_barrier_complete(unsigned* bar, unsigned x, unsigned& nloc, unsigned& nx) {
    const unsigned G = gridDim.x * gridDim.y * gridDim.z;
    unsigned sum, cnt, mine, sp = 0u;
    for (;;) {
        sum = 0u; cnt = 0u; mine = 0u;
#pragma unroll
        for (unsigned j = 0; j < 16; ++j) { const unsigned c = xb_ld(&bar[XB_XCNT(j)]); sum += c; cnt += (c > 0u) ? 1u : 0u; mine = (j == x) ? c : mine; }
        if (sum == G) break;
        __builtin_amdgcn_s_sleep(1);
        if ((++sp & 255u) == 0u) { if (xb_ld(&bar[XB_TMO])) break; if (sp > XB_SPIN_CAP) { atomicAdd(&bar[XB_TMO], 1u); break; } }
    }
    nloc = mine > 0u ? mine : 1u; nx = cnt > 0u ? cnt : 1u;
}

__device__ __forceinline__ void xcd_barrier(const XcdBarrier& b) {
    asm volatile("s_waitcnt vmcnt(0)" ::: "memory");
    __syncthreads();
    if (threadIdx.x == 0) {
        unsigned* bar = b.bar;
        __builtin_amdgcn_s_waitcnt(0);
        unsigned nloc = b.st[0], nx = b.st[1];
        if (nloc == 0u) { xcd_barrier_complete(bar, b.x, nloc, nx); b.st[0] = nloc; b.st[1] = nx; }
        const unsigned old = xb_add(&bar[XB_XSUB(b.x)], 1u);
        const unsigned gen = old / nloc;
        if (old + 1u == (gen + 1u) * nloc) {
            __builtin_amdgcn_fence(__ATOMIC_RELEASE, "agent");
            asm volatile("s_waitcnt vmcnt(0)" ::: "memory");
            const unsigned og = xb_add(&bar[XB_TOP], 1u);
            const unsigned tg = og / nx;
            if (og + 1u == (tg + 1u) * nx) xb_add(&bar[XB_TOPGEN], 1u);
            else XB_SPIN(xb_ld(&bar[XB_TOPGEN]) == tg, bar);
            __builtin_amdgcn_fence(__ATOMIC_ACQUIRE, "agent");
            xb_add(&bar[XB_XGEN(b.x)], 1u);
            asm volatile("s_waitcnt vmcnt(0)" ::: "memory");
        } else {
            XB_SPIN(xb_ld(&bar[XB_XGEN(b.x)]) == gen, bar);
            __builtin_amdgcn_fence(__ATOMIC_ACQUIRE, "agent");
            asm volatile("s_waitcnt vmcnt(0)" ::: "memory");
        }
    }
    __syncthreads();
}


struct Args { const float* in[35]; float* out; unsigned char* ws; int ph_lo, ph_hi; };
enum InIdx { I_X = 0, I_C, I_CTX, I_CCTX, I_MODW, I_MODB, I_NORMG, I_EWIN, I_EWOUT, I_RDEC, I_RNORMG, I_QNORM, I_KNORM, I_FWG, I_FWU, I_FWD, I_OWIN, I_OWOUT, I_DLAM, I_DSUBG,
             I_RMU, I_RW0, I_RW2, I_RA0, I_RA2, I_RG2, I_RKK, I_RKA, I_RRK, I_RLNG, I_RLNB, I_MROUTER, I_MWG, I_MWU, I_MWD };
struct Frame {
    LAS unsigned char* lds; char* ldsg;
    volatile LAS unsigned* MISC; gu32* ctl;
    int tid, lane, wave, vcu, G, gw, NGW;
    unsigned char* ws;
};
typedef float f32x2v __attribute__((ext_vector_type(2)));
typedef unsigned v2u __attribute__((ext_vector_type(2)));
typedef float f32x16 __attribute__((ext_vector_type(16)));
__device__ __forceinline__ float bf2f(unsigned short h) { return __uint_as_float(((unsigned)h) << 16); }
__device__ __forceinline__ float wave_sum_shfl(float v) {
#pragma unroll
    for (int o = 1; o < 64; o <<= 1) v += __shfl_xor(v, o);
    return v;
}
__device__ __forceinline__ float wave_sum(float v) {
    v += __builtin_bit_cast(float, __builtin_amdgcn_update_dpp(0, __builtin_bit_cast(int, v), 0xB1, 0xF, 0xF, true));
    v += __builtin_bit_cast(float, __builtin_amdgcn_update_dpp(0, __builtin_bit_cast(int, v), 0x4E, 0xF, 0xF, true));
    v += __builtin_bit_cast(float, __builtin_amdgcn_update_dpp(0, __builtin_bit_cast(int, v), 0x141, 0xF, 0xF, true));
    v += __builtin_bit_cast(float, __builtin_amdgcn_update_dpp(0, __builtin_bit_cast(int, v), 0x140, 0xF, 0xF, true));
    const int iv = __builtin_bit_cast(int, v);
    return (__builtin_bit_cast(float, __builtin_amdgcn_readlane(iv, 0)) + __builtin_bit_cast(float, __builtin_amdgcn_readlane(iv, 16))) +
           (__builtin_bit_cast(float, __builtin_amdgcn_readlane(iv, 32)) + __builtin_bit_cast(float, __builtin_amdgcn_readlane(iv, 48)));
}
#define DPPF(v, ctrl) __builtin_bit_cast(float, __builtin_amdgcn_update_dpp(0, __builtin_bit_cast(int, (v)), (ctrl), 0xF, 0xF, true))
__device__ __forceinline__ float sum16(float v) { v += DPPF(v, 0x128); v += DPPF(v, 0x124); v += DPPF(v, 0x122); v += DPPF(v, 0x121); return v; }
__device__ __forceinline__ float sum8(float v) { v += DPPF(v, 0xB1); v += DPPF(v, 0x4E); v += DPPF(v, 0x141); return v; }
__device__ __forceinline__ float lane_xor8(float v) { return DPPF(v, 0x128); }
__device__ __forceinline__ float lane_xor4(float v, bool bit2) { const float up = DPPF(v, 0x12C), dn = DPPF(v, 0x124); return bit2 ? dn : up; }
__device__ __forceinline__ void unpack8(const v4u w, float (&f)[8]) {
    f[0] = __uint_as_float(w.x << 16); f[1] = __uint_as_float(w.x & 0xffff0000u); f[2] = __uint_as_float(w.y << 16); f[3] = __uint_as_float(w.y & 0xffff0000u);
    f[4] = __uint_as_float(w.z << 16); f[5] = __uint_as_float(w.z & 0xffff0000u); f[6] = __uint_as_float(w.w << 16); f[7] = __uint_as_float(w.w & 0xffff0000u); }
__device__ __forceinline__ v4u pack8_sw(const float (&f)[8]) { v4u w; w.x = pk2_sw(f[0], f[1]); w.y = pk2_sw(f[2], f[3]); w.z = pk2_sw(f[4], f[5]); w.w = pk2_sw(f[6], f[7]); return w; }
__device__ __forceinline__ v4u pack8(const float (&f)[8]) { v4u w; w.x = pk2(f[0], f[1]); w.y = pk2(f[2], f[3]); w.z = pk2(f[4], f[5]); w.w = pk2(f[6], f[7]); return w; }
__device__ __forceinline__ f32x4 ld_bf4(const bf16* p) { const v2u w = *(const v2u*)p; return (f32x4){__uint_as_float(w.x << 16), __uint_as_float(w.x & 0xffff0000u), __uint_as_float(w.y << 16), __uint_as_float(w.y & 0xffff0000u)}; }
template <class T> __device__ __forceinline__ T ldnt(const T* p) { return __builtin_nontemporal_load(p); }
__device__ __forceinline__ f32x4 ld_bf4_nt(const bf16* p) { const v2u w = ldnt((const v2u*)p); return (f32x4){__uint_as_float(w.x << 16), __uint_as_float(w.x & 0xffff0000u), __uint_as_float(w.y << 16), __uint_as_float(w.y & 0xffff0000u)}; }
__device__ __forceinline__ void st_bf4(bf16* p, const f32x4 v) { v2u w; w.x = pk2(v[0], v[1]); w.y = pk2(v[2], v[3]); __builtin_nontemporal_store(w, (v2u*)p); }
template <class T> __device__ __forceinline__ void stnt(T* p, const T v) { __builtin_nontemporal_store(v, p); }
__device__ __forceinline__ float sigmoidf_(float x) { return __builtin_amdgcn_rcpf(1.0f + __builtin_amdgcn_exp2f(-1.44269504089f * x)); }
__device__ __forceinline__ float siluf_(float x) { return x * __builtin_amdgcn_rcpf(1.0f + __builtin_amdgcn_exp2f(-1.44269504089f * x)); }
__device__ __forceinline__ float sq4(const f32x4 v) { return (v[0] * v[0] + v[1] * v[1]) + (v[2] * v[2] + v[3] * v[3]); }

__device__ __forceinline__ void tr_item(const float* W, int ldw, int k0, int nsrc0, bf16* WT, int ldt, int ndst0, LAS float* scr, int lane) {
#pragma unroll 8
    for (int i = 0; i < 32; ++i) { const int kk = 2 * i + (lane >> 5); scr[kk * 33 + (lane & 31)] = __builtin_nontemporal_load(W + (size_t)(k0 + kk) * ldw + nsrc0 + (lane & 31)); }
    LDS_WAIT(); asm volatile("" ::: "memory");
    const int c = lane & 7;
#pragma unroll
    for (int j = 0; j < 4; ++j) { const int n = (lane >> 3) + 8 * j; const LAS float* s = scr + (8 * c) * 33 + n;
        v4u o; o.x = pk2(s[0 * 33], s[1 * 33]); o.y = pk2(s[2 * 33], s[3 * 33]); o.z = pk2(s[4 * 33], s[5 * 33]); o.w = pk2(s[6 * 33], s[7 * 33]);
        *(GAS v4u*)(WT + (size_t)(ndst0 + n) * ldt + k0 + 8 * c) = o; }
    LDS_WAIT(); asm volatile("" ::: "memory");
}
__device__ __forceinline__ void tr_plain(const float* W, int K, int N, bf16* WT, LAS float* scr, int item, int lane) {
    const int nblk = N / 32, kb = item / nblk, nb = item % nblk; tr_item(W, N, 64 * kb, 32 * nb, WT, K, 32 * nb, scr, lane);
}
__device__ __forceinline__ void tr_gu(const float* Wg, const float* Wu, int K, int HID, bf16* WT, LAS float* scr, int item, int lane) {
    const int nblk = 2 * HID / 32, kb = item / nblk, nb = item % nblk, nd = 32 * nb, t = nd / 256, w = nd % 256;
    const bool up = w >= 128; tr_item(up ? Wu : Wg, HID, 64 * kb, 128 * t + (up ? w - 128 : w), WT, K, nd, scr, lane);
}
__device__ __forceinline__ void p0_prologue(const Frame& F, const Args& A) {
    LAS float* scr = (LAS float*)(F.lds + RING_OFF + F.wave * 16384);
    unsigned char* ws = F.ws;
    if (F.vcu < 48) {
        const int l = F.vcu / 24, cb = F.vcu % 24, col = 256 * cb + 4 * F.lane, k0 = 128 * F.wave;
        LAS f32x4* part = (LAS f32x4*)(F.lds + RING_OFF);
        const float* W = A.in[I_MODW] + (size_t)l * D * 6144 + (size_t)k0 * 6144 + col;
        f32x4 a0 = {0.f, 0.f, 0.f, 0.f}, a1 = a0, a2 = a0;
#pragma unroll 1
        for (int kb = 0; kb < 128; kb += 32) {
            f32x4 w[32];
#pragma unroll
            for (int j = 0; j < 32; ++j) w[j] = __builtin_nontemporal_load((const f32x4*)(W + (size_t)(kb + j) * 6144));
#pragma unroll
            for (int j = 0; j < 32; ++j) { const int k = k0 + kb + j; a0 += w[j] * siluf_(A.in[I_C][k]); a1 += w[j] * siluf_(A.in[I_C][1024 + k]); a2 += w[j] * siluf_(A.in[I_CCTX][k]); }
        }
        part[(F.wave * 3 + 0) * 64 + F.lane] = a0; part[(F.wave * 3 + 1) * 64 + F.lane] = a1; part[(F.wave * 3 + 2) * 64 + F.lane] = a2;
        __syncthreads();
        if (F.wave < 3) { f32x4 s = *(const f32x4*)(A.in[I_MODB] + l * 6144 + col);
#pragma unroll
            for (int w8 = 0; w8 < 8; ++w8) s += part[(w8 * 3 + F.wave) * 64 + F.lane];
            *(f32x4*)((float*)(ws + WS_MODV) + (size_t)(l * 3 + F.wave) * 6144 + col) = s; }
        __syncthreads();
    }
    constexpr int I0 = (D / 64) * (E_IN / 32);
    for (int it = F.gw; it < I0; it += F.NGW) tr_plain(A.in[I_EWIN], D, E_IN, (bf16*)(ws + WS_WIN0), scr, it, F.lane);
}
__device__ __forceinline__ void p0_rest(const Frame& F, const Args& A, int first) {
    if ((int)blockIdx.x < first) return;
    LAS float* scr = (LAS float*)(F.lds + RING_OFF + F.wave * 16384); unsigned char* ws = F.ws;
    const int nw = (F.G - first) * NWAVES, myw = ((int)blockIdx.x - first) * NWAVES + F.wave;
    constexpr int I1 = (D / 64) * (D / 32), I2 = (D / 64) * (2 * FFH / 32), I3 = (FFH / 64) * (D / 32), I4 = (D / 64) * (O_IN / 32), I5 = I1;
    constexpr int NITEMS = I1 + I2 + I3 + I4 + I5;
    for (int it = myw; it < NITEMS; it += nw) {
        int r = it;
        if (r < I1) { tr_plain(A.in[I_EWOUT], D, D, (bf16*)(ws + WS_WOUT0), scr, r, F.lane); continue; } r -= I1;
        if (r < I2) { tr_gu(A.in[I_FWG], A.in[I_FWU], D, FFH, (bf16*)(ws + WS_WGU0), scr, r, F.lane); continue; } r -= I2;
        if (r < I3) { tr_plain(A.in[I_FWD], FFH, D, (bf16*)(ws + WS_WD0), scr, r, F.lane); continue; } r -= I3;
        if (r < I4) { tr_plain(A.in[I_OWIN], D, O_IN, (bf16*)(ws + WS_WIN1), scr, r, F.lane); continue; } r -= I4;
        tr_plain(A.in[I_OWOUT], D, D, (bf16*)(ws + WS_WOUT1), scr, r, F.lane);
    }
    const int gt = ((int)blockIdx.x - first) * (NWAVES * 64) + F.tid, NGT = (F.G - first) * NWAVES * 64;
    { bf16* z = (bf16*)(ws + WS_WIN1) + (size_t)O_IN * D; for (int i = gt; i < (O_INP - O_IN) * D / 8; i += NGT) *(v4u*)(z + (size_t)i * 8) = (v4u){0u, 0u, 0u, 0u}; }
    { bf16* wl = (bf16*)(ws + WS_WL);
      for (int i = gt; i < 2560 * 384; i += NGT) {
          const int n = i / 384, k = i % 384, blk = n / 512, nn = n % 512; float v = 0.f;
          if (blk < 2) { const int kk = k - 64 * blk; if (kk >= 0 && kk < 64) v = A.in[I_RW2][((size_t)blk * 64 + kk) * 512 + nn]; }
          else if (blk < 4) { const int d = blk - 2, kk = k - 128 - 64 * d; if (kk >= 0 && kk < 64) v = A.in[I_RA2][((size_t)d * 64 + kk) * 512 + nn]; }
          else { const int kk = k - 256; if (kk >= 0) v = A.in[I_RG2][(size_t)kk * 512 + nn]; }
          wl[i] = (bf16)f2bf(v); } }
}
__device__ __forceinline__ void moe_weights(const Frame& F, const Args& A) {
    LAS float* scr = (LAS float*)(F.lds + RING_OFF + F.wave * 16384);
    constexpr int IG = (D / 64) * (2 * EH / 32), ID = (EH / 64) * (D / 32);
    for (int it = F.gw; it < NE * (IG + ID); it += F.NGW) {
        const int e = it / (IG + ID); int r = it % (IG + ID);
        if (r < IG) tr_gu(A.in[I_MWG] + (size_t)e * D * EH, A.in[I_MWU] + (size_t)e * D * EH, D, EH, (bf16*)(F.ws + WS_WMOE_GU) + (size_t)e * 2 * EH * D, scr, r, F.lane);
        else tr_plain(A.in[I_MWD] + (size_t)e * EH * D, EH, D, (bf16*)(F.ws + WS_WMOE_D) + (size_t)e * D * EH, scr, r - IG, F.lane);
    }
}

__device__ __forceinline__ const float* modv(const Frame& F, int layer, int r) { const int b = r / TP, p = r % TP; return (const float*)(F.ws + WS_MODV) + (size_t)(layer * 3 + (p < CT ? 2 : b)) * 6144; }
__device__ __forceinline__ const float* p1_src(const Args& A, int r) { const int b = r / TP, p = r % TP; return p < CT ? A.in[I_CTX] + (size_t)(b * CT + p) * D : A.in[I_X] + (size_t)(b * SL + p - CT) * D; }
__device__ __forceinline__ void p1_first_h(const Frame& F, const Args& A) {
    bf16* H = (bf16*)(F.ws + WS_H); const float* ng = A.in[I_NORMG];
    f32x4 g[4], sh[4], sc[4]; int cur = -1;
#pragma unroll
    for (int j = 0; j < 4; ++j) g[j] = *(const f32x4*)(ng + 4 * F.lane + 256 * j);
    for (int r0 = F.gw; r0 < MR; r0 += 4 * F.NGW) {
        f32x4 v[4][4]; int rr[4];
#pragma unroll
        for (int q = 0; q < 4; ++q) { rr[q] = r0 + q * F.NGW; const int rl = rr[q] < MR ? rr[q] : r0; const float* s = p1_src(A, rl);
#pragma unroll
            for (int j = 0; j < 4; ++j) v[q][j] = __builtin_nontemporal_load((const f32x4*)(s + 4 * F.lane + 256 * j)); }
#pragma unroll
        for (int q = 0; q < 4; ++q) if (rr[q] < MR) {
            const int r = rr[q], p = r % TP, set = p < CT ? 2 : r / TP;
            if (set != cur) { cur = set; const float* mv = (const float*)(F.ws + WS_MODV) + (size_t)set * 6144;
#pragma unroll
                for (int j = 0; j < 4; ++j) { sh[j] = *(const f32x4*)(mv + 4 * F.lane + 256 * j); sc[j] = *(const f32x4*)(mv + 1024 + 4 * F.lane + 256 * j) + 1.0f; } }
            float ss = 0.f;
#pragma unroll
            for (int j = 0; j < 4; ++j) ss += sq4(v[q][j]);
            const float rs = rsqrtf(wave_sum(ss) * (1.f / D) + NORM_EPS);
#pragma unroll
            for (int j = 0; j < 4; ++j) st_bf4(H + (size_t)r * D + 4 * F.lane + 256 * j, (v[q][j] * rs * g[j]) * sc[j] + sh[j]);
        }
    }
}
struct RowYX { f32x4 y[4], x[4]; };
__device__ __forceinline__ void st_x4(float* p, const f32x4 v) { __builtin_nontemporal_store(v, (f32x4*)p); }
__device__ __forceinline__ void st_x4(bf16* p, const f32x4 v) { st_bf4(p, v); }
__device__ __forceinline__ void load_yx(const Frame& F, const bf16* yrow, const float* xin, RowYX& R) {
#pragma unroll
    for (int j = 0; j < 4; ++j) { R.y[j] = ld_bf4_nt(yrow + 4 * F.lane + 256 * j); R.x[j] = ldnt((const f32x4*)(xin + 4 * F.lane + 256 * j)); }
}
__device__ __forceinline__ void load_yxb(const Frame& F, const bf16* yrow, const bf16* xin, RowYX& R) {
#pragma unroll
    for (int j = 0; j < 4; ++j) { R.y[j] = ld_bf4_nt(yrow + 4 * F.lane + 256 * j); R.x[j] = ld_bf4_nt(xin + 4 * F.lane + 256 * j); }
}
template <class TX> __device__ __forceinline__ void resid_norm(const Frame& F, const RowYX& R, TX* xout, const float* gate, const float* ngA, const float* ngB, const float* sh, const float* sc, bf16* hrow, f32x4 (&h)[4]) {
    float ss = 0.f;
#pragma unroll
    for (int j = 0; j < 4; ++j) ss += sq4(R.y[j]);
    const float rs = rsqrtf(wave_sum(ss) * (1.f / D) + NORM_EPS);
    f32x4 x[4]; float s2 = 0.f;
#pragma unroll
    for (int j = 0; j < 4; ++j) { const int c = 4 * F.lane + 256 * j;
        x[j] = R.x[j] + *(const f32x4*)(gate + c) * (R.y[j] * rs * *(const f32x4*)(ngA + c)); st_x4(xout + c, x[j]); s2 += sq4(x[j]); }
    const float r2 = rsqrtf(wave_sum(s2) * (1.f / D) + NORM_EPS);
#pragma unroll
    for (int j = 0; j < 4; ++j) { const int c = 4 * F.lane + 256 * j;
        h[j] = (x[j] * r2 * *(const f32x4*)(ngB + c)) * (*(const f32x4*)(sc + c) + 1.0f) + *(const f32x4*)(sh + c); st_bf4(hrow + c, h[j]); }
}
__device__ __forceinline__ void p_resid_row(const Frame& F, const Args& A, int r, const RowYX& R, int layer, int which) {
    bf16* XR = (bf16*)(F.ws + WS_XR); bf16* H = (bf16*)(F.ws + WS_H); const float* ng = A.in[I_NORMG]; const float* mv = modv(F, layer, r); f32x4 h[4];
    if (which == 0) resid_norm(F, R, XR + (size_t)r * D, mv + 2 * 1024, ng + (layer * 4 + 1) * D, ng + (layer * 4 + 2) * D, mv + 3 * 1024, mv + 4 * 1024, H + (size_t)r * D, h);
    else { const float* mn = modv(F, layer + 1, r);
        resid_norm(F, R, XR + (size_t)r * D, mv + 5 * 1024, ng + (layer * 4 + 3) * D, ng + ((layer + 1) * 4 + 0) * D, mn + 0 * 1024, mn + 1 * 1024, H + (size_t)r * D, h); }
}
template <int NKS> __device__ __forceinline__ void load_y(const Frame& F, const bf16* Y, int r, RowYX& R) {
    const int p = r % TP;
    if (NKS > 0 && p < CT) { const float* yf = (const float*)(F.ws + WS_Y0F) + (size_t)((r / TP) * CT + p) * D + 4 * F.lane;
#pragma unroll
        for (int j = 0; j < 4; ++j) { f32x4 t[NKS > 0 ? NKS : 1];
#pragma unroll
            for (int s = 0; s < NKS; ++s) t[s] = ldnt((const f32x4*)(yf + (size_t)s * 512 * D + 256 * j));
            R.y[j] = t[0];
#pragma unroll
            for (int s = 1; s < NKS; ++s) R.y[j] += t[s]; } }
    else {
#pragma unroll
        for (int j = 0; j < 4; ++j) R.y[j] = ld_bf4_nt(Y + (size_t)r * D + 4 * F.lane + 256 * j); }
}
struct ModRegs { f32x4 ga[4], gb[4], sh[4]; int cur; };
__device__ __forceinline__ void mod_load(const Frame& F, const Args& A, ModRegs& M, int set, int layer, int which) {
    if (set == M.cur) return; M.cur = set;
    const float* ng = A.in[I_NORMG]; const float* mv = (const float*)(F.ws + WS_MODV) + (size_t)(layer * 3 + set) * 6144; const float* mn = (const float*)(F.ws + WS_MODV) + (size_t)((layer + 1) * 3 + set) * 6144;
    const float* gate = mv + (which == 0 ? 2 : 5) * 1024; const float* ngA = ng + (layer * 4 + (which == 0 ? 1 : 3)) * D; const float* ngB = which == 0 ? ng + (layer * 4 + 2) * D : ng + ((layer + 1) * 4 + 0) * D;
    const float* sh = which == 0 ? mv + 3 * 1024 : mn; const float* sc = which == 0 ? mv + 4 * 1024 : mn + 1024;
#pragma unroll
    for (int j = 0; j < 4; ++j) { const int c = 4 * F.lane + 256 * j;
        M.ga[j] = *(const f32x4*)(gate + c) * *(const f32x4*)(ngA + c); M.gb[j] = *(const f32x4*)(ngB + c) * (*(const f32x4*)(sc + c) + 1.0f); M.sh[j] = *(const f32x4*)(sh + c); }
}
template <class TX> __device__ __forceinline__ void resid_norm_m(const Frame& F, const RowYX& R, const ModRegs& M, TX* xout, bf16* hrow, f32x4 (&h)[4]) {
    float ss = 0.f;
#pragma unroll
    for (int j = 0; j < 4; ++j) ss += sq4(R.y[j]);
    const float rs = rsqrtf(wave_sum(ss) * (1.f / D) + NORM_EPS);
    f32x4 x[4]; float s2 = 0.f;
#pragma unroll
    for (int j = 0; j < 4; ++j) { x[j] = R.x[j] + M.ga[j] * (R.y[j] * rs); st_x4(xout + 4 * F.lane + 256 * j, x[j]); s2 += sq4(x[j]); }
    const float r2 = rsqrtf(wave_sum(s2) * (1.f / D) + NORM_EPS);
#pragma unroll
    for (int j = 0; j < 4; ++j) { h[j] = (x[j] * r2) * M.gb[j] + M.sh[j]; st_bf4(hrow + 4 * F.lane + 256 * j, h[j]); }
}
template <int NKS> __device__ __forceinline__ void p_resid_all(const Frame& F, const Args& A, const bf16* Y, int layer, int which  ) {
    bf16* XR = (bf16*)(F.ws + WS_XR); bf16* H = (bf16*)(F.ws + WS_H); ModRegs M; M.cur = -1;
    for (int r = F.gw; r < MR; r += 2 * F.NGW) {
        const int r2 = r + F.NGW; const bool two = r2 < MR; const int rb = two ? r2 : r; RowYX Ra, Rb;
        load_y<NKS>(F, Y, r, Ra); load_y<NKS>(F, Y, rb, Rb);
#pragma unroll
        for (int j = 0; j < 4; ++j) {
            if (which == 0) { Ra.x[j] = ldnt((const f32x4*)(p1_src(A, r) + 4 * F.lane + 256 * j)); Rb.x[j] = ldnt((const f32x4*)(p1_src(A, rb) + 4 * F.lane + 256 * j)); }
            else { Ra.x[j] = ld_bf4_nt(XR + (size_t)r * D + 4 * F.lane + 256 * j); Rb.x[j] = ld_bf4_nt(XR + (size_t)rb * D + 4 * F.lane + 256 * j); } }
        f32x4 h[4];
        mod_load(F, A, M, (r % TP) < CT ? 2 : r / TP, layer, which); resid_norm_m(F, Ra, M, XR + (size_t)r * D, H + (size_t)r * D, h);
        if (two) { mod_load(F, A, M, (r2 % TP) < CT ? 2 : r2 / TP, layer, which); resid_norm_m(F, Rb, M, XR + (size_t)r2 * D, H + (size_t)r2 * D, h); }
    }
}
template <int NP> __device__ __forceinline__ void rope_cs(int lane, int t, float (&cs)[8], float (&sn)[8]) {
    const float rowp = (float)(t / 64), colp = (float)(t % 64);
#pragma unroll
    for (int e = 0; e < 8; ++e) { const int i = 8 * (lane & (NP / 8 - 1)) + e, fi = i & (NP / 2 - 1);
        const float f = __builtin_amdgcn_exp2f(-(float)fi * (13.287712379549449f / (float)(NP / 2))); const float ang = ((i < NP / 2) ? rowp : colp) * f;
        cs[e] = __cosf(ang); sn[e] = __sinf(ang); }
}
template <int XORD> __device__ __forceinline__ void rope_apply(float (&v)[8], const float (&cs)[8], const float (&sn)[8], bool first) {
#pragma unroll
    for (int e = 0; e < 8; ++e) { const float p = XORD == 8 ? lane_xor8(v[e]) : lane_xor4(v[e], !first); v[e] = first ? v[e] * cs[e] - p * sn[e] : p * sn[e] + v[e] * cs[e]; }
}
__device__ __forceinline__ void p3_ld8(const bf16* row, const float* part, int off, bool lat, float (&v)[8]) {
    if (lat) { unpack8(ldnt((const v4u*)(row + off)), v); return; }
    f32x4 a = ldnt((const f32x4*)(part + off)), b = ldnt((const f32x4*)(part + off + 4));
#pragma unroll
    for (int s = 1; s < 4; ++s) { a += ldnt((const f32x4*)(part + (size_t)s * 512 * E_IN + off)); b += ldnt((const f32x4*)(part + (size_t)s * 512 * E_IN + off + 4)); }
#pragma unroll
    for (int j = 0; j < 4; ++j) { v[j] = a[j]; v[4 + j] = b[j]; }
}
__device__ __forceinline__ void p3_post0(const Frame& F, const Args& A) {
    bf16* P = (bf16*)(F.ws + WS_PRJ0); const int l = F.lane;
    float qg[8], kg[8];
#pragma unroll
    for (int e = 0; e < 8; ++e) { qg[e] = A.in[I_QNORM][8 * (l & 15) + e]; kg[e] = A.in[I_KNORM][8 * (l & 15) + e]; }
    for (int r = F.gw; r < MR; r += F.NGW) {
        const int p = r % TP; const bool lat = p >= CT; bf16* row = P + (size_t)r * E_IN;
        float cs[8], sn[8];
#pragma unroll
        for (int e = 0; e < 8; ++e) { cs[e] = 1.f; sn[e] = 0.f; }
        if (lat) rope_cs<64>(l, p - CT, cs, sn);
        const bool first = (l & 8) == 0;
        float v[8];
        unpack8(ldnt((const v4u*)(row + 8 * l)), v); rope_apply<8>(v, cs, sn, first); *(v4u*)(row + 8 * l) = pack8(v);
        unpack8(ldnt((const v4u*)(row + 512 + 8 * l)), v);
#pragma unroll
        for (int e = 0; e < 8; ++e) v[e] *= 0.088388347648318440f;
        rope_apply<8>(v, cs, sn, first); *(v4u*)(row + 512 + 8 * l) = pack8(v);
        { unpack8(ldnt((const v4u*)(row + 2048 + 8 * l)), v); float ss = 0.f;
#pragma unroll
          for (int e = 0; e < 8; ++e) ss += v[e] * v[e];
          ss = sum16(ss);
          const float rs = rsqrtf(ss * (1.f / 128.f) + NORM_EPS);
#pragma unroll
          for (int e = 0; e < 8; ++e) v[e] = v[e] * rs * qg[e];
          rope_apply<8>(v, cs, sn, first); *(v4u*)(row + 2048 + 8 * l) = pack8(v); }
        { unpack8(ldnt((const v4u*)(row + 2560 + 8 * l)), v); float ss = 0.f;
#pragma unroll
          for (int e = 0; e < 8; ++e) ss += v[e] * v[e];
          ss = sum16(ss);
          const float rs = rsqrtf(ss * (1.f / 128.f) + NORM_EPS);
#pragma unroll
          for (int e = 0; e < 8; ++e) v[e] = v[e] * rs * kg[e];
          rope_apply<8>(v, cs, sn, first); if (l < 32) *(v4u*)(row + 2560 + 8 * l) = pack8(v); }
    }
}

typedef LAS unsigned short lbf16;
typedef short bf16x8 __attribute__((ext_vector_type(8)));
__device__ __forceinline__ float ret_lg(const Args& A, int d, int h) { return log2f(1.0f - exp2f(-A.in[I_RDEC][d * 4 + h])); }
template <int NOUT> __device__ __forceinline__ void stage_T(const bf16* src, int ld, lbf16* T0, lbf16* T1, int tid, float lg0, float lg1) {
    const int m = tid >> 2, q = tid & 3;
    const float s0 = NOUT == 2 ? exp2f(lg0 * (float)(127 - m)) : 1.f, s1 = NOUT == 2 ? exp2f(lg1 * (float)m) : 1.f;
#pragma unroll
    for (int c = 0; c < 4; ++c) { float f[8]; unpack8(*(const v4u*)(src + (size_t)m * ld + q * 32 + c * 8), f);
#pragma unroll
        for (int e = 0; e < 8; ++e) { const int col = q * 32 + c * 8 + e; T0[col * 136 + m] = (unsigned short)f2bf(f[e] * s0); if (NOUT == 2) T1[col * 136 + m] = (unsigned short)f2bf(f[e] * s1); } }
}
__device__ __forceinline__ void ret_u_unit(const Frame& F, const Args& A, int unit) {
    const int b = unit / (4 * NCH), h = (unit / NCH) % 4, g = unit % NCH, r0 = b * TP + g * 128;
    const bf16* P = (const bf16*)(F.ws + WS_PRJ0) + (size_t)r0 * E_IN;
    lbf16* KT0 = (lbf16*)(F.lds); lbf16* KT1 = KT0 + 128 * 136; lbf16* VT = KT1 + 128 * 136;
    const float lg0 = ret_lg(A, 0, h), lg1 = ret_lg(A, 1, h);
    stage_T<2>(P + 512 + h * 128, E_IN, KT0, KT1, F.tid, lg0, lg1);
    stage_T<1>(P + 1024 + h * 128, E_IN, VT, VT, F.tid, 0.f, 0.f);
    __syncthreads();
    const int rb = F.wave >> 1, ch = F.wave & 1, r32 = F.lane & 31, hi = F.lane >> 5;
#pragma unroll
    for (int d = 0; d < 2; ++d) {
        const lbf16* KT = d ? KT1 : KT0; f32x16 acc[2] = {};
#pragma unroll
        for (int ks = 0; ks < 8; ++ks) { const bf16x8 a = *(const LAS bf16x8*)(KT + (32 * rb + r32) * 136 + 16 * ks + 8 * hi);
#pragma unroll
            for (int dt = 0; dt < 2; ++dt) { const bf16x8 bb = *(const LAS bf16x8*)(VT + (64 * ch + 32 * dt + r32) * 136 + 16 * ks + 8 * hi);
                acc[dt] = __builtin_amdgcn_mfma_f32_32x32x16_bf16(a, bb, acc[dt], 0, 0, 0); } }
        float* U = (float*)(F.ws + WS_UT) + ((size_t)((b * 4 + h) * NCH + g) * 2 + d) * 16384;
#pragma unroll
        for (int dt = 0; dt < 2; ++dt) { const int dv = 64 * ch + 32 * dt + r32;
#pragma unroll
            for (int g4 = 0; g4 < 4; ++g4) *(f32x4*)(U + dv * 128 + 32 * rb + 8 * g4 + 4 * hi) = (f32x4){acc[dt][4 * g4], acc[dt][4 * g4 + 1], acc[dt][4 * g4 + 2], acc[dt][4 * g4 + 3]}; }
    }
    __syncthreads();
}
__device__ __forceinline__ void ret_prefix(const Frame& F, const Args& A) {
    const float* UT = (const float*)(F.ws + WS_UT); bf16* ST = (bf16*)(F.ws + WS_H);
    const int gt = F.vcu * (NWAVES * 64) + F.tid, NGT = F.G * NWAVES * 64;
    for (int idx = gt; idx < 16 * 16384; idx += NGT) {
        const int sc = idx >> 14, el = idx & 16383, b = sc >> 3, h = (sc >> 1) & 3, d = sc & 1;
        const float cd = exp2f(ret_lg(A, d, h) * 128.f); float s = 0.f;
#pragma unroll 6
        for (int i = 0; i < NCH; ++i) { const int g = d == 0 ? i : (i < 2 ? 1 - i : NCH + 1 - i);
            const size_t off = ((size_t)((b * 4 + h) * NCH + g) * 2 + d) * 16384 + el; ST[off] = (bf16)f2bf(s); s = s * cd + __builtin_nontemporal_load(UT + off); }
    }
}
__device__ __forceinline__ bf16x8 scale_frag(const bf16x8 q, float s) { float f[8]; unpack8(__builtin_bit_cast(v4u, q), f);
#pragma unroll
    for (int e = 0; e < 8; ++e) f[e] *= s;
    return __builtin_bit_cast(bf16x8, pack8_sw(f)); }
__device__ __forceinline__ void ret_out_unit(const Frame& F, const Args& A, int unit) {
    const int b = unit / (4 * NCH), h = (unit / NCH) % 4, g = unit % NCH, r0 = b * TP + g * 128;
    const bf16* P = (const bf16*)(F.ws + WS_PRJ0) + (size_t)r0 * E_IN;
    lbf16* VT = (lbf16*)(F.lds); LAS float* YS = (LAS float*)(F.lds + 128 * 136 * 2);
    const float lg0 = ret_lg(A, 0, h), lg1 = ret_lg(A, 1, h);
    stage_T<1>(P + 1024 + h * 128, E_IN, VT, VT, F.tid, 0.f, 0.f);
    const int rb = F.wave >> 1, ch = F.wave & 1, r32 = F.lane & 31, hi = F.lane >> 5;
    const int n = 32 * rb + r32;
    bf16x8 qf[8];
#pragma unroll
    for (int ks = 0; ks < 8; ++ks) qf[ks] = *(const bf16x8*)(P + (size_t)n * E_IN + h * 128 + 16 * ks + 8 * hi);
    __syncthreads();
    f32x16 Y[2] = {};
    const lbf16* vrow0 = VT + (64 * ch + r32) * 136;
#pragma unroll 1
    for (int mt = 0; mt < 4; ++mt) {
        f32x16 X = {};
#pragma unroll
        for (int ks = 0; ks < 8; ++ks) { const bf16x8 kf = *(const bf16x8*)(P + (size_t)(32 * mt + r32) * E_IN + 512 + h * 128 + 16 * ks + 8 * hi);
            X = __builtin_amdgcn_mfma_f32_32x32x16_bf16(kf, qf[ks], X, 0, 0, 0); }
        float xs[16];
#pragma unroll
        for (int r = 0; r < 16; ++r) { const int m = 32 * mt + (r & 3) + 8 * (r >> 2) + 4 * hi; const float dl = (float)(n - m);
            xs[r] = X[r] * (dl >= 0.f ? exp2f(lg0 * dl) : exp2f(-lg1 * dl)); }
#pragma unroll
        for (int s = 0; s < 2; ++s) { v4u w; w.x = pk2_sw(xs[8 * s], xs[8 * s + 1]); w.y = pk2_sw(xs[8 * s + 2], xs[8 * s + 3]); w.z = pk2_sw(xs[8 * s + 4], xs[8 * s + 5]); w.w = pk2_sw(xs[8 * s + 6], xs[8 * s + 7]);
            const bf16x8 pa = __builtin_bit_cast(bf16x8, w);
#pragma unroll
            for (int dt = 0; dt < 2; ++dt) { const lbf16* vrow = vrow0 + 32 * dt * 136;
                const v2u lo = *(const LAS v2u*)(vrow + 32 * mt + 16 * s + 4 * hi), hh = *(const LAS v2u*)(vrow + 32 * mt + 16 * s + 8 + 4 * hi);
                const v4u wv = {lo.x, lo.y, hh.x, hh.y};
                Y[dt] = __builtin_amdgcn_mfma_f32_32x32x16_bf16(pa, __builtin_bit_cast(bf16x8, wv), Y[dt], 0, 0, 0); } }
        asm volatile("" ::: "memory");
    }
#pragma unroll 1
    for (int d = 0; d < 2; ++d) {
        const float qd = d == 0 ? exp2f(lg0 * (float)(n + 1)) : exp2f(lg1 * (float)(128 - n));
        const bf16* S = (const bf16*)(F.ws + WS_H) + ((size_t)((b * 4 + h) * NCH + g) * 2 + d) * 16384;
#pragma unroll
        for (int ks = 0; ks < 8; ++ks) { const bf16x8 qs = scale_frag(qf[ks], qd);
#pragma unroll
            for (int dt = 0; dt < 2; ++dt) { const bf16x8 sf = *(const bf16x8*)(S + (size_t)(64 * ch + 32 * dt + r32) * 128 + 16 * ks + 8 * hi);
                Y[dt] = __builtin_amdgcn_mfma_f32_32x32x16_bf16(qs, sf, Y[dt], 0, 0, 0); }
            asm volatile("" ::: "memory"); }
    }
#pragma unroll
    for (int dt = 0; dt < 2; ++dt)
#pragma unroll
        for (int r = 0; r < 16; ++r) YS[(32 * rb + (r & 3) + 8 * (r >> 2) + 4 * hi) * 132 + 64 * ch + 32 * dt + r32] = Y[dt][r];
    __syncthreads();
    bf16* MIX = (bf16*)(F.ws + WS_MIX0);
    const float g0 = A.in[I_RNORMG][h * 128 + 2 * F.lane], g1 = A.in[I_RNORMG][h * 128 + 2 * F.lane + 1];
#pragma unroll 4
    for (int i = 0; i < 16; ++i) { const int row = 16 * F.wave + i; const f32x2v y = *(const LAS f32x2v*)(YS + row * 132 + 2 * F.lane);
        const float rs = rsqrtf(wave_sum_shfl(y.x * y.x + y.y * y.y) * (1.f / 128.f) + NORM_EPS);
        const unsigned gw2 = *(const unsigned*)(P + (size_t)row * E_IN + 1536 + h * 128 + 2 * F.lane);
        const float ga = __uint_as_float(gw2 << 16), gb = __uint_as_float(gw2 & 0xffff0000u);
        *(unsigned*)(MIX + (size_t)(r0 + row) * D + h * 128 + 2 * F.lane) = pk2_sw(y.x * rs * g0 * siluf_(ga), y.y * rs * g1 * siluf_(gb)); }
    __syncthreads();
}

__device__ __forceinline__ void attn0_unit(const Frame& F, int unit) {
    const att::bf16* P = (const att::bf16*)(F.ws + WS_PRJ0); att::bf16* MIX = (att::bf16*)(F.ws + WS_MIX0);
    int b, qh, qrow0, seq;
    if (unit < 256) { b = unit >> 7; qh = (unit >> 5) & 3; qrow0 = b * TP + CT + (unit & 31) * 256; seq = TP; }
    else { const int u = unit - 256; b = u >> 2; qh = u & 3; qrow0 = b * TP; seq = CT; }
    const int kvh = qh >> 1;
    att::attn_dense_body<E_IN, E_IN, D, 8>(P + (size_t)qrow0 * E_IN + 2048 + qh * 128, P + (size_t)b * TP * E_IN + 2560 + kvh * 128, P + (size_t)b * TP * E_IN + 2816 + kvh * 128,
                                        MIX + (size_t)qrow0 * D + 512 + qh * 128, seq, F.ldsg, 0);
    __syncthreads();
}
__device__ __forceinline__ void attn1_unit(const Frame& F, int unit) {
    const int half = unit & 1, u2 = unit >> 1, b = u2 >> 8, h = (u2 >> 6) & 3, qb = u2 & 63;
    const att::bf16* KV = (const att::bf16*)(F.ws + WS_KV1) + (size_t)(b * TP + half * (TP / 2)) * 1024;
    const size_t qoff = (size_t)(b * SL + qb * 128) * 1024 + (2 * h) * 128;
    att::attn_dense_body<1024, 1024, 1024, 4, true, true>((const att::bf16*)(F.ws + WS_QD) + qoff, KV + h * 128, KV + 512 + h * 128, (att::bf16*)(F.ws + (half ? WS_OB2 : WS_OB)) + qoff, TP / 2, F.ldsg, 0,
                                                    (float*)(F.ws + WS_ASTAT) + (size_t)unit * 512);
    __syncthreads();
}

__device__ __forceinline__ void p13_prep1(const Frame& F, const Args& A) {
    const int l = F.lane; unsigned char* ws = F.ws;
    bf16* KV = (bf16*)(ws + WS_KV1); const bf16* RWQ = (const bf16*)(ws + WS_RWQ); bf16* QD = (bf16*)(ws + WS_QD); bf16* LIN = (bf16*)(ws + WS_LIN);
    bf16* SR = (bf16*)(ws + WS_SCAN + SA_R * SCAN_ARR); bf16* SV = (bf16*)(ws + WS_SCAN + SA_V * SCAN_ARR); bf16* SAN = (bf16*)(ws + WS_SCAN + SA_AN * SCAN_ARR); bf16* SK = (bf16*)(ws + WS_SCAN + SA_K * SCAN_ARR);
    const float* mu = A.in[I_RMU];
    float kkg[8];
#pragma unroll
    for (int e = 0; e < 8; ++e) kkg[e] = A.in[I_RKK][8 * l + e];
    float mu8[4][8];
#pragma unroll
    for (int j = 0; j < 4; ++j)
#pragma unroll
        for (int e = 0; e < 8; ++e) mu8[j][e] = ((j < 3) || (l < 48)) ? mu[8 * l + 512 * j + e] : 0.f;
    for (int r = F.gw; r < MR; r += F.NGW) {
        const int b = r / TP, p = r % TP; const bool lat = p >= CT;
        const bf16* row = RWQ + (size_t)r * 2560;
        if (lat) {
            float cs[8], sn[8]; rope_cs<32>(l, p - CT, cs, sn); const bool first = (l & 4) == 0; float v[8];
            unpack8(ldnt((const v4u*)(row + 8 * l)), v); rope_apply<4>(v, cs, sn, first);
#pragma unroll
            for (int e = 0; e < 8; ++e) v[e] *= 1.41421356237f;
            { const int qh = l >> 3, m = qh & 1; bf16* q = QD + (size_t)(b * SL + p - CT) * 1024 + qh * 128;
              *(v4u*)(q + m * 64 + 8 * (l & 7)) = pack8(v); *(v4u*)(q + (1 - m) * 64 + 8 * (l & 7)) = (v4u){0u, 0u, 0u, 0u}; }
            bf16* kr = KV + (size_t)r * 1024 + 8 * l; unpack8(*(const v4u*)kr, v); rope_apply<4>(v, cs, sn, first); *(v4u*)kr = pack8(v);
        }
        const bool hasp = lat ? (p > CT) : (p > 0), hasn = lat ? (p < TP - 1) : (p < CT - 1);
        float pv[4][8];
#pragma unroll
        for (int j = 0; j < 4; ++j) {
            const int c = 8 * l + 512 * j; const bool on = (j < 3) || (l < 48);
            float x[8], xp[8], xn[8];
#pragma unroll
            for (int e = 0; e < 8; ++e) { x[e] = 0.f; xp[e] = 0.f; xn[e] = 0.f; }
            if (on) { unpack8(*(const v4u*)(row + 512 + c), x); if (hasp) unpack8(*(const v4u*)(row - 2560 + 512 + c), xp); if (hasn) unpack8(*(const v4u*)(row + 2560 + 512 + c), xn); }
#pragma unroll
            for (int e = 0; e < 8; ++e) pv[j][e] = x[e] + mu8[j][e] * (0.5f * (xp[e] + xn[e]) - x[e]);
        }
        const size_t so = (size_t)r * 512 + 8 * l;
        stnt((v4u*)(SR + so), pack8(pv[0])); stnt((v4u*)(SK + so), pack8(pv[1])); stnt((v4u*)(SV + so), pack8(pv[2]));
        { float kk[8]; float ss = 0.f;
#pragma unroll
          for (int e = 0; e < 8; ++e) { kk[e] = pv[1][e] * kkg[e]; ss += kk[e] * kk[e]; }
          ss = sum8(ss);
          const float inv = -1.0f / fmaxf(sqrtf(ss), 1e-12f);
#pragma unroll
          for (int e = 0; e < 8; ++e) kk[e] *= inv;
          stnt((v4u*)(SAN + so), pack8(kk)); }
        if (l < 48) { float o[8];
#pragma unroll
            for (int e = 0; e < 8; ++e) o[e] = l < 16 ? 1.0f - 2.0f * __builtin_amdgcn_rcpf(1.0f + __builtin_amdgcn_exp2f(2.88539008178f * pv[3][e])) : (l < 32 ? pv[3][e] : sigmoidf_(pv[3][e]));
            stnt((v4u*)(LIN + (size_t)r * 384 + 8 * l), pack8(o)); }
    }
}

template <int NB_> __device__ __forceinline__ void mg_batch(const bf16* ap, const bf16* bp, f32x4& c) {
    bf16x8 a[NB_], b[NB_];
#pragma unroll
    for (int j = 0; j < NB_; ++j) { a[j] = *(const bf16x8*)(ap + 32 * j); b[j] = *(const bf16x8*)(bp + 32 * j); }
#pragma unroll
    for (int j = 0; j < NB_; ++j) c = __builtin_amdgcn_mfma_f32_16x16x32_bf16(a[j], b[j], c, 0, 0, 0);
}
template <class Epi> __device__ __forceinline__ void mini_gemm_ctx(const Frame& F, const bf16* Abase, int lda, const bf16* Wt, int K, int ncs, int first_wg, const Epi& E) {
    const int NP = 32 * ncs, r = F.lane & 15, kq = F.lane >> 4;
    int Kr = K; asm volatile("" : "+s"(Kr));
#ifndef MINI_REP
#define MINI_REP 1
#endif
    for (int rep = 0; rep < MINI_REP; ++rep)
    for (int p = ((int)blockIdx.x - first_wg + F.G) % F.G; p < NP; p += F.G) {
        const int rs = p & 31, cs = p >> 5, r0 = (rs >> 4) * TP + (rs & 15) * 16;
        const bf16* ap = Abase + (size_t)(r0 + r) * lda + 8 * kq;
        const bf16* bp = Wt + (size_t)(128 * cs + 16 * F.wave + r) * K + 8 * kq;
        f32x4 c = {0.f, 0.f, 0.f, 0.f};
        int k = 0;
#pragma unroll 1
        for (; k + 512 <= Kr; k += 512) { mg_batch<16>(ap + k, bp + k, c); __builtin_amdgcn_sched_barrier(0); }
        if (k < Kr) mg_batch<8>(ap + k, bp + k, c);
        const int col = 128 * cs + 16 * F.wave + r;
#pragma unroll
        for (int j = 0; j < 4; ++j) E.elem(r0 + 4 * kq + j, col, c[j], 0.f);
    }
}
struct MStore { bf16* O; int ldc; __device__ __forceinline__ void elem(int row, int col, float v, float) const { O[(size_t)row * ldc + col] = (bf16)f2bf(v); } };
struct MSwiglu { bf16* O; int ldc; __device__ __forceinline__ void elem(int row, int col, float g, float u) const { O[(size_t)row * ldc + col] = (bf16)f2bf(siluf_(g) * u); } };
struct MSplit1 { bf16* KV; bf16* RWQ; __device__ __forceinline__ void elem(int row, int col, float v, float) const {
    if (col >= 512 && col < 1536) KV[(size_t)row * 1024 + col - 512] = (bf16)f2bf(v); else RWQ[(size_t)row * 2560 + (col < 512 ? col : col - 1024)] = (bf16)f2bf(v); } };
struct MLora { bf16* base; const float* w0; const float* a0;
    __device__ __forceinline__ void elem(int row, int col, float v, float) const { const int blk = col >> 9, c = col & 511;
        const int arr = blk == 0 ? SA_L0 : blk == 1 ? SA_L1 : blk == 2 ? SA_A0 : blk == 3 ? SA_A1 : SA_G;
        float o = v; if (blk < 2) o = sigmoidf_(v + w0[blk * 512 + c]) * (0.60653065971f * 1.44269504089f); else if (blk < 4) o = sigmoidf_(v + a0[(blk - 2) * 512 + c]);
        ((bf16*)((unsigned char*)base + (size_t)arr * SCAN_ARR))[(size_t)row * 512 + c] = (bf16)f2bf(o); } };

__device__ __forceinline__ float dpp_add16(float x) {
    x += __builtin_bit_cast(float, __builtin_amdgcn_update_dpp(0, __builtin_bit_cast(int, x), 0xB1, 0xF, 0xF, true));
    x += __builtin_bit_cast(float, __builtin_amdgcn_update_dpp(0, __builtin_bit_cast(int, x), 0x4E, 0xF, 0xF, true));
    x += __builtin_bit_cast(float, __builtin_amdgcn_update_dpp(0, __builtin_bit_cast(int, x), 0x141, 0xF, 0xF, true));
    x += __builtin_bit_cast(float, __builtin_amdgcn_update_dpp(0, __builtin_bit_cast(int, x), 0x140, 0xF, 0xF, true));
    return x;
}
constexpr int SC_TOK = 32, SC_STRIDE = 336;
constexpr int SC_BUF = SC_TOK * SC_STRIDE;
constexpr int SC_YOFF = 2 * SC_BUF;
__device__ __forceinline__ int scan_row(int b, int d, int i) { return b * TP + (d == 0 ? i : (i < CT ? CT - 1 - i : CT + (TP - 1 - i))); }
struct ScanOps { f32x4 w, a, b, k, r; float v; };
__device__ __forceinline__ float dot4(const f32x4 s, const f32x4 a) { f32x2v p = (f32x2v){s[0], s[1]} * (f32x2v){a[0], a[1]}; p = __builtin_elementwise_fma((f32x2v){s[2], s[3]}, (f32x2v){a[2], a[3]}, p); return p.x + p.y; }
template <int DIR, int NREP> __device__ __forceinline__ void rwkv_scan(const Frame& F, const Args& A, int sid) {
    const int b = sid >> 5, h = (sid >> 2) & 7, q = sid & 3;
    unsigned char* ws = F.ws;
    const bf16* aL = (const bf16*)(ws + WS_SCAN + (size_t)(DIR ? SA_L1 : SA_L0) * SCAN_ARR); const bf16* aAN = (const bf16*)(ws + WS_SCAN + (size_t)SA_AN * SCAN_ARR);
    const bf16* aA = (const bf16*)(ws + WS_SCAN + (size_t)(DIR ? SA_A1 : SA_A0) * SCAN_ARR); const bf16* aK = (const bf16*)(ws + WS_SCAN + (size_t)SA_K * SCAN_ARR);
    const bf16* aR = (const bf16*)(ws + WS_SCAN + (size_t)SA_R * SCAN_ARR); const bf16* aV = (const bf16*)(ws + WS_SCAN + (size_t)SA_V * SCAN_ARR);
    bf16* YO = (bf16*)(ws + WS_YS) + (size_t)DIR * ML * 512;
    LAS float* buf = (LAS float*)F.lds;
    constexpr int NCHK = TP / SC_TOK;
    if (F.wave >= 4) {
        const int st = F.tid - 256, stok = st >> 3, sc8 = 8 * (st & 7), vtok = st >> 1, vc8 = 8 * (st & 1);
        float ka8[8];
#pragma unroll
        for (int e = 0; e < 8; ++e) ka8[e] = A.in[I_RKA][h * 64 + sc8 + e];
        v4u sr[6];
#define SC_LOAD(ch) do { const size_t ro = (size_t)scan_row(b, DIR, (ch) * SC_TOK + stok) * 512 + h * 64 + sc8; \
            sr[0] = *(const v4u*)(aL + ro); sr[1] = *(const v4u*)(aAN + ro); sr[2] = *(const v4u*)(aA + ro); sr[3] = *(const v4u*)(aK + ro); sr[4] = *(const v4u*)(aR + ro); \
            if (st < 64) sr[5] = *(const v4u*)(aV + (size_t)scan_row(b, DIR, (ch) * SC_TOK + vtok) * 512 + h * 64 + 16 * q + vc8); } while (0)
#define SC_ST8(dst, f) do { *(LAS f32x4*)(dst) = (f32x4){f[0], f[1], f[2], f[3]}; *(LAS f32x4*)((dst) + 4) = (f32x4){f[4], f[5], f[6], f[7]}; } while (0)
#define SC_WRITE(bi) do { LAS float* tb_ = buf + (bi) * SC_BUF + stok * SC_STRIDE + sc8; \
            float fl[8], fn[8], fa[8], fk[8], fr[8], o[8]; unpack8(sr[0], fl); unpack8(sr[1], fn); unpack8(sr[2], fa); unpack8(sr[3], fk); unpack8(sr[4], fr); \
            _Pragma("unroll") for (int e = 0; e < 8; ++e) o[e] = __builtin_amdgcn_exp2f(-fl[e]); SC_ST8(tb_, o); SC_ST8(tb_ + 64, fn); \
            _Pragma("unroll") for (int e = 0; e < 8; ++e) o[e] = -fn[e] * fa[e]; SC_ST8(tb_ + 128, o); \
            _Pragma("unroll") for (int e = 0; e < 8; ++e) o[e] = fk[e] * (1.0f + (fa[e] - 1.0f) * ka8[e]); SC_ST8(tb_ + 192, o); SC_ST8(tb_ + 256, fr); \
            if (st < 64) { float fv[8]; unpack8(sr[5], fv); SC_ST8(buf + (bi) * SC_BUF + vtok * SC_STRIDE + 320 + vc8, fv); } } while (0)
        for (int rep = 0; rep < NREP; ++rep) {
        SC_LOAD(0); SC_WRITE(0); SC_LOAD(1);
        __syncthreads();
        for (int ch = 0; ch < NCHK; ++ch) {
            if (ch + 1 < NCHK) SC_WRITE((ch + 1) & 1);
            if (ch + 2 < NCHK) SC_LOAD(ch + 2);
            if (ch >= 1 && (ch - 1) * SC_TOK >= CT) { const int i = (ch - 1) * SC_TOK + stok, lt = DIR == 0 ? i - CT : (TP - 1 - i);
                const f32x2v y = *(const LAS f32x2v*)(buf + SC_YOFF + ((ch - 1) & 1) * (SC_TOK * 16) + stok * 16 + 2 * (st & 7));
                *(unsigned*)(YO + (size_t)(b * SL + lt) * 512 + h * 64 + 16 * q + 2 * (st & 7)) = pk2(y.x, y.y); }
            __syncthreads();
        }
        { const int i = (NCHK - 1) * SC_TOK + stok, lt = DIR == 0 ? i - CT : (TP - 1 - i);
          const f32x2v y = *(const LAS f32x2v*)(buf + SC_YOFF + ((NCHK - 1) & 1) * (SC_TOK * 16) + stok * 16 + 2 * (st & 7));
          *(unsigned*)(YO + (size_t)(b * SL + lt) * 512 + h * 64 + 16 * q + 2 * (st & 7)) = pk2(y.x, y.y); }
        __syncthreads();
        }
#undef SC_LOAD
#undef SC_WRITE
#undef SC_ST8
    } else {
        const int rowl = F.wave * 4 + (F.lane >> 4), ks = F.lane & 15;
#define SC_RD(X, p) do { X.w = *(const LAS f32x4*)((p) + 4 * ks); X.a = *(const LAS f32x4*)((p) + 64 + 4 * ks); X.b = *(const LAS f32x4*)((p) + 128 + 4 * ks); \
            X.k = *(const LAS f32x4*)((p) + 192 + 4 * ks); X.r = *(const LAS f32x4*)((p) + 256 + 4 * ks); X.v = (p)[320 + rowl]; } while (0)
#define SC_STEP(X, yp) do { float sa = dot4(s, X.a); float yo = DIR ? dot4(s, X.r) : 0.f; sa = dpp_add16(sa); \
            s = s * X.w + X.b * sa + X.k * X.v; if (!DIR) yo = dot4(s, X.r); yo = dpp_add16(yo); *(yp) = yo; } while (0)
        for (int rep = 0; rep < NREP; ++rep) {
        f32x4 s = {0.f, 0.f, 0.f, 0.f};
        __syncthreads();
        for (int ch = 0; ch < NCHK; ++ch) {
            const LAS float* tb = buf + (ch & 1) * SC_BUF; LAS float* yb = buf + SC_YOFF + (ch & 1) * (SC_TOK * 16) + rowl;
            ScanOps XA, XB; SC_RD(XA, tb);
#pragma unroll 2
            for (int t = 0; t < SC_TOK; t += 2) {
                SC_RD(XB, tb + SC_STRIDE); SC_STEP(XA, yb);
                SC_RD(XA, tb + 2 * SC_STRIDE); SC_STEP(XB, yb + 16);
                tb += 2 * SC_STRIDE; yb += 32;
            }
            __syncthreads();
        }
        __syncthreads();
        }
#undef SC_RD
#undef SC_STEP
    }
}
__device__ __forceinline__ void p15_finish1(const Frame& F, const Args& A) {
    const int l = F.lane; unsigned char* ws = F.ws;
    const bf16* OB = (const bf16*)(ws + WS_OB); const bf16* OB2 = (const bf16*)(ws + WS_OB2); const float* AST = (const float*)(ws + WS_ASTAT); const bf16* Y0 = (const bf16*)(ws + WS_YS); const bf16* Y1 = Y0 + (size_t)ML * 512; bf16* MIX = (bf16*)(ws + WS_H);
    const bf16* SR = (const bf16*)(ws + WS_SCAN + SA_R * SCAN_ARR); const bf16* SV = (const bf16*)(ws + WS_SCAN + SA_V * SCAN_ARR); const bf16* SK = (const bf16*)(ws + WS_SCAN + SA_K * SCAN_ARR); const bf16* SG = (const bf16*)(ws + WS_SCAN + SA_G * SCAN_ARR);
    const float* lv = A.in[I_DLAM];
    const float lam = __expf(wave_sum(lv[l] * lv[64 + l])) - __expf(wave_sum(lv[128 + l] * lv[192 + l])) + LAM_INIT;
    float sg[8], rk[8], lg[8], lb[8];
#pragma unroll
    for (int e = 0; e < 8; ++e) { sg[e] = A.in[I_DSUBG][8 * (l & 15) + e] * (1.0f - LAM_INIT); rk[e] = A.in[I_RRK][8 * l + e]; lg[e] = A.in[I_RLNG][8 * l + e]; lb[e] = A.in[I_RLNB][8 * l + e]; }
    for (int t = F.gw; t < ML; t += F.NGW) {
        const int b = t / SL, r = b * TP + CT + (t % SL);
#pragma unroll
        for (int j = 0; j < 2; ++j) {
            float o[8], o2[8]; unpack8(ldnt((const v4u*)(OB + (size_t)t * 1024 + 512 * j + 8 * l)), o); unpack8(ldnt((const v4u*)(OB2 + (size_t)t * 1024 + 512 * j + 8 * l)), o2);
            { const int qh = (l >> 4) + 4 * j, tl = t % SL; const size_t u0 = ((size_t)((b * 4 + (qh >> 1)) * 64 + (tl >> 7)) * 2) * 512 + ((qh & 1) * 128 + (tl & 127)) * 2;
              const f32x2v s1 = *(const f32x2v*)(AST + u0), s2 = *(const f32x2v*)(AST + u0 + 512);
              const float M = fmaxf(s1.x, s2.x); const float w1 = s1.y * exp2f((s1.x - M) * 0.12751743f), w2 = s2.y * exp2f((s2.x - M) * 0.12751743f), inv = 1.0f / (w1 + w2);
#pragma unroll
              for (int e = 0; e < 8; ++e) o[e] = (o[e] * w1 + o2[e] * w2) * inv; }
            float ss = 0.f;
#pragma unroll
            for (int e = 0; e < 8; ++e) { const float oo = __shfl_xor(o[e], 16); o[e] = o[e] - lam * oo; ss += o[e] * o[e]; }
            ss = sum16(ss);
            const float rs = rsqrtf(ss * (1.f / 128.f) + NORM_EPS);
#pragma unroll
            for (int e = 0; e < 8; ++e) o[e] = o[e] * rs * sg[e];
            if ((l & 16) == 0) stnt((v4u*)(MIX + (size_t)r * D + ((l >> 5) + 2 * j) * 128 + 8 * (l & 15)), pack8(o));
        }
        { float y0[8], y1[8], rr[8], kk[8], vv[8], gg[8];
          unpack8(ldnt((const v4u*)(Y0 + (size_t)t * 512 + 8 * l)), y0); unpack8(ldnt((const v4u*)(Y1 + (size_t)t * 512 + 8 * l)), y1);
          unpack8(ldnt((const v4u*)(SR + (size_t)r * 512 + 8 * l)), rr); unpack8(ldnt((const v4u*)(SK + (size_t)r * 512 + 8 * l)), kk); unpack8(ldnt((const v4u*)(SV + (size_t)r * 512 + 8 * l)), vv); unpack8(ldnt((const v4u*)(SG + (size_t)r * 512 + 8 * l)), gg);
          float sm = 0.f, bs = 0.f;
#pragma unroll
          for (int e = 0; e < 8; ++e) { y0[e] += y1[e]; sm += y0[e]; bs += rr[e] * kk[e] * rk[e]; }
          sm = sum8(sm); bs = sum8(bs);
          const float mean = sm * (1.f / 64.f); float vs = 0.f;
#pragma unroll
          for (int e = 0; e < 8; ++e) { y0[e] -= mean; vs += y0[e] * y0[e]; }
          vs = sum8(vs);
          const float rs = rsqrtf(vs * (1.f / 64.f) + RWKV_LN_EPS);
#pragma unroll
          for (int e = 0; e < 8; ++e) y0[e] = ((y0[e] * rs * lg[e] + lb[e]) + bs * vv[e]) * gg[e];
          stnt((v4u*)(MIX + (size_t)r * D + 512 + 8 * l), pack8(y0)); }
    }
}
__device__ __forceinline__ void route_row(const Frame& F, const Args& A, int t, const RowYX& R, ModRegs& M) {
    bf16* H2 = (bf16*)(F.ws + WS_H2);
    {
        f32x4 h[4]; mod_load(F, A, M, t / SL, 1, 0);
        resid_norm_m(F, R, M, A.out + (size_t)t * D, H2 + (size_t)t * D, h);
        float lg[8];
        const LAS float* RL = (const LAS float*)(F.lds + 1024);
#pragma unroll
        for (int e = 0; e < 8; ++e) { float s = 0.f;
#pragma unroll
            for (int j = 0; j < 4; ++j) { const f32x4 rw = *(const LAS f32x4*)(RL + e * 1024 + 4 * F.lane + 256 * j); s += (h[j][0] * rw[0] + h[j][1] * rw[1]) + (h[j][2] * rw[2] + h[j][3] * rw[3]); }
            lg[e] = s; }
#pragma unroll
        for (int e = 0; e < 8; ++e) lg[e] = wave_sum(lg[e]);
        int e0 = 0; float l0 = lg[0];
#pragma unroll
        for (int e = 1; e < 8; ++e) if (lg[e] > l0) { l0 = lg[e]; e0 = e; }
        int e1 = -1; float l1 = -3.0e38f;
#pragma unroll
        for (int e = 0; e < 8; ++e) if (e != e0 && lg[e] > l1) { l1 = lg[e]; e1 = e; }
        if (F.lane == 0) {
            const float w0 = __builtin_amdgcn_rcpf(1.0f + __expf(l1 - l0));
            LAS unsigned* lc = (LAS unsigned*)(F.lds + 64);
            const unsigned p0 = __hip_atomic_fetch_add(lc + e0, 1u, __ATOMIC_RELAXED, __HIP_MEMORY_SCOPE_WORKGROUP), p1 = __hip_atomic_fetch_add(lc + e1, 1u, __ATOMIC_RELAXED, __HIP_MEMORY_SCOPE_WORKGROUP);
            int* rec = (int*)(F.ws + WS_ROUTE) + (size_t)t * 8; rec[0] = e0; rec[1] = e1; rec[2] = (int)p0; rec[3] = (int)p1; ((float*)rec)[4] = w0; ((float*)rec)[5] = 1.0f - w0;
        }
    }
}
__device__ __forceinline__ void p17_route(const Frame& F, const Args& A) {
    const bf16* XR = (const bf16*)(F.ws + WS_XR); const bf16* Y = (const bf16*)(F.ws + WS_Y1);
    LAS unsigned* lc = (LAS unsigned*)(F.lds + 64); LAS unsigned* lb = (LAS unsigned*)(F.lds + 128);
    ModRegs M; M.cur = -1;
    if (F.tid < 8) lc[F.tid] = 0u;
    { LAS float* RL = (LAS float*)(F.lds + 1024); const float* RT = A.in[I_MROUTER];
      for (int i = F.tid; i < 8192; i += NWAVES * 64) RL[(i & 7) * 1024 + (i >> 3)] = RT[i]; }
    __syncthreads();
    for (int t = F.gw; t < ML; t += 2 * F.NGW) {
        const int t2 = t + F.NGW; const bool two = t2 < ML; const int tb = two ? t2 : t; RowYX Ra, Rb;
        const size_t ra = (size_t)((t / SL) * TP + CT + (t % SL)) * D, rb = (size_t)((tb / SL) * TP + CT + (tb % SL)) * D;
        load_yxb(F, Y + ra, XR + ra, Ra); load_yxb(F, Y + rb, XR + rb, Rb);
        route_row(F, A, t, Ra, M); if (two) route_row(F, A, t2, Rb, M);
    }
    asm volatile("s_waitcnt vmcnt(0) lgkmcnt(0)" ::: "memory");
    __syncthreads();
    if (F.tid < 8) lb[F.tid] = __hip_atomic_fetch_add((unsigned*)(F.ctl + CW_CNT + 64 * F.tid), lc[F.tid], RLX_AGENT);
    __syncthreads();
    for (int t = F.gw; t < ML; t += F.NGW) if (F.lane == 0) {
        int* rec = (int*)(F.ws + WS_ROUTE) + (size_t)t * 8; const int e0 = rec[0], e1 = rec[1]; rec[2] += (int)lb[e0]; rec[3] += (int)lb[e1]; }
    __syncthreads();
}
__device__ __forceinline__ int moe_offsets(const Frame& F, int (&off)[NE + 1]) {
    int o = 0;
#pragma unroll
    for (int e = 0; e < NE; ++e) { off[e] = o; const int c = (int)__hip_atomic_load((unsigned*)(F.ctl + CW_CNT + 64 * e), RLX_AGENT); o += ((c + 255) >> 8) << 8; }
    off[NE] = o; return o >> 8;
}
__device__ __forceinline__ void p18_gather(const Frame& F, const Args& A) {
    int off[NE + 1]; const int nT = moe_offsets(F, off);
    if (blockIdx.x == 0 && F.tid < 256) { int e = 0;
#pragma unroll
        for (int k = 1; k < NE; ++k) if (F.tid * 256 >= off[k]) e = k;
        ((int*)(F.ws + WS_TILEE))[F.tid] = (F.tid < nT) ? e : 0; }
    const bf16* H2 = (const bf16*)(F.ws + WS_H2); bf16* AG = (bf16*)(F.ws + WS_AG);
    for (int t = F.gw; t < ML; t += F.NGW) {
        const int* rec = (const int*)(F.ws + WS_ROUTE) + (size_t)t * 8; const int e0 = rec[0], e1 = rec[1], p0 = rec[2], p1 = rec[3];
        int o0 = 0, o1 = 0;
#pragma unroll
        for (int k = 0; k < NE; ++k) { if (k == e0) o0 = off[k]; if (k == e1) o1 = off[k]; }
        const v4u a = ldnt((const v4u*)(H2 + (size_t)t * D + 8 * F.lane)), c = ldnt((const v4u*)(H2 + (size_t)t * D + 512 + 8 * F.lane));
        bf16* d0 = AG + (size_t)(o0 + p0) * D; bf16* d1 = AG + (size_t)(o1 + p1) * D;
        *(v4u*)(d0 + 8 * F.lane) = a; *(v4u*)(d0 + 512 + 8 * F.lane) = c; *(v4u*)(d1 + 8 * F.lane) = a; *(v4u*)(d1 + 512 + 8 * F.lane) = c;
    }
    moe_weights(F, A);
}
struct FinIn { f32x4 a[4], bq[4], o[4]; float w0, w1; };
__device__ __forceinline__ void fin_load(const Frame& F, const Args& A, int t, const int (&off)[NE + 1], FinIn& I) {
    const bf16* Y2 = (const bf16*)(F.ws + WS_AG);
    const int* rec = (const int*)(F.ws + WS_ROUTE) + (size_t)t * 8; const int e0 = rec[0], e1 = rec[1], p0 = rec[2], p1 = rec[3]; I.w0 = ((const float*)rec)[4]; I.w1 = ((const float*)rec)[5];
    int o0 = 0, o1 = 0;
#pragma unroll
    for (int k = 0; k < NE; ++k) { if (k == e0) o0 = off[k]; if (k == e1) o1 = off[k]; }
    const int ra = o0 + p0, rb = o1 + p1; const float* YF = (const float*)(F.ws + WS_Y2F);
    const bf16* ya = Y2 + (size_t)ra * D; const bf16* yb = Y2 + (size_t)rb * D; const float* o = A.out + (size_t)t * D;
#pragma unroll
    for (int j = 0; j < 4; ++j) { const int c = 4 * F.lane + 256 * j;
        if (ra < 32768 || F.G != 256) I.a[j] = ld_bf4_nt(ya + c); else { const float* q = YF + (size_t)(ra - 32768) * D + c; I.a[j] = ((*(const f32x4*)q + *(const f32x4*)(q + 2048 * D)) + *(const f32x4*)(q + 2 * 2048 * D)) + *(const f32x4*)(q + 3 * 2048 * D); }
        if (rb < 32768 || F.G != 256) I.bq[j] = ld_bf4_nt(yb + c); else { const float* q = YF + (size_t)(rb - 32768) * D + c; I.bq[j] = ((*(const f32x4*)q + *(const f32x4*)(q + 2048 * D)) + *(const f32x4*)(q + 2 * 2048 * D)) + *(const f32x4*)(q + 3 * 2048 * D); }
        I.o[j] = ldnt((const f32x4*)(o + c)); }
}
__device__ __forceinline__ void fin_row(const Frame& F, const Args& A, int t, const FinIn& I) {
    const float* ng = A.in[I_NORMG] + (4 + 3) * D; const int b = t / SL, r = b * TP + CT + (t % SL); const float* mv = modv(F, 1, r) + 5 * 1024;
    f32x4 m[4]; float ss = 0.f;
#pragma unroll
    for (int j = 0; j < 4; ++j) { m[j] = I.a[j] * I.w0 + I.bq[j] * I.w1; ss += sq4(m[j]); }
    const float rs = rsqrtf(wave_sum(ss) * (1.f / D) + NORM_EPS);
    float* o = A.out + (size_t)t * D;
#pragma unroll
    for (int j = 0; j < 4; ++j) { const int c = 4 * F.lane + 256 * j; stnt((f32x4*)(o + c), I.o[j] + *(const f32x4*)(mv + c) * (m[j] * rs * *(const f32x4*)(ng + c))); }
}
__device__ __forceinline__ void p21_final(const Frame& F, const Args& A) {
    int off[NE + 1]; (void)moe_offsets(F, off);
    for (int t = F.gw; t < ML; t += 2 * F.NGW) {
        const int t2 = t + F.NGW; const bool two = t2 < ML; FinIn Ia, Ib;
        fin_load(F, A, t, off, Ia); fin_load(F, A, two ? t2 : t, off, Ib);
        fin_row(F, A, t, Ia); if (two) fin_row(F, A, t2, Ib);
    }
}

constexpr int CK_RS = 72, CK_ARR = 64 * CK_RS * 2;
constexpr int CK_AH = 0, CK_BH = CK_ARR, CK_KH = 2 * CK_ARR, CK_RH = 3 * CK_ARR, CK_BCT = 4 * CK_ARR, CK_KCT = 5 * CK_ARR + 128, CK_VT = 6 * CK_ARR + 256, CK_ZT = 7 * CK_ARR + 384,
              CK_NOFF = 9 * CK_ARR + 640, CK_MAK = 10 * CK_ARR + 640, CK_ARB = 11 * CK_ARR + 640, CK_ARK = 12 * CK_ARR + 640, CK_XT = 13 * CK_ARR + 640, CK_TT = 14 * CK_ARR + 640, CK_ND = CK_TT + 4 * 16 * 40 * 2,
              CK_WS = CK_ND + 4 * 16 * 17 * 4, CK_GAM = CK_WS + 8 * 16 * 40 * 2, CK_WT = CK_GAM + 256, CK_END = CK_WT + 8 * 64 * 4;
constexpr int CK_P0 = CK_AH, CK_RT = CK_BH;
static_assert(CK_END <= RING_BYTES, "chunked scan LDS");
__device__ __forceinline__ int trow(int f) { return f * CK_RS + (f >> 3) * 8; }
template <int KS, bool SA, bool SB> __device__ __forceinline__ void mm32s(f32x16& acc, const lbf16* A, const lbf16* B, int r32, int hi) {
    const int oa = r32 * CK_RS + (SA ? (r32 >> 3) * 8 : 0), ob = r32 * CK_RS + (SB ? (r32 >> 3) * 8 : 0);
#pragma unroll
    for (int ks = 0; ks < KS; ++ks) { const bf16x8 a = *(const LAS bf16x8*)(A + oa + 16 * ks + 8 * hi), bb = *(const LAS bf16x8*)(B + ob + 16 * ks + 8 * hi);
        acc = __builtin_amdgcn_mfma_f32_32x32x16_bf16(a, bb, acc, 0, 0, 0); }
}
template <int KS> __device__ __forceinline__ void mm32(f32x16& acc, const lbf16* A, const lbf16* B, int r32, int hi) {
#pragma unroll
    for (int ks = 0; ks < KS; ++ks) { const bf16x8 a = *(const LAS bf16x8*)(A + r32 * CK_RS + 16 * ks + 8 * hi), bb = *(const LAS bf16x8*)(B + r32 * CK_RS + 16 * ks + 8 * hi);
        acc = __builtin_amdgcn_mfma_f32_32x32x16_bf16(a, bb, acc, 0, 0, 0); }
}
__device__ __forceinline__ unsigned pk2h(float lo, float hi) { return pk2(lo, hi); }
__device__ __forceinline__ v4u pack8h(const float (&f)[8]) { v4u w; w.x = pk2h(f[0], f[1]); w.y = pk2h(f[2], f[3]); w.z = pk2h(f[4], f[5]); w.w = pk2h(f[6], f[7]); return w; }
#define CK_LDSFENCE() asm volatile("s_waitcnt lgkmcnt(0)" ::: "memory")
__device__ __forceinline__ void ck_precompute(const Frame& F, const Args& A) {
    constexpr int NCK = TP / 64, NITEM = 32 * NCK;
    unsigned char* ws = F.ws; LAS unsigned char* L = F.lds;
    const bf16* SC = (const bf16*)(ws + WS_SCAN);
    const int tid = F.tid, lane = F.lane, w = F.wave, r32 = lane & 31, hi = lane >> 5;
    const int tt = tid >> 3, pc = tid & 7;
    lbf16* AH = (lbf16*)(L + CK_AH); lbf16* BH = (lbf16*)(L + CK_BH); lbf16* KH = (lbf16*)(L + CK_KH); lbf16* RH = (lbf16*)(L + CK_RH);
    lbf16* BCT = (lbf16*)(L + CK_BCT); lbf16* KCT = (lbf16*)(L + CK_KCT); lbf16* VT = (lbf16*)(L + CK_VT); lbf16* ZT = (lbf16*)(L + CK_ZT);
    lbf16* NOFF = (lbf16*)(L + CK_NOFF); lbf16* MAK = (lbf16*)(L + CK_MAK); lbf16* ARB = (lbf16*)(L + CK_ARB); lbf16* ARK = (lbf16*)(L + CK_ARK);
    lbf16* XT = (lbf16*)(L + CK_XT); lbf16* TT = (lbf16*)(L + CK_TT); LAS float* ND = (LAS float*)(L + CK_ND); lbf16* WS = (lbf16*)(L + CK_WS) + w * 16 * 40;
    LAS float* GAM = (LAS float*)(L + CK_GAM); LAS float* WT = (LAS float*)(L + CK_WT); lbf16* P0 = (lbf16*)(L + CK_P0); lbf16* RT = (lbf16*)(L + CK_RT);
    for (int i = tid; i < (CK_ND - CK_TT) / 4; i += 512) ((LAS unsigned*)TT)[i] = 0u;
    for (int i = tid; i < 8 * 16 * 40 / 2; i += 512) ((LAS unsigned*)(L + CK_WS))[i] = 0u;
    v4u pl, pn, pa, pk, pr, pv;
#define CK_LOAD(it_) do { const int sd_ = (it_) / NCK, c_ = (it_) % NCK, d_ = sd_ & 1, s_ = sd_ >> 1; \
        const size_t ro = (size_t)scan_row(s_ >> 3, d_, c_ * 64 + tt) * 512 + (s_ & 7) * 64 + 8 * pc; const size_t SAE = SCAN_ARR / 2; \
        pl = *(const v4u*)(SC + (size_t)(d_ ? SA_L1 : SA_L0) * SAE + ro); pn = *(const v4u*)(SC + (size_t)SA_AN * SAE + ro); pa = *(const v4u*)(SC + (size_t)(d_ ? SA_A1 : SA_A0) * SAE + ro); \
        pk = *(const v4u*)(SC + (size_t)SA_K * SAE + ro); pr = *(const v4u*)(SC + (size_t)SA_R * SAE + ro); pv = *(const v4u*)(SC + (size_t)SA_V * SAE + ro); } while (0)
    const int it0 = (int)blockIdx.x;
    if (it0 < NITEM) CK_LOAD(it0);
    __syncthreads();
#ifdef PROBE_STAGE
    volatile LAS unsigned long long* ps_ = (volatile LAS unsigned long long*)(F.lds + MISC_OFF + 64); unsigned long long st_prev = rt(); int st_id = 0;
#define CK_STAMP() do { if (blockIdx.x == 0 && tid == 0) { const unsigned long long n_ = rt(); if (st_id == PROBE_STAGE) ps_[1] = ps_[1] + (n_ - st_prev); st_prev = n_; } ++st_id; } while (0)
#else
#define CK_STAMP() do {} while (0)
#endif
    for (int item = it0; item < NITEM; item += F.G) {
#ifdef PROBE_STAGE
        st_id = 0;
#endif
        const int sdir = item / NCK, c = item % NCK, DIR = sdir & 1, sid = sdir >> 1, h = sid & 7;
        float ka8[8];
#pragma unroll
        for (int e = 0; e < 8; ++e) ka8[e] = A.in[I_RKA][h * 64 + 8 * pc + e];
        float lam[8]; unpack8(pl, lam);
        float Lm[8];
#pragma unroll
        for (int e = 0; e < 8; ++e) { float x = lam[e]; float y = __shfl_up(x, 8); if (lane >= 8) x += y; y = __shfl_up(x, 16); if (lane >= 16) x += y; y = __shfl_up(x, 32); if (lane >= 32) x += y; Lm[e] = x; }
        if (lane >= 56) {
#pragma unroll
            for (int e = 0; e < 8; ++e) WT[w * 64 + 8 * pc + e] = Lm[e]; }
        __syncthreads(); CK_STAMP();
        {
            float off[8], tot[8];
#pragma unroll
            for (int e = 0; e < 8; ++e) { off[e] = 0.f; tot[e] = 0.f; }
#pragma unroll
            for (int w2 = 0; w2 < 8; ++w2) { const f32x4 x0 = *(const LAS f32x4*)(WT + w2 * 64 + 8 * pc), x1 = *(const LAS f32x4*)(WT + w2 * 64 + 8 * pc + 4);
#pragma unroll
                for (int e = 0; e < 4; ++e) { tot[e] += x0[e]; tot[4 + e] += x1[e]; if (w2 < w) { off[e] += x0[e]; off[4 + e] += x1[e]; } } }
            float an[8], ag[8], kk[8], rr[8]; unpack8(pn, an); unpack8(pa, ag); unpack8(pk, kk); unpack8(pr, rr);
            float ah[8], bh[8], kh[8], rh[8], bc[8], kc[8];
#pragma unroll
            for (int e = 0; e < 8; ++e) {
                const float Lt = Lm[e] + off[e], Lp = Lt - lam[e];
                const float em = __builtin_amdgcn_exp2f(-Lp), ep = __builtin_amdgcn_exp2f(Lt), ec = __builtin_amdgcn_exp2f(Lt - tot[e]), er = DIR ? em : __builtin_amdgcn_exp2f(-Lt);
                const float bb = -an[e] * ag[e], kd = kk[e] * (1.0f + (ag[e] - 1.0f) * ka8[e]);
                ah[e] = an[e] * em; bh[e] = bb * ep; kh[e] = kd * ep; rh[e] = rr[e] * er; bc[e] = bb * ec; kc[e] = kd * ec;
            }
            const v4u pah = pack8h(ah), pbc = pack8h(bc), pkc = pack8h(kc);
            *(LAS v4u*)(AH + tt * CK_RS + 8 * pc) = pah; *(LAS v4u*)(BH + tt * CK_RS + 8 * pc) = pack8h(bh);
            *(LAS v4u*)(KH + tt * CK_RS + 8 * pc) = pack8h(kh); *(LAS v4u*)(RH + tt * CK_RS + 8 * pc) = pack8h(rh);
#pragma unroll
            for (int e2 = 0; e2 < 4; ++e2) { const int kcol = 8 * pc + 2 * e2; const unsigned xa = pah[e2], xb = pbc[e2], xk = pkc[e2], xv = pv[e2];
                ZT[trow(kcol) + tt] = (unsigned short)xa; ZT[trow(kcol + 1) + tt] = (unsigned short)(xa >> 16);
                BCT[trow(kcol) + tt] = (unsigned short)xb; BCT[trow(kcol + 1) + tt] = (unsigned short)(xb >> 16);
                KCT[trow(kcol) + tt] = (unsigned short)xk; KCT[trow(kcol + 1) + tt] = (unsigned short)(xk >> 16);
                VT[trow(kcol) + tt] = (unsigned short)xv; VT[trow(kcol + 1) + tt] = (unsigned short)(xv >> 16); }
            if (tt == 63) {
#pragma unroll
                for (int e = 0; e < 8; ++e) ((float*)(ws + WS_CKGAM))[(size_t)item * 64 + 8 * pc + e] = __builtin_amdgcn_exp2f(-tot[e]); }
        }
        if (item + F.G < NITEM) CK_LOAD(item + F.G);
        __syncthreads(); CK_STAMP();
        {
            const int rt = w >> 1; const lbf16* Ap = (rt < 2 ? AH : RH) + (32 * (rt & 1)) * CK_RS;
#pragma unroll
            for (int q = 0; q < 2; ++q) {
                const int ct = 2 * (w & 1) + q, rbk = rt & 1; const lbf16* Bp = (ct < 2 ? BH : KH) + (32 * q) * CK_RS;
                const int i = 32 * q + r32;
                lbf16* dst = rt < 2 ? (ct < 2 ? NOFF : MAK) : (ct < 2 ? ARB : ARK);
                if (rbk < q) {
#pragma unroll
                    for (int r = 0; r < 16; ++r) dst[(32 * rbk + (r & 3) + 8 * (r >> 2) + 4 * hi) * CK_RS + i] = 0;
                } else {
                    f32x16 acc = {}; mm32<4>(acc, Ap, Bp, r32, hi);
                    if (rbk > q) {
#pragma unroll
                        for (int r = 0; r < 16; r += 2) { const unsigned x = pk2h(acc[r], acc[r + 1]); const int t = 32 * rbk + (r & 3) + 8 * (r >> 2) + 4 * hi;
                            dst[t * CK_RS + i] = (unsigned short)x; dst[(t + 1) * CK_RS + i] = (unsigned short)(x >> 16); }
                    } else {
#pragma unroll
                        for (int r = 0; r < 16; ++r) { const int t = 32 * rbk + (r & 3) + 8 * (r >> 2) + 4 * hi;
                            const bool keep = rt < 2 ? (t > i) : (DIR ? (t > i) : (t >= i)); float v = keep ? acc[r] : 0.f;
                            if (rt < 2 && ct < 2) { if ((t >> 4) == (i >> 4)) { ND[((t >> 4) * 16 + (t & 15)) * 17 + (i & 15)] = v; v = 0.f; } }
                            dst[t * CK_RS + i] = (unsigned short)pk2h(v, v); }
                    }
                }
            }
        }
        __syncthreads(); CK_STAMP();
        if (w < 4) {
            const int vt = w >> 1, t2 = w & 1; f32x16 acc = {}; mm32s<4, true, false>(acc, VT + trow(32 * vt), MAK + 32 * t2 * CK_RS, r32, hi);
#pragma unroll
            for (int r = 0; r < 16; ++r) ZT[trow(64 + 32 * vt + (r & 3) + 8 * (r >> 2) + 4 * hi) + 32 * t2 + r32] = (unsigned short)f2bf(acc[r]);
        } else if (w == 4) {
            const int blk = lane >> 4, j = lane & 15; float s[16];
#pragma unroll
            for (int t = 0; t < 16; ++t) s[t] = (t == j) ? 1.f : 0.f;
#pragma unroll
            for (int i = 0; i < 16; ++i) { const float ti = s[i]; TT[(blk * 16 + i) * 40 + j] = (unsigned short)f2bf(ti);
#pragma unroll
                for (int t = 0; t < 16; ++t) if (t > i) s[t] += ND[(blk * 16 + t) * 17 + i] * ti; }
        }
        __syncthreads(); CK_STAMP();
        {
            const int c16 = lane & 15, q4 = lane >> 4; const int zr0 = 16 * w;
#pragma unroll
            for (int I = 0; I < 4; ++I) {
                f32x4 acc;
#pragma unroll
                for (int j = 0; j < 4; ++j) acc[j] = bf2f(ZT[trow(zr0 + 4 * q4 + j) + 16 * I + c16]);
                if (I >= 1) {
#pragma unroll
                    for (int ks = 0; ks < (I == 3 ? 2 : 1); ++ks) {
                        const bf16x8 a = *(const LAS bf16x8*)(ZT + trow(zr0 + c16) + 32 * ks + 8 * q4), bb = *(const LAS bf16x8*)(NOFF + (16 * I + c16) * CK_RS + 32 * ks + 8 * q4);
                        acc = __builtin_amdgcn_mfma_f32_16x16x32_bf16(a, bb, acc, 0, 0, 0); } }
#pragma unroll
                for (int j = 0; j < 4; ++j) WS[(4 * q4 + j) * 40 + c16] = (unsigned short)f2bf(acc[j]);
                CK_LDSFENCE();
                const bf16x8 a2 = *(const LAS bf16x8*)(WS + c16 * 40 + 8 * q4), b2 = *(const LAS bf16x8*)(TT + (I * 16 + c16) * 40 + 8 * q4);
                f32x4 z = {0.f, 0.f, 0.f, 0.f}; z = __builtin_amdgcn_mfma_f32_16x16x32_bf16(a2, b2, z, 0, 0, 0);
#pragma unroll
                for (int j = 0; j < 4; ++j) ZT[trow(zr0 + 4 * q4 + j) + 16 * I + c16] = (unsigned short)f2bf(z[j]);
                CK_LDSFENCE();
            }
        }
        __syncthreads(); CK_STAMP();
        {
            const int u = w & 3, kpt = u >> 1, ot = u & 1; f32x16 acc = {};
            if (w < 4) mm32s<4, true, true>(acc, ZT + trow(32 * kpt), BCT + trow(32 * ot), r32, hi); else mm32s<4, true, false>(acc, ZT + trow(32 * kpt), ARB + 32 * ot * CK_RS, r32, hi);
            v4u* dst = (v4u*)(ws + (w < 4 ? WS_CKP0 : WS_CKRT)) + (size_t)item * 512 + (ot * 4 + 2 * kpt) * 64 + lane;
#pragma unroll
            for (int s2 = 0; s2 < 2; ++s2) { float o[8];
#pragma unroll
                for (int j = 0; j < 8; ++j) o[j] = acc[8 * s2 + j];
                if (w >= 4) {
#pragma unroll
                    for (int hf = 0; hf < 2; ++hf) { const v2u rw = *(const LAS v2u*)(RH + (32 * ot + r32) * CK_RS + 32 * kpt + 16 * s2 + 8 * hf + 4 * hi);
                        o[4 * hf] += __uint_as_float(rw.x << 16); o[4 * hf + 1] += __uint_as_float(rw.x & 0xffff0000u); o[4 * hf + 2] += __uint_as_float(rw.y << 16); o[4 * hf + 3] += __uint_as_float(rw.y & 0xffff0000u); } }
                dst[s2 * 64] = pack8(o); }
        }
        {
            const int u = w & 3, rt2 = u >> 1, vt = u & 1; f32x16 acc = {};
            if (w < 4) mm32s<4, true, true>(acc, BCT + trow(32 * rt2), ZT + trow(64 + 32 * vt), r32, hi); else mm32s<4, false, true>(acc, ARB + 32 * rt2 * CK_RS, ZT + trow(64 + 32 * vt), r32, hi);
            if (w < 4) mm32s<4, true, true>(acc, KCT + trow(32 * rt2), VT + trow(32 * vt), r32, hi); else mm32s<4, false, true>(acc, ARK + 32 * rt2 * CK_RS, VT + trow(32 * vt), r32, hi);
            unsigned* dmp = (unsigned*)(ws + (w < 4 ? WS_CKQ : (DIR ? WS_CKC4B : WS_CKC4A))) + (size_t)(w < 4 ? item : sid * (TP / 64) + c) * 2048 + u * 512 + lane;
#pragma unroll
            for (int g = 0; g < 8; ++g) dmp[g * 64] = pk2(acc[2 * g], acc[2 * g + 1]);
        }
        __syncthreads(); CK_STAMP();
    }
#undef CK_LOAD
}

struct CkSet { bf16x8 af[4]; unsigned dq[8]; f32x4 gm[4]; };
template <int DIR> __device__ __forceinline__ void ck_consume(const Frame& F, int sid) {
    const int b = sid >> 3, h = sid & 7; unsigned char* ws = F.ws;
    constexpr int NCK = TP / 64; const int item0 = (sid * 2 + DIR) * NCK;
    const int lane = F.lane, w = F.wave, r32 = lane & 31, hi = lane >> 5, u = w & 3, rt2 = u >> 1, vt = u & 1;
    lbf16* XT = (lbf16*)(F.lds);
    bf16* YO = (bf16*)(ws + WS_YS) + (size_t)DIR * ML * 512;
    for (int i = F.tid; i < 64 * CK_RS / 2; i += 512) ((LAS unsigned*)XT)[i] = 0u;
    const bf16x8* Ag = (const bf16x8*)(ws + (w < 4 ? WS_CKP0 : WS_CKRT)) + (size_t)item0 * 512 + (rt2 * 4) * 64 + lane;
    const unsigned* Dg = (const unsigned*)(ws + (w < 4 ? WS_CKQ : (DIR ? WS_CKC4B : WS_CKC4A))) + (size_t)(w < 4 ? item0 : sid * NCK) * 2048 + u * 512 + lane;
    const float* Gg = (const float*)(ws + WS_CKGAM) + (size_t)item0 * 64 + 32 * rt2 + 4 * hi;
    f32x16 X = {};
#define CC_LOAD(S, c) do { _Pragma("unroll") for (int ks = 0; ks < 4; ++ks) S.af[ks] = __builtin_nontemporal_load(Ag + (size_t)(c) * 512 + ks * 64); \
        _Pragma("unroll") for (int g = 0; g < 8; ++g) S.dq[g] = __builtin_nontemporal_load(Dg + (size_t)(c) * 2048 + g * 64); \
        if (w < 4) { _Pragma("unroll") for (int g4 = 0; g4 < 4; ++g4) S.gm[g4] = *(const f32x4*)(Gg + (size_t)(c) * 64 + 8 * g4); } } while (0)
#define CC_STEP(S, c) do { f32x16 acc; \
        _Pragma("unroll") for (int g = 0; g < 8; ++g) { acc[2 * g] = __uint_as_float(S.dq[g] << 16); acc[2 * g + 1] = __uint_as_float(S.dq[g] & 0xffff0000u); } \
        _Pragma("unroll") for (int ks = 0; ks < 4; ++ks) { const v2u xl_ = *(const LAS v2u*)(XT + (32 * vt + r32) * CK_RS + 16 * ks + 4 * hi), xh_ = *(const LAS v2u*)(XT + (32 * vt + r32) * CK_RS + 16 * ks + 8 + 4 * hi); \
            const bf16x8 xb = __builtin_bit_cast(bf16x8, ((v4u){xl_.x, xl_.y, xh_.x, xh_.y})); \
            acc = __builtin_amdgcn_mfma_f32_32x32x16_bf16(S.af[ks], xb, acc, 0, 0, 0); } \
        if (w < 4) { _Pragma("unroll") for (int g4 = 0; g4 < 4; ++g4) _Pragma("unroll") for (int j = 0; j < 4; ++j) X[4 * g4 + j] = S.gm[g4][j] * X[4 * g4 + j] + acc[4 * g4 + j]; } \
        else if ((c) * 64 >= CT) { _Pragma("unroll") for (int r = 0; r < 16; ++r) { const int i = (c) * 64 + 32 * rt2 + (r & 3) + 8 * (r >> 2) + 4 * hi, lt = DIR == 0 ? i - CT : (TP - 1 - i); \
                YO[(size_t)(b * SL + lt) * 512 + h * 64 + 32 * vt + r32] = (bf16)(pk2h(acc[r], acc[r]) & 0xffffu); } } \
        if ((c) + 4 < NCK) CC_LOAD(S, (c) + 4); \
        __syncthreads(); \
        if (w < 4) { _Pragma("unroll") for (int g4 = 0; g4 < 4; ++g4) { v2u ow; ow.x = pk2h(X[4 * g4], X[4 * g4 + 1]); ow.y = pk2h(X[4 * g4 + 2], X[4 * g4 + 3]); \
                *(LAS v2u*)(XT + (32 * vt + r32) * CK_RS + 32 * rt2 + 8 * g4 + 4 * hi) = ow; } } \
        __syncthreads(); } while (0)
    CkSet S0, S1, S2, S3;
    CC_LOAD(S0, 0); CC_LOAD(S1, 1); CC_LOAD(S2, 2); CC_LOAD(S3, 3);
    __syncthreads();
    static_assert(NCK % 4 == 0, "chunk count");
    for (int c = 0; c < NCK; c += 4) { CC_STEP(S0, c); CC_STEP(S1, c + 1); CC_STEP(S2, c + 2); CC_STEP(S3, c + 3); }
#undef CC_LOAD
#undef CC_STEP
}
__device__ __forceinline__ void ck_consume_wave(const Frame& F, int task) {
    const int sdir = task >> 1, vh = task & 1, dir = sdir & 1, sid = sdir >> 1, b = sid >> 3, h = sid & 7; unsigned char* ws = F.ws;
    constexpr int NCK = TP / 64; const int item0 = sdir * NCK, lane = F.lane, r32 = lane & 31, hi = lane >> 5;
    const bf16* Pg = (const bf16*)(ws + WS_CKP0) + (size_t)item0 * 4096 + r32 * 64 + 4 * hi; const bf16* Rg = (const bf16*)(ws + WS_CKRT) + (size_t)item0 * 4096 + r32 * 64 + 4 * hi;
    const unsigned* Qd = (const unsigned*)(ws + WS_CKQ) + (size_t)item0 * 2048 + vh * 512 + lane;
    const unsigned* Cd = (const unsigned*)(ws + (dir ? WS_CKC4B : WS_CKC4A)) + (size_t)(sid * NCK) * 2048 + vh * 512 + lane;
    const float* Gg = (const float*)(ws + WS_CKGAM) + (size_t)item0 * 64 + 4 * hi;
    bf16* YO = (bf16*)(ws + WS_YS) + (size_t)dir * ML * 512 + h * 64 + 32 * vh + r32;
    f32x16 X0 = {}, X1 = {};
    v2u pf[2][4][2], rf[2][4][2]; unsigned qd[2][8], cd[2][8]; f32x4 gm[2][4];
#define CW_LOADP(c) do { _Pragma("unroll") for (int kt = 0; kt < 2; ++kt) _Pragma("unroll") for (int q = 0; q < 4; ++q) { const bf16* p_ = Pg + (size_t)(c) * 4096 + kt * 2048 + 16 * q; pf[kt][q][0] = *(const v2u*)p_; pf[kt][q][1] = *(const v2u*)(p_ + 8); } \
        _Pragma("unroll") for (int kt = 0; kt < 2; ++kt) { _Pragma("unroll") for (int g = 0; g < 8; ++g) qd[kt][g] = Qd[(size_t)(c) * 2048 + kt * 1024 + g * 64]; \
            _Pragma("unroll") for (int g4 = 0; g4 < 4; ++g4) gm[kt][g4] = *(const f32x4*)(Gg + (size_t)(c) * 64 + 32 * kt + 8 * g4); } } while (0)
#define CW_LOADR(c) do { _Pragma("unroll") for (int kt = 0; kt < 2; ++kt) { _Pragma("unroll") for (int q = 0; q < 4; ++q) { const bf16* p_ = Rg + (size_t)(c) * 4096 + kt * 2048 + 16 * q; rf[kt][q][0] = *(const v2u*)p_; rf[kt][q][1] = *(const v2u*)(p_ + 8); } \
            _Pragma("unroll") for (int g = 0; g < 8; ++g) cd[kt][g] = Cd[(size_t)(c) * 2048 + kt * 1024 + g * 64]; } } while (0)
#define CW_FRAG(f_) __builtin_bit_cast(bf16x8, ((v4u){f_[0].x, f_[0].y, f_[1].x, f_[1].y}))
#define CW_XB(Xt, s) __builtin_bit_cast(bf16x8, ((v4u){pk2h(Xt[8 * (s)], Xt[8 * (s) + 1]), pk2h(Xt[8 * (s) + 2], Xt[8 * (s) + 3]), pk2h(Xt[8 * (s) + 4], Xt[8 * (s) + 5]), pk2h(Xt[8 * (s) + 6], Xt[8 * (s) + 7])}))
    CW_LOADR(0); CW_LOADP(0);
    for (int c = 0; c < NCK; ++c) {
        bf16x8 xb[4]; xb[0] = CW_XB(X0, 0); xb[1] = CW_XB(X0, 1); xb[2] = CW_XB(X1, 0); xb[3] = CW_XB(X1, 1);
#pragma unroll
        for (int t2 = 0; t2 < 2; ++t2) {
            f32x16 acc;
#pragma unroll
            for (int g = 0; g < 8; ++g) { acc[2 * g] = __uint_as_float(cd[t2][g] << 16); acc[2 * g + 1] = __uint_as_float(cd[t2][g] & 0xffff0000u); }
#pragma unroll
            for (int q = 0; q < 4; ++q) acc = __builtin_amdgcn_mfma_f32_32x32x16_bf16(CW_FRAG(rf[t2][q]), xb[q], acc, 0, 0, 0);
            if (c * 64 >= CT) {
#pragma unroll
                for (int r = 0; r < 16; ++r) { const int i = c * 64 + 32 * t2 + (r & 3) + 8 * (r >> 2) + 4 * hi, lt = dir == 0 ? i - CT : (TP - 1 - i);
                    YO[(size_t)(b * SL + lt) * 512] = (bf16)(pk2h(acc[r], acc[r]) & 0xffffu); } }
        }
        if (c + 1 < NCK) CW_LOADR(c + 1);
        f32x16 a0, a1;
#pragma unroll
        for (int g = 0; g < 8; ++g) { a0[2 * g] = __uint_as_float(qd[0][g] << 16); a0[2 * g + 1] = __uint_as_float(qd[0][g] & 0xffff0000u); a1[2 * g] = __uint_as_float(qd[1][g] << 16); a1[2 * g + 1] = __uint_as_float(qd[1][g] & 0xffff0000u); }
#pragma unroll
        for (int q = 0; q < 4; ++q) { a0 = __builtin_amdgcn_mfma_f32_32x32x16_bf16(CW_FRAG(pf[0][q]), xb[q], a0, 0, 0, 0); a1 = __builtin_amdgcn_mfma_f32_32x32x16_bf16(CW_FRAG(pf[1][q]), xb[q], a1, 0, 0, 0); }
#pragma unroll
        for (int g4 = 0; g4 < 4; ++g4)
#pragma unroll
            for (int j = 0; j < 4; ++j) { X0[4 * g4 + j] = gm[0][g4][j] * X0[4 * g4 + j] + a0[4 * g4 + j]; X1[4 * g4 + j] = gm[1][g4][j] * X1[4 * g4 + j] + a1[4 * g4 + j]; }
        if (c + 1 < NCK) CW_LOADP(c + 1);
    }
#undef CW_LOADP
#undef CW_LOADR
#undef CW_FRAG
#undef CW_XB
}

__global__ void __launch_bounds__(NWAVES * 64, 2) hyb_fwd(Args args) {
    extern __shared__ __attribute__((aligned(16))) unsigned char lds[];
    Frame F;
    F.lds = (LAS unsigned char*)lds; F.ldsg = (char*)lds;
    F.MISC = (volatile LAS unsigned*)(F.lds + MISC_OFF);
    F.tid = threadIdx.x; F.lane = F.tid & 63; F.wave = __builtin_amdgcn_readfirstlane(F.tid >> 6);
    F.G = gridDim.x; { const int bx = blockIdx.x; F.vcu = (F.G % 8 == 0) ? (bx % 8) * (F.G / 8) + bx / 8 : bx; }
    F.gw = F.vcu * NWAVES + F.wave; F.NGW = F.G * NWAVES;
    F.ws = args.ws; F.ctl = (gu32*)(args.ws + WS_CTL);
    unsigned char* ws = args.ws;
    for (int u = F.tid; u < (LDS_BYTES - LDSCTL_OFF) / 4; u += NWAVES * 64) ((LAS unsigned*)(F.lds + LDSCTL_OFF))[u] = 0u;
    __syncthreads();
    XcdBarrier bar; bar.bar = (unsigned*)(F.ctl + CW_BAR); bar.x = 0; bar.st = nullptr;
    if (N_LAUNCHES == 1) bar = xcd_barrier_post((unsigned*)(F.ctl + CW_BAR), F.MISC + 8);
#ifndef EXTRA_BAR
#define EXTRA_BAR 0
#endif
#define GRID_BAR() do { if (N_LAUNCHES == 1) { xcd_barrier(bar); for (int xb_ = 0; xb_ < EXTRA_BAR; ++xb_) xcd_barrier(bar); } } while (0)
    const int lo = args.ph_lo, hi = args.ph_hi;
#ifndef PHMASK
#define PHMASK 0xffffffu
#endif
#define IN(k) ((((PHMASK) >> (k)) & 1u) && lo <= (k) && (k) < hi)
#ifndef REPMASK
#define REPMASK 0u
#endif
#define REPN(k) ((((REPMASK) >> (k)) & 1u) ? 2 : 1)
#define REP(k) _Pragma("unroll") for (int rep_ = 0; rep_ < (((k) == 6 || (k) == 16) ? 1 : REPN(k)); ++rep_)
#ifdef PROBE_MASK
    volatile LAS unsigned long long* pr_ = (volatile LAS unsigned long long*)(F.lds + MISC_OFF + 64);
    if (F.tid == 0) { pr_[0] = rt(); pr_[1] = 0ull; }
#define SEAM(k) do { if (IN(k) && IN((k) + 1)) GRID_BAR(); if (blockIdx.x == 0 && F.tid == 0) { const unsigned long long now_ = rt(); if (((PROBE_MASK) >> (k)) & 1u) pr_[1] = pr_[1] + (now_ - pr_[0]); pr_[0] = now_; } } while (0)
#else
#define SEAM(k) do { if (IN(k) && IN((k) + 1)) GRID_BAR(); } while (0)
#endif
    const int cb = (int)blockIdx.x;
#define OPQ(x) ({ int v_ = (x); asm volatile("" : "+s"(v_)); v_; })

    if (IN(0)) REP(0) { p0_prologue(F, args); } SEAM(0);
    if (IN(1)) REP(1) { p1_first_h(F, args); } SEAM(1);
    if (IN(2)) REP(2) {
        pg8::Gemm g{(const pg8::bf16_t*)(ws + WS_H), (const pg8::bf16_t*)(ws + WS_WIN0), MR, E_IN, OPQ(D)}; pg8::StaticOrder S; S.init(MR, E_IN, F.G, cb);
        pg8::EpiStore E{(pg8::bf16_t*)(ws + WS_PRJ0), E_IN, E_IN / 256};
        pg8::gemm_phase<pg8::EpiStore, pg8::StaticOrder, true, true>(F.lds + RING_OFF, g, S, E);
        p0_rest(F, args, (66 * (E_IN / 256)) % F.G);
    } SEAM(2);
    if (IN(3)) REP(3) { p3_post0(F, args); } SEAM(3);
    if (IN(4)) REP(4) { for (int u = F.vcu; u < NB * 4 * NCH; u += F.G) ret_u_unit(F, args, u); } SEAM(4);
    if (IN(5)) REP(5) { ret_prefix(F, args); } SEAM(5);
    if (IN(6)) REP(6) {
        if (REPN(6) == 1) {
            for (int i = cb; i < 264; i += F.G) attn0_unit(F, i);
            for (int i = cb + ((264 + F.G - 1 - cb) / F.G) * F.G; i < 264 + NB * 4 * NCH; i += F.G) ret_out_unit(F, args, i - 264);
        } else {
            for (int i = cb; i < 264 * 2; i += F.G) attn0_unit(F, i % 264);
            for (int i = cb; i < NB * 4 * NCH * 2; i += F.G) ret_out_unit(F, args, i % (NB * 4 * NCH));
        }
    } SEAM(6);
    if (IN(7)) REP(7) {
        pg8::Gemm g{(const pg8::bf16_t*)(ws + WS_MIX0), (const pg8::bf16_t*)(ws + WS_WOUT0), MR, D, OPQ(D)}; pg8::StaticOrder S; S.init(MR, D, F.G, cb);
        pg8::EpiStore E{(pg8::bf16_t*)(ws + WS_Y0), D, D / 256};
        pg8::gemm_phase<pg8::EpiStore, pg8::StaticOrder, true, true>(F.lds + RING_OFF, g, S, E);
    } SEAM(7);
    if (IN(8)) REP(8) { p_resid_all<0>(F, args, (const bf16*)(ws + WS_Y0), 0, 0); } SEAM(8);
    if (IN(9)) REP(9) {
        pg8::Gemm g{(const pg8::bf16_t*)(ws + WS_H), (const pg8::bf16_t*)(ws + WS_WGU0), MR, 2 * FFH, OPQ(D)}; pg8::StaticOrder S; S.init(MR, 2 * FFH, F.G, cb);
        pg8::EpiSwiglu E{(pg8::bf16_t*)(ws + WS_ACT0), FFH, 2 * FFH / 256};
        pg8::gemm_phase<pg8::EpiSwiglu, pg8::StaticOrder, true, true>(F.lds + RING_OFF, g, S, E);
    } SEAM(9);
    if (IN(10)) REP(10) {
        { pg8::Gemm g{(const pg8::bf16_t*)(ws + WS_ACT0), (const pg8::bf16_t*)(ws + WS_WD0), MR, D, OPQ(FFH)}; pg8::LatOrder S; S.init(ML, D, F.G, cb);
          pg8::EpiStore E{(pg8::bf16_t*)(ws + WS_Y0), D, D / 256};
          pg8::gemm_phase<pg8::EpiStore, pg8::LatOrder, true, true>(F.lds + RING_OFF, g, S, E); }
        { pg8::Gemm g{(const pg8::bf16_t*)(ws + WS_ACT0), (const pg8::bf16_t*)(ws + WS_WD0), MR, D, OPQ(256), FFH}; pg8::CtxSplitOrder S{FFH / 256, 256, F.G, cb};
          pg8::EpiAtomicCtx E{(float*)(ws + WS_Y0F), 256};
          pg8::gemm_phase<pg8::EpiAtomicCtx, pg8::CtxSplitOrder, true, true>(F.lds + RING_OFF, g, S, E); }
    } SEAM(10);
    if (IN(11)) REP(11) { p_resid_all<FFH / 256>(F, args, (const bf16*)(ws + WS_Y0), 0, 1); } SEAM(11);
    if (IN(12)) REP(12) {
        pg8::Gemm g{(const pg8::bf16_t*)(ws + WS_H), (const pg8::bf16_t*)(ws + WS_WIN1), MR, O_INP, OPQ(D)}; pg8::StaticOrder S; S.init(MR, O_INP, F.G, cb);
        pg8::EpiSplit1 E{(pg8::bf16_t*)(ws + WS_KV1), (pg8::bf16_t*)(ws + WS_RWQ)};
        pg8::gemm_phase<pg8::EpiSplit1, pg8::StaticOrder, true, true>(F.lds + RING_OFF, g, S, E);
    } SEAM(12);
    if (IN(13)) REP(13) { p13_prep1(F, args); } SEAM(13);
    if (IN(14)) REP(14) {
        pg8::Gemm g{(const pg8::bf16_t*)(ws + WS_LIN), (const pg8::bf16_t*)(ws + WS_WL), MR, 2560, OPQ(384)}; pg8::LoraOrder S; S.init(MR, 2560, F.G, cb);
        pg8::EpiLora E{(pg8::bf16_t*)(ws + WS_SCAN + SA_L0 * SCAN_ARR), (pg8::bf16_t*)(ws + WS_SCAN + SA_L1 * SCAN_ARR), (pg8::bf16_t*)(ws + WS_SCAN + SA_A0 * SCAN_ARR), (pg8::bf16_t*)(ws + WS_SCAN + SA_A1 * SCAN_ARR),
                       (pg8::bf16_t*)(ws + WS_SCAN + SA_G * SCAN_ARR), args.in[I_RW0], args.in[I_RA0]};
        pg8::gemm_phase<pg8::EpiLora, pg8::LoraOrder, true, true>(F.lds + RING_OFF, g, S, E);
    } SEAM(14);
    if (IN(15)) REP(15) { ck_precompute(F, args); } SEAM(15);
    if (IN(16)) REP(16) {
        #ifdef OLD_SCAN
            if (cb < 128) { if (cb & 1) rwkv_scan<1, REPN(16)>(F, args, cb >> 1); else rwkv_scan<0, REPN(16)>(F, args, cb >> 1); __syncthreads(); }
#else
            if (cb < 32) { if (cb & 1) ck_consume<1>(F, cb >> 1); else ck_consume<0>(F, cb >> 1); __syncthreads(); }
#endif
        for (;;) {
            if (F.tid == 0) F.MISC[0] = __hip_atomic_fetch_add((unsigned*)(F.ctl + CW_QUEUE + 64 * rep_), 1u, RLX_AGENT);
            __syncthreads(); const unsigned u = F.MISC[0]; __syncthreads();
            if (u >= 1024u * REPN(16)) break;
            attn1_unit(F, (int)(u & 1023u));
        }
    } SEAM(16);
    if (IN(17)) REP(17) { p15_finish1(F, args); } SEAM(17);
    if (IN(18)) REP(18) {
        pg8::Gemm g{(const pg8::bf16_t*)(ws + WS_H), (const pg8::bf16_t*)(ws + WS_WOUT1), MR, D, OPQ(D)}; pg8::LatOrder S; S.init(ML, D, F.G, cb);
        pg8::EpiStore E{(pg8::bf16_t*)(ws + WS_Y1), D, D / 256};
        pg8::gemm_phase<pg8::EpiStore, pg8::LatOrder, true, true>(F.lds + RING_OFF, g, S, E);
    } SEAM(18);
    if (IN(19)) REP(19) { p17_route(F, args); } SEAM(19);
    if (IN(20)) REP(20) { p18_gather(F, args); } SEAM(20);
    if (IN(21)) REP(21) {
        int off[NE + 1]; const int nT = moe_offsets(F, off);
        pg8::Gemm g{(const pg8::bf16_t*)(ws + WS_AG), (const pg8::bf16_t*)(ws + WS_WMOE_GU), nT * 256, 2 * EH, OPQ(D)};
        pg8::MoeOrder S{nT, 2 * EH / 256, F.G, cb, (const int*)(ws + WS_TILEE)};
        pg8::EpiSwiglu E{(pg8::bf16_t*)(ws + WS_ACT1), EH, 2 * EH / 256};
        pg8::gemm_phase<pg8::EpiSwiglu, pg8::MoeOrder, true, true>(F.lds + RING_OFF, g, S, E);
    } SEAM(21);
    if (IN(22)) REP(22) {
        int off[NE + 1]; const int nT = moe_offsets(F, off); const bool split = (F.G == 256); const int nMain = (split && nT > 128) ? 128 : nT;
        pg8::Gemm g{(const pg8::bf16_t*)(ws + WS_ACT1), (const pg8::bf16_t*)(ws + WS_WMOE_D), nT * 256, D, OPQ(EH)};
        pg8::MoeDownOrder S{pg8::MoeOrder{nMain, D / 256, F.G, cb, (const int*)(ws + WS_TILEE)}, nT, EH / 4};
        pg8::EpiDown E{(pg8::bf16_t*)(ws + WS_AG), (float*)(ws + WS_Y2F), 128, EH / 4, 8 * 256};
        pg8::gemm_phase<pg8::EpiDown, pg8::MoeDownOrder, true, true>(F.lds + RING_OFF, g, S, E);
    } SEAM(22);
    if (IN(23)) REP(23) { p21_final(F, args); }
#ifdef PROBE_MASK
    SEAM(23);
    if (blockIdx.x == 0 && F.tid == 0) { const unsigned long long t0_ = rt(); const unsigned long long w_ = (unsigned long long)(PROBE_AMP) * pr_[1]; while (rt() - t0_ < w_) __builtin_amdgcn_s_sleep(8); }
#endif
#undef IN
#undef SEAM
#undef GRID_BAR
}

extern "C" void kernel_launch(void* const* d_in, const int* in_sizes, int n_in, void* d_out, int out_size, void* d_ws, size_t ws_size, hipStream_t stream) {
    static int grid = 0;
    if (grid == 0) {
        if (n_in != 35 || in_sizes[0] != ML * D || out_size != ML * D || ws_size < WS_END) {
            fprintf(stderr, "kernel_launch: shape mismatch: n_in %d in0 %d out %d ws %zu (need >= %zu); nothing launched\n", n_in, n_in > 0 ? in_sizes[0] : -1, out_size, ws_size, (size_t)WS_END); grid = -1; return; }
        int dev = 0, cus = 0, per_cu = 0;
        if (hipGetDevice(&dev) != hipSuccess || hipDeviceGetAttribute(&cus, hipDeviceAttributeMultiprocessorCount, dev) != hipSuccess) { grid = -1; return; }
        if (hipFuncSetAttribute((const void*)hyb_fwd, hipFuncAttributeMaxDynamicSharedMemorySize, LDS_BYTES) != hipSuccess) { fprintf(stderr, "kernel_launch: hipFuncSetAttribute failed\n"); grid = -1; return; }
        if (hipOccupancyMaxActiveBlocksPerMultiprocessor(&per_cu, (const void*)hyb_fwd, NWAVES * 64, LDS_BYTES) != hipSuccess || per_cu < 1)
            fprintf(stderr, "kernel_launch: note: occupancy query reports %d workgroups per CU\n", per_cu);
        (void)hipGetLastError();
        grid = cus;
    }
    if (grid < 0) return;
    if (hipMemsetAsync((char*)d_ws + WS_CTL, 0, CTL_ZERO_BYTES, stream) != hipSuccess) return;
    Args a{};
    for (int i = 0; i < 35; ++i) a.in[i] = (const float*)d_in[i];
    a.out = (float*)d_out; a.ws = (unsigned char*)d_ws;
    if (N_LAUNCHES == 1) { a.ph_lo = 0; a.ph_hi = NPH; hipLaunchKernelGGL(hyb_fwd, dim3(grid), dim3(NWAVES * 64), LDS_BYTES, stream, a); }
    else { for (int li = 0; li < NPH; ++li) { a.ph_lo = li; a.ph_hi = li + 1; hipLaunchKernelGGL(hyb_fwd, dim3(grid), dim3(NWAVES * 64), LDS_BYTES, stream, a); } }
    const hipError_t le = hipPeekAtLastError();
    if (le != hipSuccess) fprintf(stderr, "kernel_launch: launch failed: %s\n", hipGetErrorName(le));
}
```

```cpp
#include <hip/hip_runtime.h>
#include <cstdio>
#include <cstdint>
#ifndef MK_N_LAUNCHES
#define MK_N_LAUNCHES 1
#endif
namespace pg8 {
#define PG8_LAS __attribute__((address_space(3)))
typedef unsigned short bf16_t;
typedef short bf16x8 __attribute__((ext_vector_type(8)));
typedef float f32x4 __attribute__((ext_vector_type(4)));
typedef unsigned u32x4 __attribute__((ext_vector_type(4)));
constexpr int BM = 256, BK = 64, HALF = 128, HTB = HALF * BK * 2  , STAGE_BYTES = 8 * HTB, NXCD = 8, WGM = 8;

__host__ __device__ __forceinline__ int lds_byte(int r, int c) { const int st = (r >> 4) * 2 + (c >> 5), rr = r & 15, cc = c & 31, ob = rr * 64 + cc * 2; return st * 1024 + (ob ^ (((ob >> 9) & 1) << 5)); }
__host__ __device__ __forceinline__ void stage_rc(int b, int& R, int& C) { const int st = b / 1024, sb = b % 1024, swz = sb ^ (((sb >> 9) & 1) << 5); R = (st >> 1) * 16 + swz / 64; C = (st & 1) * 32 + (swz % 64) / 2; }
__host__ __device__ __forceinline__ int perm32(int rho) { const int n = rho >> 4, i = rho & 15; return 8 * (i >> 2) + 4 * n + (i & 3); }

struct Unit { int pm, pn; int ko = 0, kt = 0; };
struct Gemm { const bf16_t* A; const bf16_t* Bt; int M, N, K; int ld = 0; };

struct StaticOrder {
    int nM, nN, nwg, G, c;
    __host__ __device__ void init(int M, int N, int G_, int c_) { nM = M / BM; nN = N / BM; nwg = nM * nN; G = G_; c = c_; }
    __host__ __device__ bool next(int i, Unit& u) const {
        const long L = (long)i * G + c; if (L >= nwg) return false;
        int wgid = (int)L; { const int q = nwg / NXCD, r = nwg % NXCD, xcd = wgid % NXCD, off = wgid / NXCD; wgid = (xcd < r ? xcd * (q + 1) : r * (q + 1) + (xcd - r) * q) + off; }
        const int nig = WGM * nN, gid = wgid / nig, fm = gid * WGM, gsz = (nM - fm) < WGM ? (nM - fm) : WGM;
        u.pm = fm + ((wgid % nig) % gsz); u.pn = (wgid % nig) / gsz; return true;
    }
    __device__ __forceinline__ void a_ready(const Unit&) const {}
    __device__ __forceinline__ void done(const Unit&) const {}
};

__device__ __forceinline__ unsigned cvt_pk_bf16(float lo, float hi) { unsigned r; asm volatile("v_cvt_pk_bf16_f32 %0, %1, %2" : "=v"(r) : "v"(lo), "v"(hi)); return r; }
typedef float f32x2 __attribute__((ext_vector_type(2)));
__device__ __forceinline__ float bf2f(unsigned short h) { return __uint_as_float(((unsigned)h) << 16); }
__device__ __forceinline__ float silu_f(float x) { return x * __builtin_amdgcn_rcpf(1.0f + __builtin_amdgcn_exp2f(-1.44269504089f * x)); }
__device__ __forceinline__ float sigmoid_f(float x) { return __builtin_amdgcn_rcpf(1.0f + __builtin_amdgcn_exp2f(-1.44269504089f * x)); }
__device__ __forceinline__ u32x4 pack8(const f32x4 a, const f32x4 b) { u32x4 w; w.x = cvt_pk_bf16(a[0], a[1]); w.y = cvt_pk_bf16(a[2], a[3]); w.z = cvt_pk_bf16(b[0], b[1]); w.w = cvt_pk_bf16(b[2], b[3]); return w; }
__device__ __forceinline__ void unpack8(const u32x4 w, float (&f)[8]) {
    f[0] = __uint_as_float(w.x << 16); f[1] = __uint_as_float(w.x & 0xffff0000u); f[2] = __uint_as_float(w.y << 16); f[3] = __uint_as_float(w.y & 0xffff0000u);
    f[4] = __uint_as_float(w.z << 16); f[5] = __uint_as_float(w.z & 0xffff0000u); f[6] = __uint_as_float(w.w << 16); f[7] = __uint_as_float(w.w & 0xffff0000u); }

struct EpiStore {
    static constexpr bool PERM = true, AFTER_DRAIN = false;
    bf16_t* O; int ldc; int ncolt;
    __device__ __forceinline__ void operator()(const f32x4 (&acc)[2][2][4][2], const Unit& u, int wr, int wc, int fr, int fq) const {
        const int row0 = u.pm * BM + wr * 64 + fr, col0 = (u.pn % ncolt) * BM + wc * 32 + 8 * fq;
#pragma unroll
        for (int ai = 0; ai < 2; ++ai)
#pragma unroll
            for (int m = 0; m < 4; ++m) { bf16_t* rowp = O + (size_t)(row0 + ai * HALF + m * 16) * ldc + col0;
#pragma unroll
                for (int bj = 0; bj < 2; ++bj) *(u32x4*)(rowp + bj * HALF) = pack8(acc[ai][bj][m][0], acc[ai][bj][m][1]); }
    }
};
struct EpiSwiglu {
    static constexpr bool PERM = true, AFTER_DRAIN = false;
    bf16_t* O; int ldc; int ncolt;
    __device__ __forceinline__ void operator()(const f32x4 (&acc)[2][2][4][2], const Unit& u, int wr, int wc, int fr, int fq) const {
        const int row0 = u.pm * BM + wr * 64 + fr, col0 = (u.pn % ncolt) * HALF + wc * 32 + 8 * fq;
#pragma unroll
        for (int ai = 0; ai < 2; ++ai)
#pragma unroll
            for (int m = 0; m < 4; ++m) { bf16_t* rowp = O + (size_t)(row0 + ai * HALF + m * 16) * ldc + col0;
                f32x4 o0, o1;
#pragma unroll
                for (int j = 0; j < 4; ++j) { o0[j] = silu_f(acc[ai][0][m][0][j]) * acc[ai][1][m][0][j]; o1[j] = silu_f(acc[ai][0][m][1][j]) * acc[ai][1][m][1][j]; }
                __builtin_nontemporal_store(pack8(o0, o1), (u32x4*)rowp); }
    }
};
struct EpiSplit1 {
    static constexpr bool PERM = true, AFTER_DRAIN = false;
    bf16_t* KV; bf16_t* RWQ;
    __device__ __forceinline__ void operator()(const f32x4 (&acc)[2][2][4][2], const Unit& u, int wr, int wc, int fr, int fq) const {
        const int row0 = u.pm * BM + wr * 64 + fr; bf16_t* base; int ldc, colt;
        if (u.pn >= 2 && u.pn < 6) { base = KV; ldc = 1024; colt = (u.pn - 2) * BM; }
        else { base = RWQ; ldc = 2560; colt = (u.pn < 2 ? u.pn : u.pn - 4) * BM; }
        const int col0 = colt + wc * 32 + 8 * fq;
#pragma unroll
        for (int ai = 0; ai < 2; ++ai)
#pragma unroll
            for (int m = 0; m < 4; ++m) { bf16_t* rowp = base + (size_t)(row0 + ai * HALF + m * 16) * ldc + col0;
#pragma unroll
                for (int bj = 0; bj < 2; ++bj) *(u32x4*)(rowp + bj * HALF) = pack8(acc[ai][bj][m][0], acc[ai][bj][m][1]); }
    }
};
struct EpiLora {
    static constexpr bool PERM = true, AFTER_DRAIN = false;
    bf16_t* L0; bf16_t* L1; bf16_t* A0; bf16_t* A1; bf16_t* G;
    const float* w0; const float* a0;
    __device__ __forceinline__ void operator()(const f32x4 (&acc)[2][2][4][2], const Unit& u, int wr, int wc, int fr, int fq) const {
        const int row0 = u.pm * BM + wr * 64 + fr; const int blk = u.pn >> 1, col0 = (u.pn & 1) * BM + wc * 32 + 8 * fq;
        bf16_t* O = blk == 0 ? L0 : blk == 1 ? L1 : blk == 2 ? A0 : blk == 3 ? A1 : G;
        if (blk < 4) {
            const float* bsrc = (blk < 2 ? w0 + blk * 512 : a0 + (blk - 2) * 512) + col0; const float sc = blk < 2 ? 0.60653065971f * 1.44269504089f : 1.0f;
#pragma unroll
            for (int bj = 0; bj < 2; ++bj) { const f32x4 b0 = *(const f32x4*)(bsrc + bj * HALF), b1 = *(const f32x4*)(bsrc + bj * HALF + 4);
#pragma unroll
                for (int ai = 0; ai < 2; ++ai)
#pragma unroll
                    for (int m = 0; m < 4; ++m) { f32x4 o0, o1;
#pragma unroll
                        for (int j = 0; j < 4; ++j) { o0[j] = sigmoid_f(acc[ai][bj][m][0][j] + b0[j]) * sc; o1[j] = sigmoid_f(acc[ai][bj][m][1][j] + b1[j]) * sc; }
                        *(u32x4*)(O + (size_t)(row0 + ai * HALF + m * 16) * 512 + col0 + bj * HALF) = pack8(o0, o1); } }
        } else {
#pragma unroll
            for (int ai = 0; ai < 2; ++ai)
#pragma unroll
                for (int m = 0; m < 4; ++m) { bf16_t* rowp = O + (size_t)(row0 + ai * HALF + m * 16) * 512 + col0;
#pragma unroll
                    for (int bj = 0; bj < 2; ++bj) *(u32x4*)(rowp + bj * HALF) = pack8(acc[ai][bj][m][0], acc[ai][bj][m][1]); }
        }
    }
};
struct LatOrder : StaticOrder {
    __device__ __forceinline__ bool next(int i, Unit& u) const { if (!StaticOrder::next(i, u)) return false; u.pm = u.pm < 32 ? u.pm + 1 : u.pm + 2; return true; }
};
struct EpiAtomic {
    static constexpr bool PERM = true, AFTER_DRAIN = false;
    float* O; int ldc; int ncolt; int rowtile0;
    __device__ __forceinline__ void operator()(const f32x4 (&acc)[2][2][4][2], const Unit& u, int wr, int wc, int fr, int fq) const {
        const int row0 = (u.pm - rowtile0) * BM + wr * 64 + fr, col0 = (u.pn % ncolt) * BM + wc * 32 + 8 * fq;
#pragma unroll
        for (int ai = 0; ai < 2; ++ai)
#pragma unroll
            for (int m = 0; m < 4; ++m) { float* rowp = O + (size_t)(row0 + ai * HALF + m * 16) * ldc + col0;
#pragma unroll
                for (int bj = 0; bj < 2; ++bj)
#pragma unroll
                    for (int n = 0; n < 2; ++n)
#pragma unroll
                        for (int j = 0; j < 4; ++j) __hip_atomic_fetch_add(rowp + bj * HALF + 4 * n + j, acc[ai][bj][m][n][j], __ATOMIC_RELAXED, __HIP_MEMORY_SCOPE_AGENT); }
    }
};
struct CtxSplitOrder {
    int nks, kslice, G, c;
    __device__ __forceinline__ bool next(int i, Unit& u) const {
        const int L = i * G + c; if (L >= 8 * nks) return false;
        const int rt = L / (4 * nks), j = (L / nks) & 3, ks = L % nks; u.pm = rt ? 33 : 0; u.pn = j; u.ko = ks * kslice; return true; }
    __device__ __forceinline__ void a_ready(const Unit&) const {}
    __device__ __forceinline__ void done(const Unit&) const {}
};
struct CtxSplitOrderN {
    int nks, kslice, ncol, G, c;
    __device__ __forceinline__ bool next(int i, Unit& u) const {
        const int L = i * G + c; if (L >= 2 * ncol * nks) return false;
        const int rt = L / (ncol * nks), j = (L / nks) % ncol, ks = L % nks; u.pm = rt ? 33 : 0; u.pn = j; u.ko = ks * kslice; return true; }
    __device__ __forceinline__ void a_ready(const Unit&) const {}
    __device__ __forceinline__ void done(const Unit&) const {}
};
struct EpiCtxPartial {
    static constexpr bool PERM = true, AFTER_DRAIN = false;
    float* O; int kslice; int ldc;
    __device__ __forceinline__ void operator()(const f32x4 (&acc)[2][2][4][2], const Unit& u, int wr, int wc, int fr, int fq) const {
        const int row0 = (u.pm ? BM : 0) + wr * 64 + fr, col0 = u.pn * BM + wc * 32 + 8 * fq; float* Os = O + (size_t)(u.ko / kslice) * 512 * ldc;
#pragma unroll
        for (int ai = 0; ai < 2; ++ai)
#pragma unroll
            for (int m = 0; m < 4; ++m) { float* rowp = Os + (size_t)(row0 + ai * HALF + m * 16) * ldc + col0;
#pragma unroll
                for (int bj = 0; bj < 2; ++bj)
#pragma unroll
                    for (int n = 0; n < 2; ++n) *(f32x4*)(rowp + bj * HALF + 4 * n) = acc[ai][bj][m][n]; }
    }
};
struct EpiAtomicCtx {
    static constexpr bool PERM = true, AFTER_DRAIN = false;
    float* O; int kslice;
    __device__ __forceinline__ void operator()(const f32x4 (&acc)[2][2][4][2], const Unit& u, int wr, int wc, int fr, int fq) const {
        const int row0 = (u.pm ? BM : 0) + wr * 64 + fr, col0 = u.pn * BM + wc * 32 + 8 * fq; float* Os = O + (size_t)(u.ko / kslice) * 512 * 1024;
#pragma unroll
        for (int ai = 0; ai < 2; ++ai)
#pragma unroll
            for (int m = 0; m < 4; ++m) { float* rowp = Os + (size_t)(row0 + ai * HALF + m * 16) * 1024 + col0;
#pragma unroll
                for (int bj = 0; bj < 2; ++bj)
#pragma unroll
                    for (int n = 0; n < 2; ++n) *(f32x4*)(rowp + bj * HALF + 4 * n) = acc[ai][bj][m][n]; }
    }
};
struct LatCtxOrder {
    StaticOrder S; int nks, first;
    __device__ __forceinline__ bool next(int i, Unit& u) const {
        const int nmain = S.nwg, mine = (nmain - S.c + S.G - 1) / S.G;
        if (i < (S.c < nmain ? mine : 0)) { const bool ok = S.next(i, u); u.pm = u.pm < 32 ? u.pm + 1 : u.pm + 2; u.ko = 0; u.kt = 0; return ok; }
        const int c2 = (S.c - first + S.G) % S.G, L = (i - (S.c < nmain ? mine : 0)) * S.G + c2; if (L >= 2 * S.nN * nks) return false;
        const int rt = L / (S.nN * nks), j = (L / nks) % S.nN, ks = L % nks; u.pm = rt ? 33 : 0; u.pn = j; u.ko = ks * 256; u.kt = 4; return true; }
    __device__ __forceinline__ void a_ready(const Unit&) const {}
    __device__ __forceinline__ void done(const Unit&) const {}
};
struct EpiStoreCtx {
    static constexpr bool PERM = true, AFTER_DRAIN = false;
    bf16_t* O; float* P; int ldc;
    __device__ __forceinline__ void operator()(const f32x4 (&acc)[2][2][4][2], const Unit& u, int wr, int wc, int fr, int fq) const {
        const int col0 = u.pn * BM + wc * 32 + 8 * fq;
        if (u.kt == 0) { const int row0 = u.pm * BM + wr * 64 + fr;
#pragma unroll
            for (int ai = 0; ai < 2; ++ai)
#pragma unroll
                for (int m = 0; m < 4; ++m) { bf16_t* rowp = O + (size_t)(row0 + ai * HALF + m * 16) * ldc + col0;
#pragma unroll
                    for (int bj = 0; bj < 2; ++bj) *(u32x4*)(rowp + bj * HALF) = pack8(acc[ai][bj][m][0], acc[ai][bj][m][1]); }
        } else { const int row0 = (u.pm ? BM : 0) + wr * 64 + fr; float* Os = P + (size_t)(u.ko >> 8) * 512 * ldc;
#pragma unroll
            for (int ai = 0; ai < 2; ++ai)
#pragma unroll
                for (int m = 0; m < 4; ++m) { float* rowp = Os + (size_t)(row0 + ai * HALF + m * 16) * ldc + col0;
#pragma unroll
                    for (int bj = 0; bj < 2; ++bj)
#pragma unroll
                        for (int n = 0; n < 2; ++n) *(f32x4*)(rowp + bj * HALF + 4 * n) = acc[ai][bj][m][n]; }
        }
    }
};
struct LoraOrder : StaticOrder {
    __device__ __forceinline__ bool next(int i, Unit& u) const { if (!StaticOrder::next(i, u)) return false; u.ko = u.pn >= 8 ? 128 : 0; u.kt = 4; return true; }
};
struct MoeOrder {
    int nT, nN, G, c; const int* tile_e;
    __device__ __forceinline__ bool next(int i, Unit& u) const {
        if ((G & 7) || (nN & 3) || (G >> 3) < 32) { const long L = (long)i * G + c; if (L >= (long)nT * nN) return false; const int t = (int)(L / nN), j = (int)(L % nN); u.pm = t; u.pn = tile_e[t] * nN + j; return true; }
        const int ncg = nN >> 2, nrb = (nT + 7) >> 3, wpx = G >> 3, x = c & 7, w = c >> 3;
        const int per = wpx >> 5;
        const long su = ((long)i * per + (w >> 5)) * 8 + x; if (per == 0 || su >= (long)nrb * ncg) return false;
        const int rb = (int)(su / ncg), cg = (int)(su % ncg), t = 8 * rb + (w & 7), j = 4 * cg + ((w >> 3) & 3);
        if (t >= nT) return false;
        u.pm = t; u.pn = tile_e[t] * nN + j; return true; }
    __device__ __forceinline__ void a_ready(const Unit&) const {}
    __device__ __forceinline__ void done(const Unit&) const {}
};
struct EpiPartial {
    static constexpr bool PERM = true, AFTER_DRAIN = false;
    float* O; int rowtile0; int kq; int rows;
    __device__ __forceinline__ void operator()(const f32x4 (&acc)[2][2][4][2], const Unit& u, int wr, int wc, int fr, int fq) const {
        const int row0 = (u.pm - rowtile0) * BM + wr * 64 + fr, col0 = (u.pn & 3) * BM + wc * 32 + 8 * fq; float* Os = O + (size_t)(u.ko / kq) * rows * 1024;
#pragma unroll
        for (int ai = 0; ai < 2; ++ai)
#pragma unroll
            for (int m = 0; m < 4; ++m) { float* rowp = Os + (size_t)(row0 + ai * HALF + m * 16) * 1024 + col0;
#pragma unroll
                for (int bj = 0; bj < 2; ++bj)
#pragma unroll
                    for (int n = 0; n < 2; ++n) *(f32x4*)(rowp + bj * HALF + 4 * n) = acc[ai][bj][m][n]; }
    }
};
struct MoeDownOrder {
    MoeOrder M; int nT, kq;
    __device__ __forceinline__ bool next(int i, Unit& u) const {
        const int nrb = (M.nT + 7) >> 3, x = M.c & 7, mine = x < nrb ? (nrb - x + 7) >> 3 : 0;
        if (i < mine) { const bool ok = M.next(i, u); u.ko = 0; u.kt = 0; return ok; }
        const long L = (long)(i - mine) * M.G + M.c; if (L >= (long)(nT - M.nT) * 16) return false;
        const int t = M.nT + (int)(L >> 4), j = (int)(L >> 2) & 3; u.pm = t; u.pn = M.tile_e[t] * 4 + j; u.ko = (int)(L & 3) * kq; u.kt = kq / BK; return true; }
    __device__ __forceinline__ void a_ready(const Unit&) const {}
    __device__ __forceinline__ void done(const Unit&) const {}
};
struct EpiDown {
    static constexpr bool PERM = true, AFTER_DRAIN = false;
    bf16_t* O; float* P; int rowtile0; int kq; int rows;
    __device__ __forceinline__ void operator()(const f32x4 (&acc)[2][2][4][2], const Unit& u, int wr, int wc, int fr, int fq) const {
        const int col0 = (u.pn & 3) * BM + wc * 32 + 8 * fq;
        if (u.kt == 0) { const int row0 = u.pm * BM + wr * 64 + fr;
#pragma unroll
            for (int ai = 0; ai < 2; ++ai)
#pragma unroll
                for (int m = 0; m < 4; ++m) { bf16_t* rowp = O + (size_t)(row0 + ai * HALF + m * 16) * 1024 + col0;
#pragma unroll
                    for (int bj = 0; bj < 2; ++bj) *(u32x4*)(rowp + bj * HALF) = pack8(acc[ai][bj][m][0], acc[ai][bj][m][1]); }
        } else { const int row0 = (u.pm - rowtile0) * BM + wr * 64 + fr; float* Os = P + (size_t)(u.ko / kq) * rows * 1024;
#pragma unroll
            for (int ai = 0; ai < 2; ++ai)
#pragma unroll
                for (int m = 0; m < 4; ++m) { float* rowp = Os + (size_t)(row0 + ai * HALF + m * 16) * 1024 + col0;
#pragma unroll
                    for (int bj = 0; bj < 2; ++bj)
#pragma unroll
                        for (int n = 0; n < 2; ++n) *(f32x4*)(rowp + bj * HALF + 4 * n) = acc[ai][bj][m][n]; }
        }
    }
};
struct MoeTailOrder {
    int t0, nT, G, c, kq; const int* tile_e;
    __device__ __forceinline__ bool next(int i, Unit& u) const {
        const long L = (long)i * G + c; if (L >= (long)(nT - t0) * 16) return false;
        const int t = t0 + (int)(L >> 4), j = (int)(L >> 2) & 3; u.pm = t; u.pn = tile_e[t] * 4 + j; u.ko = (int)(L & 3) * kq; return true; }
    __device__ __forceinline__ void a_ready(const Unit&) const {}
    __device__ __forceinline__ void done(const Unit&) const {}
};

template <class Epi, class Sched, bool ALIGN_EPI = false, bool SP2 = false>
__device__ __forceinline__ void gemm_phase(PG8_LAS unsigned char* lds, const Gemm g, const Sched& S, const Epi& E) {
    const int tid = threadIdx.x, wid = __builtin_amdgcn_readfirstlane(tid >> 6), lane = tid & 63, wr = wid >> 2, wc = wid & 3, fr = lane & 15, fq = lane >> 4;
    const int nt = g.K / BK, K = g.ld ? g.ld : g.K;
    unsigned voffA[2], voffB[2];
#pragma unroll
    for (int i = 0; i < 2; ++i) { int R, C; stage_rc(tid * 16 + i * 8192, R, C); const int Rb = Epi::PERM ? ((R & ~31) + perm32(R & 31)) : R;
        voffA[i] = (unsigned)(R * K + C) * 2u; voffB[i] = (unsigned)(Rb * K + C) * 2u; }
    const size_t kstep = (size_t)(BK * 2);
    const size_t hstep = (size_t)HALF * K * 2;
    const size_t tstep = 2 * hstep;
    const unsigned ldsw = (unsigned)wid * 1024u;
    const int aoff = lds_byte(wr * 64 + fr, fq * 8), boff = lds_byte(wc * 32 + fr, fq * 8);
#define PG8_SA(b, h) (((b) * 2 + (h)) * HTB)
#define PG8_SB(b, h) ((4 + (b) * 2 + (h)) * HTB)
#define PG8_STAGE(bufoff, gbase, voff) do { _Pragma("unroll") for (int _i = 0; _i < 2; ++_i) \
        __builtin_amdgcn_global_load_lds((const unsigned*)((const char*)(gbase) + (voff)[_i]), (PG8_LAS unsigned*)(lds + (bufoff) + ldsw + _i * 8192), 16, 0, 0); } while (0)
#define PG8_LDA(dst, b, h) do { _Pragma("unroll") for (int m = 0; m < 4; ++m) _Pragma("unroll") for (int k = 0; k < 2; ++k) dst[m][k] = *(const PG8_LAS bf16x8*)(lds + PG8_SA(b, h) + aoff + m * 2048 + k * 1024); } while (0)
#define PG8_LDB(dst, b, h) do { _Pragma("unroll") for (int n = 0; n < 2; ++n) _Pragma("unroll") for (int k = 0; k < 2; ++k) dst[n][k] = *(const PG8_LAS bf16x8*)(lds + PG8_SB(b, h) + boff + n * 2048 + k * 1024); } while (0)
#define PG8_MMA(ai, bj, At, Bt) do { __builtin_amdgcn_s_setprio(1); _Pragma("unroll") for (int m = 0; m < 4; ++m) _Pragma("unroll") for (int n = 0; n < 2; ++n) _Pragma("unroll") for (int k = 0; k < 2; ++k) \
        acc[ai][bj][m][n] = __builtin_amdgcn_mfma_f32_16x16x32_bf16(Bt[n][k], At[m][k], acc[ai][bj][m][n], 0, 0, 0); __builtin_amdgcn_s_setprio(0); } while (0)
#define PG8_WAIT_V(n) asm volatile("s_waitcnt vmcnt(" #n ")" ::: "memory")
#define PG8_WAIT_L(n) asm volatile("s_waitcnt lgkmcnt(" #n ")" ::: "memory")
#define PG8_BAR __builtin_amdgcn_s_barrier()
#define PG8_SCHED __builtin_amdgcn_sched_barrier(0)
    Unit cur, nxt; int ui = 0;
    if (!S.next(0, cur)) return;
    f32x4 acc[2][2][4][2];
#pragma unroll
    for (int a = 0; a < 2; ++a)
#pragma unroll
        for (int b = 0; b < 2; ++b)
#pragma unroll
            for (int m = 0; m < 4; ++m)
#pragma unroll
                for (int n = 0; n < 2; ++n) acc[a][b][m][n] = (f32x4){0.f, 0.f, 0.f, 0.f};
    bf16x8 At[4][2], B0[2][2], B1[2][2];
    const char* cA = (const char*)g.A + (size_t)cur.pm * tstep + (size_t)cur.ko * 2; const char* cB = (const char*)g.Bt + (size_t)cur.pn * tstep + (size_t)cur.ko * 2;
    S.a_ready(cur);
    if constexpr (SP2) {
        PG8_STAGE(PG8_SB(0, 0), cB, voffB); PG8_STAGE(PG8_SB(0, 1), cB + hstep, voffB); PG8_STAGE(PG8_SA(0, 0), cA, voffA); PG8_STAGE(PG8_SA(0, 1), cA + hstep, voffA);
        if (wr == 1) PG8_BAR;
        PG8_WAIT_V(2); PG8_BAR;
        PG8_STAGE(PG8_SB(1, 0), cB + kstep, voffB); PG8_STAGE(PG8_SA(1, 0), cA + kstep, voffA); PG8_STAGE(PG8_SB(1, 1), cB + hstep + kstep, voffB);
        PG8_WAIT_V(6); PG8_BAR;
    } else {
        PG8_STAGE(PG8_SB(0, 0), cB, voffB); PG8_STAGE(PG8_SA(0, 0), cA, voffA); PG8_STAGE(PG8_SB(0, 1), cB + hstep, voffB); PG8_STAGE(PG8_SA(0, 1), cA + hstep, voffA);
        if (wr == 1) PG8_BAR;
        PG8_WAIT_V(4); PG8_BAR;
        PG8_STAGE(PG8_SB(1, 0), cB + kstep, voffB); PG8_STAGE(PG8_SA(1, 0), cA + kstep, voffA); PG8_STAGE(PG8_SB(1, 1), cB + hstep + kstep, voffB);
        PG8_WAIT_V(6); PG8_BAR;
    }
    for (;;) {
        const bool has_next = S.next(ui + 1, nxt);
        const char* nA = has_next ? (const char*)g.A + (size_t)nxt.pm * tstep + (size_t)nxt.ko * 2 : cA; const char* nB = has_next ? (const char*)g.Bt + (size_t)nxt.pn * tstep + (size_t)nxt.ko * 2 : cB;
        const int ntu = cur.kt ? cur.kt : nt;
        for (int t = 0; t < ntu; t += 2) {
            const bool last = (t == ntu - 2);
            const char* a1 = cA + (size_t)(t + 1) * kstep;
            const char* a2 = last ? nA : cA + (size_t)(t + 2) * kstep; const char* b2 = last ? nB : cB + (size_t)(t + 2) * kstep;
            const char* a3 = a2 + kstep; const char* b3 = b2 + kstep;
            if (last && has_next) S.a_ready(nxt);
            if constexpr (SP2) {
            PG8_LDB(B0, 0, 0); PG8_LDB(B1, 0, 1); PG8_SCHED; PG8_LDA(At, 0, 0); PG8_STAGE(PG8_SA(1, 1), a1 + hstep, voffA);
            PG8_WAIT_V(8); PG8_WAIT_L(0); PG8_BAR; PG8_MMA(0, 0, At, B0); PG8_MMA(0, 1, At, B1); PG8_BAR; PG8_SCHED;
            PG8_LDA(At, 0, 1); PG8_STAGE(PG8_SB(0, 0), b2, voffB); PG8_STAGE(PG8_SB(0, 1), b2 + hstep, voffB); PG8_STAGE(PG8_SA(0, 0), a2, voffA);
            PG8_WAIT_V(8); PG8_WAIT_L(0); PG8_BAR; PG8_MMA(1, 0, At, B0); PG8_MMA(1, 1, At, B1); PG8_BAR; PG8_SCHED;
            PG8_LDB(B0, 1, 0); PG8_LDB(B1, 1, 1); PG8_SCHED; PG8_LDA(At, 1, 0); PG8_STAGE(PG8_SA(0, 1), a2 + hstep, voffA);
            PG8_WAIT_V(8); PG8_WAIT_L(0); PG8_BAR; PG8_MMA(0, 0, At, B0); PG8_MMA(0, 1, At, B1); PG8_BAR; PG8_SCHED;
            PG8_LDA(At, 1, 1); PG8_STAGE(PG8_SB(1, 0), b3, voffB); PG8_STAGE(PG8_SB(1, 1), b3 + hstep, voffB); PG8_STAGE(PG8_SA(1, 0), a3, voffA);
            PG8_WAIT_V(8); PG8_WAIT_L(0); PG8_BAR; PG8_MMA(1, 0, At, B0); PG8_MMA(1, 1, At, B1); PG8_BAR; PG8_SCHED;
            } else {
            PG8_LDB(B0, 0, 0); PG8_SCHED; PG8_LDA(At, 0, 0); PG8_STAGE(PG8_SA(1, 1), a1 + hstep, voffA);
            PG8_WAIT_L(8); PG8_BAR; PG8_WAIT_L(0); PG8_MMA(0, 0, At, B0); PG8_BAR; PG8_SCHED;
            PG8_LDB(B1, 0, 1); PG8_STAGE(PG8_SB(0, 0), b2, voffB);
            PG8_BAR; PG8_WAIT_L(0); PG8_MMA(0, 1, At, B1); PG8_BAR;
            PG8_LDA(At, 0, 1); PG8_STAGE(PG8_SA(0, 0), a2, voffA);
            PG8_BAR; PG8_WAIT_L(0); PG8_MMA(1, 0, At, B0); PG8_BAR; PG8_SCHED;
            PG8_STAGE(PG8_SB(0, 1), b2 + hstep, voffB);
            PG8_WAIT_V(6); PG8_BAR; PG8_MMA(1, 1, At, B1); PG8_BAR;
            PG8_LDB(B0, 1, 0); PG8_SCHED; PG8_LDA(At, 1, 0); PG8_STAGE(PG8_SA(0, 1), a2 + hstep, voffA);
            PG8_WAIT_L(8); PG8_BAR; PG8_WAIT_L(0); PG8_MMA(0, 0, At, B0); PG8_BAR; PG8_SCHED;
            PG8_LDB(B1, 1, 1); PG8_STAGE(PG8_SB(1, 0), b3, voffB);
            PG8_BAR; PG8_WAIT_L(0); PG8_MMA(0, 1, At, B1); PG8_BAR;
            PG8_LDA(At, 1, 1); PG8_STAGE(PG8_SA(1, 0), a3, voffA);
            PG8_BAR; PG8_WAIT_L(0); PG8_MMA(1, 0, At, B0); PG8_BAR; PG8_SCHED;
            PG8_STAGE(PG8_SB(1, 1), b3 + hstep, voffB);
            PG8_WAIT_V(6); PG8_BAR; PG8_MMA(1, 1, At, B1); PG8_BAR;
            }
        }
        if constexpr (ALIGN_EPI) { if (wr == 0) PG8_BAR; }
        if constexpr (!Epi::AFTER_DRAIN) { E(acc, cur, wr, wc, fr, fq); S.done(cur); }
        if (!has_next) break;
#pragma unroll
        for (int a = 0; a < 2; ++a)
#pragma unroll
            for (int b = 0; b < 2; ++b)
#pragma unroll
                for (int m = 0; m < 4; ++m)
#pragma unroll
                    for (int n = 0; n < 2; ++n) acc[a][b][m][n] = (f32x4){0.f, 0.f, 0.f, 0.f};
        cur = nxt; cA = nA; cB = nB; ++ui;
        if constexpr (ALIGN_EPI) { if (wr == 1) PG8_BAR; }
    }
    PG8_WAIT_V(0);
    if constexpr (!ALIGN_EPI) { if (wr == 0) PG8_BAR; }
    PG8_BAR;
    if constexpr (Epi::AFTER_DRAIN) { E.fused(acc, cur, wr, wc, fr, fq, lds, wid, lane); S.done(cur); }
#undef PG8_SA
#undef PG8_SB
#undef PG8_STAGE
#undef PG8_LDA
#undef PG8_LDB
#undef PG8_MMA
#undef PG8_WAIT_V
#undef PG8_WAIT_L
#undef PG8_BAR
#undef PG8_SCHED
}
}
namespace att {
using bf16 = unsigned short;
constexpr int   D = 128, NW = 8, QBLK = 32, KVBLK = 64;
constexpr float SCALE = 0.088388347648318440f;
constexpr float THR = 8.f;
constexpr int SDEPTH = 2;
constexpr size_t SHM_V = KVBLK * D * 2, SHM_K = KVBLK * D * 2, SHM_ATTN = 3 * SHM_V + 3 * SHM_K + NW * 64 * 4;
__device__ __forceinline__ unsigned short f2bf_rne(float f) { unsigned u = __builtin_bit_cast(unsigned, f); return (unsigned short)((u + 0x7fffu + ((u >> 16) & 1u)) >> 16); }
using bf16x8 = __attribute__((ext_vector_type(8))) short;
using s16x4  = __attribute__((ext_vector_type(4))) short;
using f32x16 = __attribute__((ext_vector_type(16))) float;
using f32x8  = __attribute__((ext_vector_type(8))) float;
using u32x4  = __attribute__((ext_vector_type(4))) unsigned;
#define KSWZ(row, colB) ((row) * 256 + ((colB) ^ (((row) & 7) << 4)))
#define SBAR() __builtin_amdgcn_sched_barrier(0)
__device__ __forceinline__ int crow(int r, int hi) { return (r & 3) + 8 * (r >> 2) + 4 * hi; }
__device__ __forceinline__ unsigned cvtpk(float lo, float hi) {
  unsigned r; asm volatile("v_cvt_pk_bf16_f32 %0, %1, %2" : "=v"(r) : "v"(lo), "v"(hi)); return r;
}
template <typename TIn> struct Stage;
template <> struct Stage<bf16>  { using T = bf16x8;
  __device__ static __forceinline__ T ld8(const bf16* p) { return *reinterpret_cast<const bf16x8*>(p); }
  __device__ static __forceinline__ bf16x8 tobf(T x) { return x; } };
template <> struct Stage<float> { using T = f32x8;
  __device__ static __forceinline__ T ld8(const float* p) { return *reinterpret_cast<const f32x8*>(p); }
  __device__ static __forceinline__ bf16x8 tobf(T x) {
    u32x4 w = {cvtpk(x[0], x[1]), cvtpk(x[2], x[3]), cvtpk(x[4], x[5]), cvtpk(x[6], x[7])}; return *reinterpret_cast<bf16x8*>(&w); } };

__device__ __forceinline__ void partialSM(f32x16& p0, f32x16& p1, float& m_reg, float& mn, float& alpha) {
  constexpr float C = SCALE * 1.4426950408889634f;
  float pmax = p0[0]; for (int r = 1; r < 16; ++r) pmax = fmaxf(pmax, p0[r]); for (int r = 0; r < 16; ++r) pmax = fmaxf(pmax, p1[r]);
  { auto rr = __builtin_amdgcn_permlane32_swap(__float_as_uint(pmax), __float_as_uint(pmax), false, false);
    pmax = fmaxf(__uint_as_float(rr[0]), __uint_as_float(rr[1])); }
  if (__builtin_expect(__all(pmax - m_reg <= THR / SCALE), 1)) { mn = m_reg; alpha = 1.f; }
  else { mn = fmaxf(m_reg, pmax); alpha = __builtin_amdgcn_exp2f((m_reg - mn) * C); m_reg = mn; }
  float mnC = -mn * C;
  for (int r = 0; r < 16; ++r) p0[r] = fmaf(p0[r], C, mnC); for (int r = 0; r < 16; ++r) p1[r] = fmaf(p1[r], C, mnC);
  for (int r = 0; r < 16; ++r) p0[r] = __builtin_amdgcn_exp2f(p0[r]);
}
__device__ __forceinline__ void finishSM(f32x16& p0, f32x16& p1, float alpha, float& l_reg, bf16x8& pa0, bf16x8& pa1, bf16x8& pa2, bf16x8& pa3) {
  for (int r = 0; r < 16; ++r) p1[r] = __builtin_amdgcn_exp2f(p1[r]);
  float ps = 0; for (int r = 0; r < 16; ++r) ps += p0[r]; for (int r = 0; r < 16; ++r) ps += p1[r];
  { auto rr = __builtin_amdgcn_permlane32_swap(__float_as_uint(ps), __float_as_uint(ps), false, false);
    ps = __uint_as_float(rr[0]) + __uint_as_float(rr[1]); }
  l_reg = l_reg * alpha + ps;
#define PK4(P, BASE, OUT) do { unsigned a0 = cvtpk(P[BASE + 0], P[BASE + 1]), a1 = cvtpk(P[BASE + 2], P[BASE + 3]);   \
    unsigned b0 = cvtpk(P[BASE + 4], P[BASE + 5]), b1 = cvtpk(P[BASE + 6], P[BASE + 7]);                              \
    auto r0 = __builtin_amdgcn_permlane32_swap(a0, b0, false, false); auto r1 = __builtin_amdgcn_permlane32_swap(a1, b1, false, false); \
    u32x4 w = {r0[0], r1[0], r0[1], r1[1]}; OUT = *reinterpret_cast<bf16x8*>(&w); } while (0)
  PK4(p0, 0, pa0); PK4(p0, 8, pa1); PK4(p1, 0, pa2); PK4(p1, 8, pa3);
#undef PK4
}
template <int NS> __device__ __forceinline__ void qkt(f32x16& p0, f32x16& p1, const bf16* Ks, const bf16x8* qr, int r32, int hi, int d0off) {
  p0 = f32x16{}; p1 = f32x16{};
#pragma unroll
  for (int d0 = 0; d0 < NS; ++d0) { int cb = ((d0 + d0off) * 16 + hi * 8) * 2;
    bf16x8 b0 = *reinterpret_cast<const bf16x8*>((const char*)Ks + KSWZ(r32, cb));
    bf16x8 b1 = *reinterpret_cast<const bf16x8*>((const char*)Ks + KSWZ(32 + r32, cb));
    p0 = __builtin_amdgcn_mfma_f32_32x32x16_bf16(b0, qr[d0], p0, 0, 0, 0);
    p1 = __builtin_amdgcn_mfma_f32_32x32x16_bf16(b1, qr[d0], p1, 0, 0, 0); }
}
__device__ __forceinline__ int v_st(int k, int c) { const int kk = (k & ~0xC) | ((k & 4) << 1) | ((k & 8) >> 1); return ((kk >> 3) * 4 + (c >> 5)) * 512 + ((kk & 7) * 32 + (c & 31)) * 2; }
__device__ __forceinline__ int v_rd_base(int lane) { return ((lane & 3) << 3) | (((lane >> 2) & 3) << 6) | (((lane >> 4) & 1) << 5) | (((lane >> 5) & 1) << 8); }
constexpr int v_rd_off(int d0, int ks, int half) { return d0 * 512 + ks * 4096 + half * 2048; }
template <int OFF> __device__ __forceinline__ s16x4 tr_read(int vb) {
  s16x4 r; asm volatile("ds_read_b64_tr_b16 %0, %1 offset:%2" : "=&v"(r) : "v"(vb), "i"(OFF) : "memory"); return r;
}
template <int D0> __device__ __forceinline__ void pv_one(f32x16& od, int vb, bf16x8 pa0, bf16x8 pa1, bf16x8 pa2, bf16x8 pa3) {
  const s16x4 l0 = tr_read<v_rd_off(D0, 0, 0)>(vb), h0 = tr_read<v_rd_off(D0, 0, 1)>(vb), l1 = tr_read<v_rd_off(D0, 1, 0)>(vb), h1 = tr_read<v_rd_off(D0, 1, 1)>(vb);
  const s16x4 l2 = tr_read<v_rd_off(D0, 2, 0)>(vb), h2 = tr_read<v_rd_off(D0, 2, 1)>(vb), l3 = tr_read<v_rd_off(D0, 3, 0)>(vb), h3 = tr_read<v_rd_off(D0, 3, 1)>(vb);
  asm volatile("s_waitcnt lgkmcnt(0)" ::: "memory"); SBAR();
#define PK(L, H) (bf16x8){L[0], L[1], L[2], L[3], H[0], H[1], H[2], H[3]}
  od = __builtin_amdgcn_mfma_f32_32x32x16_bf16(pa0, PK(l0, h0), od, 0, 0, 0);
  od = __builtin_amdgcn_mfma_f32_32x32x16_bf16(pa1, PK(l1, h1), od, 0, 0, 0);
  od = __builtin_amdgcn_mfma_f32_32x32x16_bf16(pa2, PK(l2, h2), od, 0, 0, 0);
  od = __builtin_amdgcn_mfma_f32_32x32x16_bf16(pa3, PK(l3, h3), od, 0, 0, 0);
#undef PK
}
__device__ __forceinline__ void pv_d0(f32x16* o, int vb, bf16x8 pa0, bf16x8 pa1, bf16x8 pa2, bf16x8 pa3) {
  pv_one<0>(o[0], vb, pa0, pa1, pa2, pa3); pv_one<1>(o[1], vb, pa0, pa1, pa2, pa3); pv_one<2>(o[2], vb, pa0, pa1, pa2, pa3); pv_one<3>(o[3], vb, pa0, pa1, pa2, pa3);
}

template <int LDQ, int LDK, int LDO, int NS, bool PAIR = false, bool RING3 = false>
__device__ __forceinline__ void attn_dense_body(const bf16* __restrict__ Qb, const bf16* __restrict__ Kh, const bf16* __restrict__ Vh,
                                                bf16* __restrict__ Ob, int seq, char* lds, int d0off, float* __restrict__ stats = nullptr) {
  using St = Stage<bf16>; using SQ = Stage<bf16>;
  const int tid = threadIdx.x, wid = tid >> 6, lane = tid & 63, r32 = lane & 31, hi = lane >> 5;
  bf16* V_lds = (bf16*)lds; bf16* K_lds = (bf16*)(lds + (RING3 ? 3 : 2) * SHM_V);
  float* ws = (float*)(lds + (RING3 ? 3 : 2) * (SHM_V + SHM_K)) + wid * 64; float* li_l = ws; float* al_l = ws + 32;
  float m_reg = -1e30f, l_reg = 0; f32x16 o[4] = {}; bf16x8 qr[NS];
  const int wrow = PAIR ? (wid & 3) : wid, comp = PAIR ? (wid >> 2) : 0; if (PAIR) d0off = 4 * comp;
  const bf16* Qw = Qb + comp * 128 + (long)(wrow * QBLK + r32) * LDQ + hi * 8;
#pragma unroll
  for (int d0 = 0; d0 < NS; ++d0) qr[d0] = SQ::tobf(SQ::ld8(Qw + (d0 + d0off) * 16));
  const int sr = tid >> 4, sc = (tid & 15) * 8, vst0 = v_st(sr, sc), vst1 = v_st(32 + sr, sc);
  const int vb0 = (int)(uintptr_t)V_lds + v_rd_base(lane);
  struct { typename St::T vs0, vs1, ks0, ks1; } sr_[SDEPTH];
#define SLOAD(i, k0) do { sr_[i].vs0 = St::ld8(&Vh[(long)((k0) + sr) * LDK + sc]); sr_[i].vs1 = St::ld8(&Vh[(long)((k0) + 32 + sr) * LDK + sc]); \
    sr_[i].ks0 = St::ld8(&Kh[(long)((k0) + sr) * LDK + sc]); sr_[i].ks1 = St::ld8(&Kh[(long)((k0) + 32 + sr) * LDK + sc]); } while (0)
#define SWRITE(b, i) do { *(bf16x8*)((char*)V_lds + (b) * SHM_V + vst0) = St::tobf(sr_[i].vs0);          \
    *(bf16x8*)((char*)V_lds + (b) * SHM_V + vst1) = St::tobf(sr_[i].vs1); int kc = sc * 2;               \
    *(bf16x8*)((char*)K_lds + (b) * SHM_K + KSWZ(sr, kc)) = St::tobf(sr_[i].ks0);                       \
    *(bf16x8*)((char*)K_lds + (b) * SHM_K + KSWZ(32 + sr, kc)) = St::tobf(sr_[i].ks1); } while (0)
#define SWAIT() do { if constexpr (SDEPTH == 2) asm volatile("s_waitcnt vmcnt(4)" ::: "memory"); else asm volatile("s_waitcnt vmcnt(0)" ::: "memory"); } while (0)
#define RESC(a) do { if (__any((a) < 1.f)) { if (hi == 0) al_l[r32] = (a); asm volatile("s_waitcnt lgkmcnt(0)" ::: "memory"); \
    for (int d = 0; d < 4; ++d) for (int r = 0; r < 16; ++r) o[d][r] *= al_l[crow(r, hi)]; } } while (0)
  f32x16 pA0, pA1, pB0, pB1; float mnA, mnB, alA, alB; bf16x8 pa0, pa1, pa2, pa3; const int NT = seq / KVBLK;
  constexpr int SE = 0, SO = SDEPTH - 1;
  if constexpr (RING3) {
  SLOAD(SE, 0); asm volatile("s_waitcnt vmcnt(0)" ::: "memory"); SWRITE(0, SE); __syncthreads();
  qkt<NS>(pA0, pA1, K_lds, qr, r32, hi, d0off); partialSM(pA0, pA1, m_reg, mnA, alA);
  SLOAD(SO, KVBLK); if constexpr (SDEPTH == 2) { if (2 < NT) SLOAD(SE, 2 * KVBLK); }
  SWAIT(); SWRITE(1, SO); __syncthreads();
  int bp = 0, bq = 1, bw = 2;
  for (int j = 1; j + 1 < NT; j += 2) {
    SBAR(); qkt<NS>(pB0, pB1, (bf16*)((char*)K_lds + bq * SHM_K), qr, r32, hi, d0off);
    finishSM(pA0, pA1, alA, l_reg, pa0, pa1, pa2, pa3); SBAR();
    SLOAD(SO, (j + SDEPTH) * KVBLK); SBAR();
    pv_d0(o, vb0 + bp * (int)SHM_V, pa0, pa1, pa2, pa3); partialSM(pB0, pB1, m_reg, mnB, alB);
    SWAIT(); SWRITE(bw, SE);
    RESC(alB); __syncthreads();
    { const int t_ = bp; bp = bq; bq = bw; bw = t_; }
    SBAR(); qkt<NS>(pA0, pA1, (bf16*)((char*)K_lds + bq * SHM_K), qr, r32, hi, d0off);
    finishSM(pB0, pB1, alB, l_reg, pa0, pa1, pa2, pa3); SBAR();
    if (SDEPTH == 1 || j + 3 < NT) SLOAD(SE, (j + 1 + SDEPTH) * KVBLK); SBAR();
    pv_d0(o, vb0 + bp * (int)SHM_V, pa0, pa1, pa2, pa3); partialSM(pA0, pA1, m_reg, mnA, alA);
    SWAIT(); SWRITE(bw, SO);
    RESC(alA); __syncthreads();
    { const int t_ = bp; bp = bq; bq = bw; bw = t_; }
  }
  SBAR(); qkt<NS>(pB0, pB1, (bf16*)((char*)K_lds + bq * SHM_K), qr, r32, hi, d0off);
  finishSM(pA0, pA1, alA, l_reg, pa0, pa1, pa2, pa3); SBAR();
  pv_d0(o, vb0 + bp * (int)SHM_V, pa0, pa1, pa2, pa3); partialSM(pB0, pB1, m_reg, mnB, alB);
  RESC(alB);
  finishSM(pB0, pB1, alB, l_reg, pa0, pa1, pa2, pa3); SBAR();
  pv_d0(o, vb0 + bq * (int)SHM_V, pa0, pa1, pa2, pa3);
  } else {
  SLOAD(SE, 0); asm volatile("s_waitcnt vmcnt(0)" ::: "memory"); SWRITE(0, SE); __syncthreads();
  qkt<NS>(pA0, pA1, K_lds, qr, r32, hi, d0off); partialSM(pA0, pA1, m_reg, mnA, alA);
  SLOAD(SO, KVBLK); if constexpr (SDEPTH == 2) { if (2 < NT) SLOAD(SE, 2 * KVBLK); }
  SWAIT(); SWRITE(1, SO); __syncthreads();
  for (int j = 1; j + 1 < NT; j += 2) {
    SBAR(); qkt<NS>(pB0, pB1, (bf16*)((char*)K_lds + SHM_K), qr, r32, hi, d0off);
    finishSM(pA0, pA1, alA, l_reg, pa0, pa1, pa2, pa3); SBAR();
    SLOAD(SO, (j + SDEPTH) * KVBLK); SBAR();
    pv_d0(o, vb0, pa0, pa1, pa2, pa3); partialSM(pB0, pB1, m_reg, mnB, alB);
    __syncthreads(); SWAIT(); SWRITE(0, SE);
    RESC(alB); __syncthreads();
    SBAR(); qkt<NS>(pA0, pA1, K_lds, qr, r32, hi, d0off);
    finishSM(pB0, pB1, alB, l_reg, pa0, pa1, pa2, pa3); SBAR();
    if (SDEPTH == 1 || j + 3 < NT) SLOAD(SE, (j + 1 + SDEPTH) * KVBLK); SBAR();
    pv_d0(o, vb0 + (int)SHM_V, pa0, pa1, pa2, pa3); partialSM(pA0, pA1, m_reg, mnA, alA);
    __syncthreads(); SWAIT(); SWRITE(1, SO);
    RESC(alA); __syncthreads();
  }
  SBAR(); qkt<NS>(pB0, pB1, (bf16*)((char*)K_lds + SHM_K), qr, r32, hi, d0off);
  finishSM(pA0, pA1, alA, l_reg, pa0, pa1, pa2, pa3); SBAR();
  pv_d0(o, vb0, pa0, pa1, pa2, pa3); partialSM(pB0, pB1, m_reg, mnB, alB);
  __syncthreads(); RESC(alB);
  finishSM(pB0, pB1, alB, l_reg, pa0, pa1, pa2, pa3); SBAR();
  pv_d0(o, vb0 + (int)SHM_V, pa0, pa1, pa2, pa3);
  }
  if (stats && hi == 0) { stats[(comp * 128 + wrow * QBLK + r32) * 2] = m_reg; stats[(comp * 128 + wrow * QBLK + r32) * 2 + 1] = l_reg; }
  if (hi == 0) li_l[r32] = l_reg; asm volatile("s_waitcnt lgkmcnt(0)" ::: "memory");
  float rli[16];
#pragma unroll
  for (int r = 0; r < 16; ++r) rli[r] = __builtin_amdgcn_rcpf(li_l[crow(r, hi)]);
  bf16* Ow = Ob + comp * 128 + (long)(wrow * QBLK) * LDO;
#pragma unroll
  for (int r = 0; r < 16; ++r) { int orow = crow(r, hi);
    for (int d0 = 0; d0 < 4; ++d0) Ow[(long)orow * LDO + d0 * 32 + r32] = f2bf_rne(o[d0][r] * rli[r]); }
#undef SLOAD
#undef SWRITE
#undef SWAIT
#undef RESC
}
}

constexpr int NWAVES = 8;
constexpr int D = 1024, NB = 2, SL = 8192, CT = 256, TP = SL + CT, MR = NB * TP, ML = NB * SL;
constexpr int E_IN = 3072, O_IN = 3456, O_INP = 3584, FFH = 2816, NE = 8, EH = 3584;
constexpr int NCH = TP / 128;
constexpr int NPH = 24;
constexpr int N_LAUNCHES = MK_N_LAUNCHES;
constexpr float NORM_EPS = 1e-6f, RWKV_LN_EPS = 64e-5f;
constexpr float LAM_INIT = 0.3555090676f;
constexpr int MOE_ROWS = 2 * ML + NE * 256;

enum ScanArr { SA_R = 0, SA_V, SA_K, SA_G, SA_AN, SA_L0, SA_L1, SA_A0, SA_A1, SA_N };
constexpr size_t MiB = 1u << 20;
constexpr size_t WS_CTL = 0, CTL_ZERO_BYTES = 20 * 1024;
constexpr size_t WS_MODV = 1 * MiB;
constexpr size_t WS_MODP = 1 * MiB + 256 * 1024;
constexpr int MODP_STRIDE = 2 * 3 * 6144;
static_assert(WS_MODP + (size_t)4 * MODP_STRIDE * 4 <= 2 * MiB, "mod partials");
constexpr size_t WS_ROUTE = 2 * MiB;
constexpr size_t WS_TILEE = 2 * MiB + 768 * 1024;
constexpr size_t WS_WL = 3 * MiB;
constexpr size_t WS_WIN0 = 5 * MiB, WS_WOUT0 = 11 * MiB, WS_WGU0 = 13 * MiB, WS_WD0 = 24 * MiB;
constexpr size_t WS_WIN1 = 30 * MiB, WS_WOUT1 = 37 * MiB;
constexpr size_t WS_XR = 39 * MiB;
constexpr size_t WS_H = 105 * MiB;
constexpr size_t WS_PRJ0 = 138 * MiB;
constexpr size_t WS_MIX0 = 237 * MiB;
constexpr size_t WS_UT = 270 * MiB;
constexpr size_t WS_Y0 = 270 * MiB;
constexpr size_t WS_ACT0 = 138 * MiB;
constexpr size_t WS_KV1 = 138 * MiB;
constexpr size_t WS_RWQ = 171 * MiB;
constexpr size_t WS_QD = 254 * MiB;
constexpr size_t WS_SCAN = 286 * MiB;
constexpr size_t SCAN_ARR = (size_t)MR * 512 * 2;
constexpr size_t WS_LIN = 468 * MiB;
constexpr size_t WS_OB = 171 * MiB;
constexpr size_t WS_YS = 203 * MiB;
constexpr size_t WS_Y1 = 138 * MiB;
constexpr size_t WS_H2 = 310 * MiB;
constexpr size_t WS_WMOE_D = 349 * MiB, WS_WMOE_GU = 405 * MiB;
constexpr size_t WS_AG = 242 * MiB;
constexpr size_t WS_ACT1 = 4 * MiB;
constexpr size_t WS_CKP0 = 105 * MiB, WS_CKQ = 435 * MiB, WS_CKRT = 468 * MiB, WS_CKC4A = 5 * MiB, WS_CKC4B = 235 * MiB, WS_CKGAM = 22 * MiB;
constexpr size_t WS_OB2 = 352 * MiB, WS_ASTAT = 374 * MiB;
constexpr size_t WS_Y2F = 310 * MiB;
constexpr size_t WS_Y0F = 340 * MiB;
constexpr size_t WS_PRJF = 364 * MiB;
constexpr size_t WS_END = 517 * MiB;
static_assert(WS_OB2 >= WS_SCAN + 4 * SCAN_ARR && WS_ASTAT + (size_t)1024 * 256 * 8 <= WS_SCAN + SA_N * SCAN_ARR, "split-KV buffers");
static_assert(WS_CKQ + (size_t)4224 * 8192 <= WS_CKRT && WS_CKRT + (size_t)4224 * 8192 <= WS_END && WS_CKC4A + (size_t)2112 * 8192 <= WS_CKGAM && WS_CKGAM + (size_t)4224 * 256 <= WS_WIN1 && WS_CKC4B + (size_t)2112 * 8192 <= WS_QD && WS_CKC4B >= WS_YS + (size_t)2 * ML * 512 * 2, "ck map");
static_assert(WS_WL + (size_t)2560 * 384 * 2 <= WS_WIN0 && WS_WD0 + (size_t)D * FFH * 2 <= WS_WIN1 && WS_WOUT1 + (size_t)D * D * 2 <= WS_XR, "ws map A");
static_assert(WS_XR + (size_t)MR * D * 4 <= WS_H && WS_H + (size_t)MR * D * 2 <= WS_PRJ0 && WS_PRJ0 + (size_t)MR * E_IN * 2 <= WS_MIX0 && WS_MIX0 + (size_t)MR * D * 2 <= WS_UT, "ws map B");
static_assert(WS_UT + (size_t)NB * 4 * NCH * 2 * 16384 * 4 <= WS_END && WS_ACT0 + (size_t)MR * FFH * 2 <= WS_MIX0, "ws map C");
static_assert((size_t)NB * 4 * NCH * 2 * 16384 * 2 <= (size_t)MR * D * 2, "ST fits in H");
static_assert(WS_KV1 + (size_t)MR * 1024 * 2 <= WS_RWQ && WS_RWQ + (size_t)MR * 2560 * 2 <= WS_QD && WS_QD + (size_t)ML * 1024 * 2 <= WS_SCAN && WS_SCAN + SA_N * SCAN_ARR <= WS_LIN && WS_LIN + (size_t)MR * 384 * 2 <= WS_END, "ws map D");
static_assert(WS_OB + (size_t)ML * 1024 * 2 <= WS_YS && WS_YS + (size_t)2 * ML * 512 * 2 <= WS_AG, "ws map E");
static_assert(WS_ACT1 + (size_t)MOE_ROWS * EH * 2 <= WS_AG && WS_AG + (size_t)MOE_ROWS * D * 2 <= WS_H2 && WS_H2 + (size_t)ML * D * 2 <= WS_WMOE_GU, "ws map F");
static_assert(WS_H2 + (size_t)ML * D * 2 <= WS_WMOE_D && WS_WMOE_D + (size_t)NE * D * EH * 2 <= WS_WMOE_GU && WS_WMOE_GU + (size_t)NE * 2 * EH * D * 2 <= WS_END, "ws map G");
constexpr int CW_TMO = 0, CW_CODE = 1;
constexpr int CW_BAR = 64;
constexpr int CW_QUEUE = 3584;
constexpr int CW_CNT = 3712;
static_assert((CW_CNT + 64 * NE) * 4 <= (int)CTL_ZERO_BYTES, "CTL");

constexpr int RING_OFF = 0, RING_BYTES = 155648;
constexpr int LDSCTL_OFF = RING_BYTES, MISC_OFF = LDSCTL_OFF + 320;
constexpr int LDS_BYTES = 156672;
static_assert(MISC_OFF + 128 <= LDS_BYTES, "LDS map");
#define GAS __attribute__((address_space(1)))
#define LAS __attribute__((address_space(3)))
typedef unsigned short bf16;
typedef unsigned v4u __attribute__((ext_vector_type(4)));
typedef float f32x4 __attribute__((ext_vector_type(4)));
typedef short bf16x8 __attribute__((ext_vector_type(8)));
typedef GAS unsigned gu32;
typedef GAS unsigned long long gu64;
#define RLX_AGENT __ATOMIC_RELAXED, __HIP_MEMORY_SCOPE_AGENT
#define LDS_WAIT() asm volatile("s_waitcnt lgkmcnt(0)" ::: "memory")
#define VM_WAIT() asm volatile("s_waitcnt vmcnt(0)" ::: "memory")
__device__ __forceinline__ unsigned long long rt() { return __builtin_amdgcn_s_memrealtime(); }
__device__ __forceinline__ unsigned f2bf(float f) { unsigned u = __builtin_bit_cast(unsigned, f); return (u + 0x7fffu + ((u >> 16) & 1u)) >> 16; }
__device__ __forceinline__ unsigned pk2_sw(float lo, float hi) { return f2bf(lo) | (f2bf(hi) << 16); }
typedef float f32x2c_t __attribute__((ext_vector_type(2))); typedef __bf16 bf16x2c_t __attribute__((ext_vector_type(2)));
__device__ __forceinline__ unsigned pk2(float lo, float hi) { const f32x2c_t v = {lo, hi}; const bf16x2c_t b = __builtin_convertvector(v, bf16x2c_t); return __builtin_bit_cast(unsigned, b); }

#define XB_TMO      128
#define XB_XCNT(j)  (256  + 64 * (j))
#define XB_XSUB(j)  (1280 + 64 * (j))
#define XB_XGEN(j)  (2304 + 64 * (j))
#define XB_TOP      3328
#define XB_TOPGEN   3392
#define XCD_BAR_WORDS 3456
#define XB_SPIN_CAP (1u << 18)

__device__ __forceinline__ unsigned xb_ld(unsigned* p)              { return __hip_atomic_load(p, __ATOMIC_RELAXED, __HIP_MEMORY_SCOPE_AGENT); }
__device__ __forceinline__ unsigned xb_add(unsigned* p, unsigned v) { return __hip_atomic_fetch_add(p, v, __ATOMIC_RELAXED, __HIP_MEMORY_SCOPE_AGENT); }
__device__ __forceinline__ unsigned xb_xcc_id() { return (unsigned)__builtin_amdgcn_s_getreg((3 << 11) | 20) & 0xFu; }
#define XB_SPIN(cond, bar) do { unsigned _sp = 0; while (cond) { __builtin_amdgcn_s_sleep(1); \
    if ((++_sp & 255u) == 0u) { if (xb_ld(&(bar)[XB_TMO])) break; if (_sp > XB_SPIN_CAP) { atomicAdd(&(bar)[XB_TMO], 1u); break; } } } } while (0)

struct XcdBarrier {
    unsigned* bar; unsigned x;
    volatile LAS unsigned* st;
};

__device__ __forceinline__ XcdBarrier xcd_barrier_post(unsigned* bar, volatile LAS unsigned* st) {
    XcdBarrier b; b.bar = bar; b.x = xb_xcc_id(); b.st = st;
    if (threadIdx.x == 0) (void)xb_add(&bar[XB_XCNT(b.x)], 1u);
    return b;
}
__device__ __forceinline__ void xcd_barrier_complete(unsigned* bar, unsigned x, unsigned& nloc, unsigned& nx) {
    const unsigned G = gridDim.x * gridDim.y * gridDim.z;
    unsigned sum, cnt, mine, sp = 0u;
    for (;;) {
        sum = 0u; cnt = 0u; mine = 0u;
#pragma unroll
        for (unsigned j = 0; j < 16; ++j) { const unsigned c = xb_ld(&bar[XB_XCNT(j)]); sum += c; cnt += (c > 0u) ? 1u : 0u; mine = (j == x) ? c : mine; }
        if (sum == G) break;
        __builtin_amdgcn_s_sleep(1);
        if ((++sp & 255u) == 0u) { if (xb_ld(&bar[XB_TMO])) break; if (sp > XB_SPIN_CAP) { atomicAdd(&bar[XB_TMO], 1u); break; } }
    }
    nloc = mine > 0u ? mine : 1u; nx = cnt > 0u ? cnt : 1u;
}

__device__ __forceinline__ void xcd_barrier(const XcdBarrier& b) {
    asm volatile("s_waitcnt vmcnt(0)" ::: "memory");
    __syncthreads();
    if (threadIdx.x == 0) {
        unsigned* bar = b.bar;
        __builtin_amdgcn_s_waitcnt(0);
        unsigned nloc = b.st[0], nx = b.st[1];
        if (nloc == 0u) { xcd_barrier_complete(bar, b.x, nloc, nx); b.st[0] = nloc; b.st[1] = nx; }
        const unsigned old = xb_add(&bar[XB_XSUB(b.x)], 1u);
        const unsigned gen = old / nloc;
        if (old + 1u == (gen + 1u) * nloc) {
            __builtin_amdgcn_fence(__ATOMIC_RELEASE, "agent");
            asm volatile("s_waitcnt vmcnt(0)" ::: "memory");
            const unsigned og = xb_add(&bar[XB_TOP], 1u);
            const unsigned tg = og / nx;
            if (og + 1u == (tg + 1u) * nx) xb_add(&bar[XB_TOPGEN], 1u);
            else XB_SPIN(xb_ld(&bar[XB_TOPGEN]) == tg, bar);
            __builtin_amdgcn_fence(__ATOMIC_ACQUIRE, "agent");
            xb_add(&bar[XB_XGEN(b.x)], 1u);
            asm volatile("s_waitcnt vmcnt(0)" ::: "memory");
        } else {
            XB_SPIN(xb_ld(&bar[XB_XGEN(b.x)]) == gen, bar);
            __builtin_amdgcn_fence(__ATOMIC_ACQUIRE, "agent");
            asm volatile("s_waitcnt vmcnt(0)" ::: "memory");
        }
    }
    __syncthreads();
}


struct Args { const float* in[35]; float* out; unsigned char* ws; int ph_lo, ph_hi; };
enum InIdx { I_X = 0, I_C, I_CTX, I_CCTX, I_MODW, I_MODB, I_NORMG, I_EWIN, I_EWOUT, I_RDEC, I_RNORMG, I_QNORM, I_KNORM, I_FWG, I_FWU, I_FWD, I_OWIN, I_OWOUT, I_DLAM, I_DSUBG,
             I_RMU, I_RW0, I_RW2, I_RA0, I_RA2, I_RG2, I_RKK, I_RKA, I_RRK, I_RLNG, I_RLNB, I_MROUTER, I_MWG, I_MWU, I_MWD };
struct Frame {
    LAS unsigned char* lds; char* ldsg;
    volatile LAS unsigned* MISC; gu32* ctl;
    int tid, lane, wave, vcu, G, gw, NGW;
    unsigned char* ws;
};
typedef float f32x2v __attribute__((ext_vector_type(2)));
typedef unsigned v2u __attribute__((ext_vector_type(2)));
typedef float f32x16 __attribute__((ext_vector_type(16)));
__device__ __forceinline__ float bf2f(unsigned short h) { return __uint_as_float(((unsigned)h) << 16); }
__device__ __forceinline__ float wave_sum_shfl(float v) {
#pragma unroll
    for (int o = 1; o < 64; o <<= 1) v += __shfl_xor(v, o);
    return v;
}
__device__ __forceinline__ float wave_sum(float v) {
    v += __builtin_bit_cast(float, __builtin_amdgcn_update_dpp(0, __builtin_bit_cast(int, v), 0xB1, 0xF, 0xF, true));
    v += __builtin_bit_cast(float, __builtin_amdgcn_update_dpp(0, __builtin_bit_cast(int, v), 0x4E, 0xF, 0xF, true));
    v += __builtin_bit_cast(float, __builtin_amdgcn_update_dpp(0, __builtin_bit_cast(int, v), 0x141, 0xF, 0xF, true));
    v += __builtin_bit_cast(float, __builtin_amdgcn_update_dpp(0, __builtin_bit_cast(int, v), 0x140, 0xF, 0xF, true));
    const int iv = __builtin_bit_cast(int, v);
    return (__builtin_bit_cast(float, __builtin_amdgcn_readlane(iv, 0)) + __builtin_bit_cast(float, __builtin_amdgcn_readlane(iv, 16))) +
           (__builtin_bit_cast(float, __builtin_amdgcn_readlane(iv, 32)) + __builtin_bit_cast(float, __builtin_amdgcn_readlane(iv, 48)));
}
#define DPPF(v, ctrl) __builtin_bit_cast(float, __builtin_amdgcn_update_dpp(0, __builtin_bit_cast(int, (v)), (ctrl), 0xF, 0xF, true))
__device__ __forceinline__ float sum16(float v) { v += DPPF(v, 0x128); v += DPPF(v, 0x124); v += DPPF(v, 0x122); v += DPPF(v, 0x121); return v; }
__device__ __forceinline__ float sum8(float v) { v += DPPF(v, 0xB1); v += DPPF(v, 0x4E); v += DPPF(v, 0x141); return v; }
__device__ __forceinline__ float lane_xor8(float v) { return DPPF(v, 0x128); }
__device__ __forceinline__ float lane_xor4(float v, bool bit2) { const float up = DPPF(v, 0x12C), dn = DPPF(v, 0x124); return bit2 ? dn : up; }
__device__ __forceinline__ void unpack8(const v4u w, float (&f)[8]) {
    f[0] = __uint_as_float(w.x << 16); f[1] = __uint_as_float(w.x & 0xffff0000u); f[2] = __uint_as_float(w.y << 16); f[3] = __uint_as_float(w.y & 0xffff0000u);
    f[4] = __uint_as_float(w.z << 16); f[5] = __uint_as_float(w.z & 0xffff0000u); f[6] = __uint_as_float(w.w << 16); f[7] = __uint_as_float(w.w & 0xffff0000u); }
__device__ __forceinline__ v4u pack8_sw(const float (&f)[8]) { v4u w; w.x = pk2_sw(f[0], f[1]); w.y = pk2_sw(f[2], f[3]); w.z = pk2_sw(f[4], f[5]); w.w = pk2_sw(f[6], f[7]); return w; }
__device__ __forceinline__ v4u pack8(const float (&f)[8]) { v4u w; w.x = pk2(f[0], f[1]); w.y = pk2(f[2], f[3]); w.z = pk2(f[4], f[5]); w.w = pk2(f[6], f[7]); return w; }
__device__ __forceinline__ f32x4 ld_bf4(const bf16* p) { const v2u w = *(const v2u*)p; return (f32x4){__uint_as_float(w.x << 16), __uint_as_float(w.x & 0xffff0000u), __uint_as_float(w.y << 16), __uint_as_float(w.y & 0xffff0000u)}; }
template <class T> __device__ __forceinline__ T ldnt(const T* p) { return __builtin_nontemporal_load(p); }
__device__ __forceinline__ f32x4 ld_bf4_nt(const bf16* p) { const v2u w = ldnt((const v2u*)p); return (f32x4){__uint_as_float(w.x << 16), __uint_as_float(w.x & 0xffff0000u), __uint_as_float(w.y << 16), __uint_as_float(w.y & 0xffff0000u)}; }
__device__ __forceinline__ void st_bf4(bf16* p, const f32x4 v) { v2u w; w.x = pk2(v[0], v[1]); w.y = pk2(v[2], v[3]); *(v2u*)p = w; }
template <class T> __device__ __forceinline__ void stnt(T* p, const T v) { __builtin_nontemporal_store(v, p); }
__device__ __forceinline__ float sigmoidf_(float x) { return __builtin_amdgcn_rcpf(1.0f + __builtin_amdgcn_exp2f(-1.44269504089f * x)); }
__device__ __forceinline__ float siluf_(float x) { return x * __builtin_amdgcn_rcpf(1.0f + __builtin_amdgcn_exp2f(-1.44269504089f * x)); }
__device__ __forceinline__ float sq4(const f32x4 v) { return (v[0] * v[0] + v[1] * v[1]) + (v[2] * v[2] + v[3] * v[3]); }

struct TrV { f32x4 v[8]; };
__device__ __forceinline__ void tr_load(const float* W, int ldw, int k0, int nsrc0, int lane, TrV& T) {
    const int rr = lane >> 3, c4 = 4 * (lane & 7);
#pragma unroll
    for (int i = 0; i < 8; ++i) T.v[i] = __builtin_nontemporal_load((const f32x4*)(W + (size_t)(k0 + rr + 8 * i) * ldw + nsrc0 + c4));
}
__device__ __forceinline__ void tr_store(const TrV& T, int k0, bf16* WT, int ldt, int ndst0, LAS float* scr, int lane, bool nt = false) {
    { const int rr = lane >> 3, c4 = 4 * (lane & 7);
#pragma unroll
      for (int i = 0; i < 8; ++i)
#pragma unroll
          for (int j = 0; j < 4; ++j) scr[(rr + 8 * i) * 33 + c4 + j] = T.v[i][j]; }
    LDS_WAIT(); asm volatile("" ::: "memory");
    const int c = lane & 7;
#pragma unroll
    for (int j = 0; j < 4; ++j) { const int n = (lane >> 3) + 8 * j; const LAS float* s = scr + (8 * c) * 33 + n;
        v4u o; o.x = pk2(s[0 * 33], s[1 * 33]); o.y = pk2(s[2 * 33], s[3 * 33]); o.z = pk2(s[4 * 33], s[5 * 33]); o.w = pk2(s[6 * 33], s[7 * 33]);
        if (nt) __builtin_nontemporal_store(o, (GAS v4u*)(WT + (size_t)(ndst0 + n) * ldt + k0 + 8 * c)); else *(GAS v4u*)(WT + (size_t)(ndst0 + n) * ldt + k0 + 8 * c) = o; }
    LDS_WAIT(); asm volatile("" ::: "memory");
}
__device__ __forceinline__ void tr_item(const float* W, int ldw, int k0, int nsrc0, bf16* WT, int ldt, int ndst0, LAS float* scr, int lane) {
    TrV T; tr_load(W, ldw, k0, nsrc0, lane, T); tr_store(T, k0, WT, ldt, ndst0, scr, lane);
}
__device__ __forceinline__ void tr_plain(const float* W, int K, int N, bf16* WT, LAS float* scr, int item, int lane) {
    const int nblk = N / 32, kb = item / nblk, nb = item % nblk; tr_item(W, N, 64 * kb, 32 * nb, WT, K, 32 * nb, scr, lane);
}
__device__ __forceinline__ void tr_gu(const float* Wg, const float* Wu, int K, int HID, bf16* WT, LAS float* scr, int item, int lane) {
    const int nblk = 2 * HID / 32, kb = item / nblk, nb = item % nblk, nd = 32 * nb, t = nd / 256, w = nd % 256;
    const bool up = w >= 128; tr_item(up ? Wu : Wg, HID, 64 * kb, 128 * t + (up ? w - 128 : w), WT, K, nd, scr, lane);
}
struct TrA { const float* W; int ldw, k0, nsrc0; bf16* WT; int ldt, ndst0; };
__device__ __forceinline__ TrA tr_plain_addr(const float* W, int K, int N, bf16* WT, int item) { const int nblk = N / 32, kb = item / nblk, nb = item % nblk; return TrA{W, N, 64 * kb, 32 * nb, WT, K, 32 * nb}; }
__device__ __forceinline__ TrA tr_gu_addr(const float* Wg, const float* Wu, int K, int HID, bf16* WT, int item) {
    const int nblk = 2 * HID / 32, kb = item / nblk, nb = item % nblk, nd = 32 * nb, t = nd / 256, w = nd % 256; const bool up = w >= 128;
    return TrA{up ? Wu : Wg, HID, 64 * kb, 128 * t + (up ? w - 128 : w), WT, K, nd}; }
__device__ __forceinline__ void p0_prologue(const Frame& F, const Args& A) {
    LAS float* scr = (LAS float*)(F.lds + RING_OFF + F.wave * 16384);
    unsigned char* ws = F.ws;
    for (int u = F.vcu; u < 192; u += F.G) {
        const int l = u / 96, rem = u % 96, cb = rem >> 2, kq = rem & 3, col = 256 * cb + 4 * F.lane, kw = 32 * F.wave;
        LAS f32x4* part = (LAS f32x4*)(F.lds + RING_OFF);
        LAS float* SLU = (LAS float*)(F.lds + RING_OFF + 32768);
        const float* W = A.in[I_MODW] + (size_t)l * D * 6144 + (size_t)(256 * kq + kw) * 6144 + col;
        f32x4 w[32];
#pragma unroll
        for (int j = 0; j < 32; ++j) w[j] = __builtin_nontemporal_load((const f32x4*)(W + (size_t)j * 6144));
        for (int i = F.tid; i < 768; i += NWAVES * 64) { const int v = i >> 8, k = 256 * kq + (i & 255); SLU[i] = siluf_(v == 0 ? A.in[I_C][k] : v == 1 ? A.in[I_C][1024 + k] : A.in[I_CCTX][k]); }
        __syncthreads();
        f32x4 a0 = {0.f, 0.f, 0.f, 0.f}, a1 = a0, a2 = a0;
#pragma unroll
        for (int j = 0; j < 32; ++j) { a0 += w[j] * SLU[kw + j]; a1 += w[j] * SLU[256 + kw + j]; a2 += w[j] * SLU[512 + kw + j]; }
        part[(F.wave * 3 + 0) * 64 + F.lane] = a0; part[(F.wave * 3 + 1) * 64 + F.lane] = a1; part[(F.wave * 3 + 2) * 64 + F.lane] = a2;
        __syncthreads();
        if (F.wave < 3) { f32x4 s = {0.f, 0.f, 0.f, 0.f}; if (kq == 0) s = *(const f32x4*)(A.in[I_MODB] + l * 6144 + col);
#pragma unroll
            for (int w8 = 0; w8 < 8; ++w8) s += part[(w8 * 3 + F.wave) * 64 + F.lane];
            *(f32x4*)((float*)(ws + WS_MODP) + (size_t)kq * MODP_STRIDE + (size_t)(l * 3 + F.wave) * 6144 + col) = s; }
        __syncthreads();
    }
    constexpr int I0 = (D / 64) * (E_IN / 32);
    for (int it = F.gw; it < I0; it += F.NGW) tr_plain(A.in[I_EWIN], D, E_IN, (bf16*)(ws + WS_WIN0), scr, it, F.lane);
}
__device__ __forceinline__ void p0_rest(const Frame& F, const Args& A, int first) {
    (void)first;
    LAS float* scr = (LAS float*)(F.lds + RING_OFF + F.wave * 16384); unsigned char* ws = F.ws;
    constexpr int I1 = (D / 64) * (D / 32), I2 = (D / 64) * (2 * FFH / 32), I3 = (FFH / 64) * (D / 32), I4 = (D / 64) * (O_IN / 32), I5 = I1;
    constexpr int NITEMS = I1 + I2 + I3 + I4 + I5;
    auto addr = [&](int r) -> TrA {
        if (r >= NITEMS) {
            const int b6 = (r - NITEMS) >> 4, nb = (r - NITEMS) & 15; const float* W; int rowblk, col0;
            if (b6 < 2) { W = A.in[I_RW2] + (size_t)b6 * 64 * 512; rowblk = b6; col0 = 64 * b6; }
            else if (b6 < 4) { W = A.in[I_RA2] + (size_t)(b6 - 2) * 64 * 512; rowblk = b6; col0 = 64 * b6; }
            else { W = A.in[I_RG2] + (size_t)(b6 - 4) * 64 * 512; rowblk = 4; col0 = 256 + 64 * (b6 - 4); }
            return TrA{W, 512, 0, 32 * nb, (bf16*)(ws + WS_WL) + (size_t)(rowblk * 512) * 384 + col0, 384, 32 * nb}; }
        if (r < I1) return tr_plain_addr(A.in[I_EWOUT], D, D, (bf16*)(ws + WS_WOUT0), r); r -= I1;
        if (r < I2) return tr_gu_addr(A.in[I_FWG], A.in[I_FWU], D, FFH, (bf16*)(ws + WS_WGU0), r); r -= I2;
        if (r < I3) return tr_plain_addr(A.in[I_FWD], FFH, D, (bf16*)(ws + WS_WD0), r); r -= I3;
        if (r < I4) return tr_plain_addr(A.in[I_OWIN], D, O_IN, (bf16*)(ws + WS_WIN1), r); r -= I4;
        return tr_plain_addr(A.in[I_OWOUT], D, D, (bf16*)(ws + WS_WOUT1), r); };
    constexpr int NTOT = NITEMS + 96, CH = 2 * NWAVES; static_assert(NTOT % CH == 0, "conversion chunks");
    for (;;) {
        if (F.tid == 0) F.MISC[0] = __hip_atomic_fetch_add((unsigned*)(F.ctl + CW_QUEUE + 104), 1u, RLX_AGENT);
        __syncthreads(); const int c = (int)F.MISC[0]; __syncthreads();
        if (c * CH >= NTOT) break;
        const int it = c * CH + F.wave; const TrA a0 = addr(it), a1 = addr(it + NWAVES);
        TrV T0, T1; tr_load(a0.W, a0.ldw, a0.k0, a0.nsrc0, F.lane, T0); tr_load(a1.W, a1.ldw, a1.k0, a1.nsrc0, F.lane, T1);
        tr_store(T0, a0.k0, a0.WT, a0.ldt, a0.ndst0, scr, F.lane); tr_store(T1, a1.k0, a1.WT, a1.ldt, a1.ndst0, scr, F.lane);
    }
    const int gt = (int)blockIdx.x * (NWAVES * 64) + F.tid, NGT = F.G * NWAVES * 64;
    { bf16* z = (bf16*)(ws + WS_WIN1) + (size_t)O_IN * D; for (int i = gt; i < (O_INP - O_IN) * D / 8; i += NGT) *(v4u*)(z + (size_t)i * 8) = (v4u){0u, 0u, 0u, 0u}; }
    { bf16* wl = (bf16*)(ws + WS_WL);
      for (int i = gt; i < 2560 * 48; i += NGT) {
          const int n = i / 48, g = i % 48, blk = n >> 9, lo = blk < 4 ? 8 * blk : 32, hi = blk < 4 ? lo + 8 : 48;
          if (g < lo || g >= hi) *(v4u*)(wl + (size_t)n * 384 + 8 * g) = (v4u){0u, 0u, 0u, 0u}; } }
}
constexpr int MOE_FILL_E0 = 0, MOE_FILL_NE = NE, MOE_FILL_FREE = 2, NCONS = 32, MOE_IG = (D / 64) * (2 * EH / 32), MOE_FILL_CH = 2 * NWAVES, MOE_FILL_NCH = MOE_FILL_NE * MOE_IG / MOE_FILL_CH;
constexpr int CW_CONSDONE = CW_QUEUE + 100;
static_assert((MOE_FILL_NE * MOE_IG) % MOE_FILL_CH == 0 && MOE_IG % MOE_FILL_CH == 0 && WS_WMOE_GU >= WS_SCAN + (size_t)7 * SCAN_ARR && WS_WMOE_GU + (size_t)MOE_FILL_FREE * 2 * EH * D * 2 <= WS_CKQ, "early gate|up conversion: destination must be dead scan space");
__device__ __forceinline__ void moe_gu_item(const Frame& F, const Args& A, int e, int r, LAS float* scr) {
    tr_gu(A.in[I_MWG] + (size_t)e * D * EH, A.in[I_MWU] + (size_t)e * D * EH, D, EH, (bf16*)(F.ws + WS_WMOE_GU) + (size_t)e * 2 * EH * D, scr, r, F.lane);
}
struct GuAddr { const float* W; int k0, nsrc0, nd; bf16* WT; };
__device__ __forceinline__ GuAddr moe_gu_addr(const Frame& F, const Args& A, int e, int r) {
    constexpr int nblk = 2 * EH / 32; const int kb = r / nblk, nb = r % nblk, nd = 32 * nb, t = nd / 256, w = nd % 256; const bool up = w >= 128;
    return GuAddr{(up ? A.in[I_MWU] : A.in[I_MWG]) + (size_t)e * D * EH, 64 * kb, 128 * t + (up ? w - 128 : w), nd, (bf16*)(F.ws + WS_WMOE_GU) + (size_t)e * 2 * EH * D};
}
__device__ __forceinline__ void moe_gu_fill_chunk(const Frame& F, const Args& A, int c) {
    LAS float* scr = (LAS float*)(F.lds + RING_OFF + F.wave * 16384);
    static_assert(MOE_FILL_CH == 2 * NWAVES, "two items per wave");
    if (c * MOE_FILL_CH >= MOE_FILL_FREE * MOE_IG) {
        if (F.tid == 0) while (__hip_atomic_load((unsigned*)(F.ctl + CW_CONSDONE), __ATOMIC_RELAXED, __HIP_MEMORY_SCOPE_AGENT) < (unsigned)NCONS) __builtin_amdgcn_s_sleep(16);
        __syncthreads(); }
    const int it0 = c * MOE_FILL_CH + F.wave, it1 = it0 + NWAVES;
    const GuAddr a0 = moe_gu_addr(F, A, MOE_FILL_E0 + it0 / MOE_IG, it0 % MOE_IG), a1 = moe_gu_addr(F, A, MOE_FILL_E0 + it1 / MOE_IG, it1 % MOE_IG);
    TrV T0, T1; tr_load(a0.W, EH, a0.k0, a0.nsrc0, F.lane, T0); tr_load(a1.W, EH, a1.k0, a1.nsrc0, F.lane, T1);
    tr_store(T0, a0.k0, a0.WT, D, a0.nd, scr, F.lane, true); tr_store(T1, a1.k0, a1.WT, D, a1.nd, scr, F.lane, true);
}
__device__ __forceinline__ void moe_weights(const Frame& F, const Args& A) {
    LAS float* scr = (LAS float*)(F.lds + RING_OFF + F.wave * 16384);
    for (int it = F.gw; it < (NE - MOE_FILL_NE) * MOE_IG; it += F.NGW) {
        int e = it / MOE_IG; const int r = it % MOE_IG; if (e >= MOE_FILL_E0) e += MOE_FILL_NE;
        moe_gu_item(F, A, e, r, scr);
    }
}
__device__ __forceinline__ void moe_weights_down_queue(const Frame& F, const Args& A) {
    LAS float* scr = (LAS float*)(F.lds + RING_OFF + F.wave * 16384);
    constexpr int ID = (EH / 64) * (D / 32), NIT = NE * ID, CH = 8 * NWAVES;
    for (;;) {
        if (F.tid == 0) F.MISC[0] = __hip_atomic_fetch_add((unsigned*)(F.ctl + CW_QUEUE + 96), 1u, RLX_AGENT);
        __syncthreads(); const int c = (int)F.MISC[0]; __syncthreads();
        if (c * CH >= NIT) break;
#pragma unroll 1
        for (int k = 0; k < 8; ++k) { const int it = c * CH + k * NWAVES + F.wave;
            if (it < NIT) { const int e = it / ID, r = it % ID; tr_plain(A.in[I_MWD] + (size_t)e * EH * D, EH, D, (bf16*)(F.ws + WS_WMOE_D) + (size_t)e * D * EH, scr, r, F.lane); } }
    }
}

__device__ __forceinline__ const float* modv(const Frame& F, int layer, int r) { const int b = r / TP, p = r % TP; return (const float*)(F.ws + WS_MODV) + (size_t)(layer * 3 + (p < CT ? 2 : b)) * 6144; }
__device__ __forceinline__ const float* p1_src(const Args& A, int r) { const int b = r / TP, p = r % TP; return p < CT ? A.in[I_CTX] + (size_t)(b * CT + p) * D : A.in[I_X] + (size_t)(b * SL + p - CT) * D; }
__device__ __forceinline__ f32x4 modp_sum4(const float* p) { return (*(const f32x4*)p + *(const f32x4*)(p + MODP_STRIDE)) + (*(const f32x4*)(p + 2 * MODP_STRIDE) + *(const f32x4*)(p + 3 * MODP_STRIDE)); }
__device__ __forceinline__ void p1_first_h(const Frame& F, const Args& A) {
    bf16* H = (bf16*)(F.ws + WS_H); const float* ng = A.in[I_NORMG];
    { const int gt = F.vcu * (NWAVES * 64) + F.tid;
      for (int i = gt; i < MODP_STRIDE / 4; i += F.G * NWAVES * 64) *(f32x4*)((float*)(F.ws + WS_MODV) + 4 * i) = modp_sum4((const float*)(F.ws + WS_MODP) + 4 * i); }
    f32x4 g[4], sh[4], sc[4]; int cur = -1;
#pragma unroll
    for (int j = 0; j < 4; ++j) g[j] = *(const f32x4*)(ng + 4 * F.lane + 256 * j);
    LAS f32x4* MT = (LAS f32x4*)(F.lds + RING_OFF);
    for (int i = F.tid; i < 3 * 2 * 256; i += NWAVES * 64) { const int set = i >> 9, v = (i >> 8) & 1, c4 = i & 255;
        f32x4 s = modp_sum4((const float*)(F.ws + WS_MODP) + (size_t)set * 6144 + v * 1024 + 4 * c4); if (v) s += 1.0f; MT[i] = s; }
    __syncthreads();
    for (int r0 = F.gw; r0 < MR; r0 += 4 * F.NGW) {
        f32x4 v[4][4]; int rr[4];
#pragma unroll
        for (int q = 0; q < 4; ++q) { rr[q] = r0 + q * F.NGW; const int rl = rr[q] < MR ? rr[q] : r0; const float* s = p1_src(A, rl);
#pragma unroll
            for (int j = 0; j < 4; ++j) v[q][j] = __builtin_nontemporal_load((const f32x4*)(s + 4 * F.lane + 256 * j)); }
#pragma unroll
        for (int q = 0; q < 4; ++q) if (rr[q] < MR) {
            const int r = rr[q], p = r % TP, set = p < CT ? 2 : r / TP;
            if (set != cur) { cur = set;
#pragma unroll
                for (int j = 0; j < 4; ++j) { sh[j] = MT[(set * 2 + 0) * 256 + F.lane + 64 * j]; sc[j] = MT[(set * 2 + 1) * 256 + F.lane + 64 * j]; } }
            float ss = 0.f;
#pragma unroll
            for (int j = 0; j < 4; ++j) ss += sq4(v[q][j]);
            const float rs = rsqrtf(wave_sum(ss) * (1.f / D) + NORM_EPS);
#pragma unroll
            for (int j = 0; j < 4; ++j) st_bf4(H + (size_t)r * D + 4 * F.lane + 256 * j, (v[q][j] * rs * g[j]) * sc[j] + sh[j]);
        }
    }
}
struct RowYX { f32x4 y[4], x[4]; };
__device__ __forceinline__ void st_x4(float* p, const f32x4 v) { __builtin_nontemporal_store(v, (f32x4*)p); }
__device__ __forceinline__ void st_x4(bf16* p, const f32x4 v) { v2u w; w.x = pk2(v[0], v[1]); w.y = pk2(v[2], v[3]); __builtin_nontemporal_store(w, (v2u*)p); }
__device__ __forceinline__ void load_yx(const Frame& F, const bf16* yrow, const float* xin, RowYX& R) {
#pragma unroll
    for (int j = 0; j < 4; ++j) { R.y[j] = ld_bf4_nt(yrow + 4 * F.lane + 256 * j); R.x[j] = ldnt((const f32x4*)(xin + 4 * F.lane + 256 * j)); }
}
__device__ __forceinline__ void load_yxb(const Frame& F, const bf16* yrow, const bf16* xin, RowYX& R) {
#pragma unroll
    for (int j = 0; j < 4; ++j) { R.y[j] = ld_bf4_nt(yrow + 4 * F.lane + 256 * j); R.x[j] = ld_bf4_nt(xin + 4 * F.lane + 256 * j); }
}
template <class TX> __device__ __forceinline__ void resid_norm(const Frame& F, const RowYX& R, TX* xout, const float* gate, const float* ngA, const float* ngB, const float* sh, const float* sc, bf16* hrow, f32x4 (&h)[4]) {
    float ss = 0.f;
#pragma unroll
    for (int j = 0; j < 4; ++j) ss += sq4(R.y[j]);
    const float rs = rsqrtf(wave_sum(ss) * (1.f / D) + NORM_EPS);
    f32x4 x[4]; float s2 = 0.f;
#pragma unroll
    for (int j = 0; j < 4; ++j) { const int c = 4 * F.lane + 256 * j;
        x[j] = R.x[j] + *(const f32x4*)(gate + c) * (R.y[j] * rs * *(const f32x4*)(ngA + c)); st_x4(xout + c, x[j]); s2 += sq4(x[j]); }
    const float r2 = rsqrtf(wave_sum(s2) * (1.f / D) + NORM_EPS);
#pragma unroll
    for (int j = 0; j < 4; ++j) { const int c = 4 * F.lane + 256 * j;
        h[j] = (x[j] * r2 * *(const f32x4*)(ngB + c)) * (*(const f32x4*)(sc + c) + 1.0f) + *(const f32x4*)(sh + c); st_bf4(hrow + c, h[j]); }
}
__device__ __forceinline__ void p_resid_row(const Frame& F, const Args& A, int r, const RowYX& R, int layer, int which) {
    bf16* XR = (bf16*)(F.ws + WS_XR); bf16* H = (bf16*)(F.ws + WS_H); const float* ng = A.in[I_NORMG]; const float* mv = modv(F, layer, r); f32x4 h[4];
    if (which == 0) resid_norm(F, R, XR + (size_t)r * D, mv + 2 * 1024, ng + (layer * 4 + 1) * D, ng + (layer * 4 + 2) * D, mv + 3 * 1024, mv + 4 * 1024, H + (size_t)r * D, h);
    else { const float* mn = modv(F, layer + 1, r);
        resid_norm(F, R, XR + (size_t)r * D, mv + 5 * 1024, ng + (layer * 4 + 3) * D, ng + ((layer + 1) * 4 + 0) * D, mn + 0 * 1024, mn + 1 * 1024, H + (size_t)r * D, h); }
}
template <int NKS> __device__ __forceinline__ void load_y(const Frame& F, const bf16* Y, int r, RowYX& R) {
    const int p = r % TP;
    if (NKS > 0 && p < CT) { const float* yf = (const float*)(F.ws + WS_Y0F) + (size_t)((r / TP) * CT + p) * D + 4 * F.lane;
#pragma unroll
        for (int j = 0; j < 4; ++j) { f32x4 t[NKS > 0 ? NKS : 1];
#pragma unroll
            for (int s = 0; s < NKS; ++s) t[s] = ldnt((const f32x4*)(yf + (size_t)s * 512 * D + 256 * j));
            R.y[j] = t[0];
#pragma unroll
            for (int s = 1; s < NKS; ++s) R.y[j] += t[s]; } }
    else {
#pragma unroll
        for (int j = 0; j < 4; ++j) R.y[j] = ld_bf4_nt(Y + (size_t)r * D + 4 * F.lane + 256 * j); }
}
struct ModRegs { f32x4 ga[4], gb[4], sh[4]; int cur; };
__device__ __forceinline__ void mod_load(const Frame& F, const Args& A, ModRegs& M, int set, int layer, int which) {
    if (set == M.cur) return; M.cur = set;
    const float* ng = A.in[I_NORMG]; const float* mv = (const float*)(F.ws + WS_MODV) + (size_t)(layer * 3 + set) * 6144; const float* mn = (const float*)(F.ws + WS_MODV) + (size_t)((layer + 1) * 3 + set) * 6144;
    const float* gate = mv + (which == 0 ? 2 : 5) * 1024; const float* ngA = ng + (layer * 4 + (which == 0 ? 1 : 3)) * D; const float* ngB = which == 0 ? ng + (layer * 4 + 2) * D : ng + ((layer + 1) * 4 + 0) * D;
    const float* sh = which == 0 ? mv + 3 * 1024 : mn; const float* sc = which == 0 ? mv + 4 * 1024 : mn + 1024;
#pragma unroll
    for (int j = 0; j < 4; ++j) { const int c = 4 * F.lane + 256 * j;
        M.ga[j] = *(const f32x4*)(gate + c) * *(const f32x4*)(ngA + c); M.gb[j] = *(const f32x4*)(ngB + c) * (*(const f32x4*)(sc + c) + 1.0f); M.sh[j] = *(const f32x4*)(sh + c); }
}
template <class TX> __device__ __forceinline__ void resid_norm_m(const Frame& F, const RowYX& R, const ModRegs& M, TX* xout, bf16* hrow, f32x4 (&h)[4]) {
    float ss = 0.f;
#pragma unroll
    for (int j = 0; j < 4; ++j) ss += sq4(R.y[j]);
    const float rs = rsqrtf(wave_sum(ss) * (1.f / D) + NORM_EPS);
    f32x4 x[4]; float s2 = 0.f;
#pragma unroll
    for (int j = 0; j < 4; ++j) { x[j] = R.x[j] + M.ga[j] * (R.y[j] * rs); st_x4(xout + 4 * F.lane + 256 * j, x[j]); s2 += sq4(x[j]); }
    const float r2 = rsqrtf(wave_sum(s2) * (1.f / D) + NORM_EPS);
#pragma unroll
    for (int j = 0; j < 4; ++j) { h[j] = (x[j] * r2) * M.gb[j] + M.sh[j]; st_bf4(hrow + 4 * F.lane + 256 * j, h[j]); }
}
template <int NKS> __device__ __forceinline__ void p_resid_all(const Frame& F, const Args& A, const bf16* Y, int layer, int which  ) {
    bf16* XR = (bf16*)(F.ws + WS_XR); bf16* H = (bf16*)(F.ws + WS_H); ModRegs M; M.cur = -1;
    const int nl = F.gw < ML ? (ML - F.gw + 2 * F.NGW - 1) / (2 * F.NGW) : 0, step = F.NGW >= CT ? F.NGW / CT : 1;
#pragma unroll 1
    for (int it = 0; ; ++it) {
        int r, r2; bool two;
        if (it < nl) { const int v = F.gw + 2 * it * F.NGW, v2 = v + F.NGW; two = v2 < ML; r = (v / SL) * TP + CT + v % SL; r2 = two ? (v2 / SL) * TP + CT + v2 % SL : r; }
        else { const int c = F.gw / step + (it - nl) * (F.NGW / step); if (F.gw % step != 0 || c >= CT) break; r = c; r2 = TP + c; two = true; }
        const int rb = r2; RowYX Ra, Rb;
        load_y<NKS>(F, Y, r, Ra); load_y<NKS>(F, Y, rb, Rb);
#pragma unroll
        for (int j = 0; j < 4; ++j) {
            if (which == 0) { Ra.x[j] = ldnt((const f32x4*)(p1_src(A, r) + 4 * F.lane + 256 * j)); Rb.x[j] = ldnt((const f32x4*)(p1_src(A, rb) + 4 * F.lane + 256 * j)); }
            else { Ra.x[j] = ld_bf4_nt(XR + (size_t)r * D + 4 * F.lane + 256 * j); Rb.x[j] = ld_bf4_nt(XR + (size_t)rb * D + 4 * F.lane + 256 * j); } }
        f32x4 h[4];
        mod_load(F, A, M, (r % TP) < CT ? 2 : r / TP, layer, which); resid_norm_m(F, Ra, M, XR + (size_t)r * D, H + (size_t)r * D, h);
        if (two) { mod_load(F, A, M, (r2 % TP) < CT ? 2 : r2 / TP, layer, which); resid_norm_m(F, Rb, M, XR + (size_t)r2 * D, H + (size_t)r2 * D, h); }
    }
}
template <int NP> __device__ __forceinline__ void rope_cs(int lane, int t, float (&cs)[8], float (&sn)[8]) {
    const float rowp = (float)(t / 64), colp = (float)(t % 64);
#pragma unroll
    for (int e = 0; e < 8; ++e) { const int i = 8 * (lane & (NP / 8 - 1)) + e, fi = i & (NP / 2 - 1);
        const float f = __builtin_amdgcn_exp2f(-(float)fi * (13.287712379549449f / (float)(NP / 2))); const float ang = ((i < NP / 2) ? rowp : colp) * f;
        cs[e] = __cosf(ang); sn[e] = __sinf(ang); }
}
template <int XORD> __device__ __forceinline__ void rope_apply(float (&v)[8], const float (&cs)[8], const float (&sn)[8], bool first) {
#pragma unroll
    for (int e = 0; e < 8; ++e) { const float p = XORD == 8 ? lane_xor8(v[e]) : lane_xor4(v[e], !first); v[e] = first ? v[e] * cs[e] - p * sn[e] : p * sn[e] + v[e] * cs[e]; }
}
__device__ __forceinline__ void p3_ld8(const bf16* row, const float* part, int off, bool lat, float (&v)[8]) {
    if (lat) { unpack8(ldnt((const v4u*)(row + off)), v); return; }
    f32x4 a = ldnt((const f32x4*)(part + off)), b = ldnt((const f32x4*)(part + off + 4));
#pragma unroll
    for (int s = 1; s < 4; ++s) { a += ldnt((const f32x4*)(part + (size_t)s * 512 * E_IN + off)); b += ldnt((const f32x4*)(part + (size_t)s * 512 * E_IN + off + 4)); }
#pragma unroll
    for (int j = 0; j < 4; ++j) { v[j] = a[j]; v[4 + j] = b[j]; }
}
__device__ __forceinline__ void p3_post0(const Frame& F, const Args& A) {
    bf16* P = (bf16*)(F.ws + WS_PRJ0); const int l = F.lane;
    float qg[8], kg[8];
#pragma unroll
    for (int e = 0; e < 8; ++e) { qg[e] = A.in[I_QNORM][8 * (l & 15) + e]; kg[e] = A.in[I_KNORM][8 * (l & 15) + e]; }
    for (int it = F.gw; it < 2 * CT * 6; it += F.NGW) {
        const int c = it / 6, grp = it % 6, r = (c / CT) * TP + (c % CT); bf16* row = P + (size_t)r * E_IN + 512 * grp + 8 * l; const float* part = (const float*)(F.ws + WS_PRJF) + (size_t)c * E_IN;
        float v[8]; p3_ld8(row, part, 512 * grp + 8 * l, false, v);
        if (grp == 1) {
#pragma unroll
            for (int e = 0; e < 8; ++e) v[e] *= 0.088388347648318440f; }
        if (grp == 4 || (grp == 5 && l < 32)) { float ss = 0.f;
#pragma unroll
            for (int e = 0; e < 8; ++e) ss += v[e] * v[e];
            ss = sum16(ss); const float rs = rsqrtf(ss * (1.f / 128.f) + NORM_EPS);
#pragma unroll
            for (int e = 0; e < 8; ++e) v[e] = v[e] * rs * (grp == 4 ? qg[e] : kg[e]); }
        *(v4u*)row = pack8(v);
    }
    for (int t = F.gw; t < ML; t += F.NGW) {
        const int r = (t / SL) * TP + CT + (t % SL);
        const int p = r % TP; const bool lat = true; bf16* row = P + (size_t)r * E_IN;
        const float* part = nullptr;
        float cs[8], sn[8];
#pragma unroll
        for (int e = 0; e < 8; ++e) { cs[e] = 1.f; sn[e] = 0.f; }
        if (lat) rope_cs<64>(l, p - CT, cs, sn);
        const bool first = (l & 8) == 0;
        float v[8];
        p3_ld8(row, part, 8 * l, lat, v); rope_apply<8>(v, cs, sn, first); *(v4u*)(row + 8 * l) = pack8(v);
        p3_ld8(row, part, 512 + 8 * l, lat, v);
#pragma unroll
        for (int e = 0; e < 8; ++e) v[e] *= 0.088388347648318440f;
        rope_apply<8>(v, cs, sn, first); *(v4u*)(row + 512 + 8 * l) = pack8(v);
        if (!lat) { p3_ld8(row, part, 1024 + 8 * l, false, v); *(v4u*)(row + 1024 + 8 * l) = pack8(v); p3_ld8(row, part, 1536 + 8 * l, false, v); *(v4u*)(row + 1536 + 8 * l) = pack8(v); }
        { p3_ld8(row, part, 2048 + 8 * l, lat, v); float ss = 0.f;
#pragma unroll
          for (int e = 0; e < 8; ++e) ss += v[e] * v[e];
          ss = sum16(ss);
          const float rs = rsqrtf(ss * (1.f / 128.f) + NORM_EPS);
#pragma unroll
          for (int e = 0; e < 8; ++e) v[e] = v[e] * rs * qg[e];
          rope_apply<8>(v, cs, sn, first); *(v4u*)(row + 2048 + 8 * l) = pack8(v); }
        { p3_ld8(row, part, 2560 + 8 * l, lat, v); float ss = 0.f;
          if (!lat && l >= 32) *(v4u*)(row + 2560 + 8 * l) = pack8(v);
#pragma unroll
          for (int e = 0; e < 8; ++e) ss += v[e] * v[e];
          ss = sum16(ss);
          const float rs = rsqrtf(ss * (1.f / 128.f) + NORM_EPS);
#pragma unroll
          for (int e = 0; e < 8; ++e) v[e] = v[e] * rs * kg[e];
          rope_apply<8>(v, cs, sn, first); if (l < 32) *(v4u*)(row + 2560 + 8 * l) = pack8(v); }
    }
}

typedef LAS unsigned short lbf16;
typedef short bf16x8 __attribute__((ext_vector_type(8)));
__device__ __forceinline__ float ret_lg(const Args& A, int d, int h) { return log2f(1.0f - exp2f(-A.in[I_RDEC][d * 4 + h])); }
template <int NOUT> __device__ __forceinline__ void stage_T(const bf16* src, int ld, lbf16* T0, lbf16* T1, int tid, float lg0, float lg1) {
    const int m = tid >> 2, q = tid & 3;
    const float s0 = NOUT == 2 ? exp2f(lg0 * (float)(127 - m)) : 1.f, s1 = NOUT == 2 ? exp2f(lg1 * (float)m) : 1.f;
#pragma unroll
    for (int c = 0; c < 4; ++c) { float f[8]; unpack8(*(const v4u*)(src + (size_t)m * ld + q * 32 + c * 8), f);
#pragma unroll
        for (int e = 0; e < 8; ++e) { const int col = q * 32 + c * 8 + e; T0[col * 136 + m] = (unsigned short)f2bf(f[e] * s0); if (NOUT == 2) T1[col * 136 + m] = (unsigned short)f2bf(f[e] * s1); } }
}
__device__ __forceinline__ void ret_u_unit(const Frame& F, const Args& A, int unit) {
    const int b = unit / (4 * NCH), h = (unit / NCH) % 4, g = unit % NCH, r0 = b * TP + g * 128;
    const bf16* P = (const bf16*)(F.ws + WS_PRJ0) + (size_t)r0 * E_IN;
    lbf16* KT0 = (lbf16*)(F.lds); lbf16* KT1 = KT0 + 128 * 136; lbf16* VT = KT1 + 128 * 136;
    const float lg0 = ret_lg(A, 0, h), lg1 = ret_lg(A, 1, h);
    stage_T<2>(P + 512 + h * 128, E_IN, KT0, KT1, F.tid, lg0, lg1);
    stage_T<1>(P + 1024 + h * 128, E_IN, VT, VT, F.tid, 0.f, 0.f);
    __syncthreads();
    const int rb = F.wave >> 1, ch = F.wave & 1, r32 = F.lane & 31, hi = F.lane >> 5;
#pragma unroll
    for (int d = 0; d < 2; ++d) {
        const lbf16* KT = d ? KT1 : KT0; f32x16 acc[2] = {};
#pragma unroll
        for (int ks = 0; ks < 8; ++ks) { const bf16x8 a = *(const LAS bf16x8*)(KT + (32 * rb + r32) * 136 + 16 * ks + 8 * hi);
#pragma unroll
            for (int dt = 0; dt < 2; ++dt) { const bf16x8 bb = *(const LAS bf16x8*)(VT + (64 * ch + 32 * dt + r32) * 136 + 16 * ks + 8 * hi);
                acc[dt] = __builtin_amdgcn_mfma_f32_32x32x16_bf16(a, bb, acc[dt], 0, 0, 0); } }
        bf16* U = (bf16*)(F.ws + WS_UT) + ((size_t)((b * 4 + h) * NCH + g) * 2 + d) * 16384;
#pragma unroll
        for (int dt = 0; dt < 2; ++dt) { const int dv = 64 * ch + 32 * dt + r32;
#pragma unroll
            for (int g4 = 0; g4 < 4; ++g4) *(v2u*)(U + dv * 128 + 32 * rb + 8 * g4 + 4 * hi) = (v2u){pk2(acc[dt][4 * g4], acc[dt][4 * g4 + 1]), pk2(acc[dt][4 * g4 + 2], acc[dt][4 * g4 + 3])}; }
    }
    __syncthreads();
}
__device__ __forceinline__ void ret_prefix(const Frame& F, const Args& A) {
    const bf16* UT = (const bf16*)(F.ws + WS_UT); bf16* ST = (bf16*)(F.ws + WS_H);
    const int gt = F.vcu * (NWAVES * 64) + F.tid, NGT = F.G * NWAVES * 64;
    for (int idx = gt; idx < 16 * 8192; idx += NGT) {
        const int sc = idx >> 13, el = (idx & 8191) * 2, b = sc >> 3, h = (sc >> 1) & 3, d = sc & 1;
        const float cd = exp2f(ret_lg(A, d, h) * 128.f); float s0 = 0.f, s1 = 0.f;
#pragma unroll 6
        for (int i = 0; i < NCH; ++i) { const int g = d == 0 ? i : (i < 2 ? 1 - i : NCH + 1 - i);
            const size_t off = ((size_t)((b * 4 + h) * NCH + g) * 2 + d) * 16384 + el; *(unsigned*)(ST + off) = pk2(s0, s1);
            const unsigned u = __builtin_nontemporal_load((const unsigned*)(UT + off)); s0 = s0 * cd + __uint_as_float(u << 16); s1 = s1 * cd + __uint_as_float(u & 0xffff0000u); }
    }
}
__device__ __forceinline__ bf16x8 scale_frag(const bf16x8 q, float s) { float f[8]; unpack8(__builtin_bit_cast(v4u, q), f);
#pragma unroll
    for (int e = 0; e < 8; ++e) f[e] *= s;
    return __builtin_bit_cast(bf16x8, pack8_sw(f)); }
__device__ __forceinline__ void ret_out_unit(const Frame& F, const Args& A, int unit) {
    const int b = unit / (4 * NCH), h = (unit / NCH) % 4, g = unit % NCH, r0 = b * TP + g * 128;
    const bf16* P = (const bf16*)(F.ws + WS_PRJ0) + (size_t)r0 * E_IN;
    lbf16* VT = (lbf16*)(F.lds); lbf16* KL = VT + 128 * 136; lbf16* SL0 = KL + 128 * 136; lbf16* SL1 = SL0 + 128 * 136; LAS float* YS = (LAS float*)(F.lds + 128 * 136 * 2);
    const float lg0 = ret_lg(A, 0, h), lg1 = ret_lg(A, 1, h);
    const bf16* S0 = (const bf16*)(F.ws + WS_H) + ((size_t)((b * 4 + h) * NCH + g) * 2) * 16384;
    const int rb = F.wave >> 1, ch = F.wave & 1, r32 = F.lane & 31, hi = F.lane >> 5;
    const int n = 32 * rb + r32;
    bf16x8 qf[8];
    int tidl = F.tid; asm volatile("" : "+v"(tidl));
    { v4u kq[4], s0q[4], s1q[4];
#pragma unroll
      for (int i = 0; i < 4; ++i) { const int piece = tidl + 512 * i, row = piece >> 4, c = piece & 15;
          kq[i] = *(const v4u*)(P + (size_t)row * E_IN + 512 + h * 128 + c * 8); s0q[i] = *(const v4u*)(S0 + (size_t)piece * 8); s1q[i] = *(const v4u*)(S0 + 16384 + (size_t)piece * 8); }
#pragma unroll
      for (int ks = 0; ks < 8; ++ks) qf[ks] = *(const bf16x8*)(P + (size_t)n * E_IN + h * 128 + 16 * ks + 8 * hi);
#pragma unroll
      for (int i = 0; i < 4; ++i) { const int piece = tidl + 512 * i, o = (piece >> 4) * 136 + (piece & 15) * 8;
          *(LAS v4u*)(KL + o) = kq[i]; *(LAS v4u*)(SL0 + o) = s0q[i]; *(LAS v4u*)(SL1 + o) = s1q[i]; }
      asm volatile("" ::: "memory"); }
    stage_T<1>(P + 1024 + h * 128, E_IN, VT, VT, F.tid, 0.f, 0.f);
    __syncthreads();
    f32x16 Y[2] = {};
    const lbf16* vrow0 = VT + (64 * ch + r32) * 136;
#pragma unroll 1
    for (int mt = 0; mt < 4; ++mt) {
        f32x16 X = {};
#pragma unroll
        for (int ks = 0; ks < 8; ++ks) { const bf16x8 kf = *(const LAS bf16x8*)(KL + (32 * mt + r32) * 136 + 16 * ks + 8 * hi);
            X = __builtin_amdgcn_mfma_f32_32x32x16_bf16(kf, qf[ks], X, 0, 0, 0); }
        float xs[16];
#pragma unroll
        for (int r = 0; r < 16; ++r) { const int m = 32 * mt + (r & 3) + 8 * (r >> 2) + 4 * hi; const float dl = (float)(n - m);
            xs[r] = X[r] * __builtin_amdgcn_exp2f(dl >= 0.f ? lg0 * dl : -lg1 * dl); }
#pragma unroll
        for (int s = 0; s < 2; ++s) { v4u w; w.x = pk2_sw(xs[8 * s], xs[8 * s + 1]); w.y = pk2_sw(xs[8 * s + 2], xs[8 * s + 3]); w.z = pk2_sw(xs[8 * s + 4], xs[8 * s + 5]); w.w = pk2_sw(xs[8 * s + 6], xs[8 * s + 7]);
            const bf16x8 pa = __builtin_bit_cast(bf16x8, w);
#pragma unroll
            for (int dt = 0; dt < 2; ++dt) { const lbf16* vrow = vrow0 + 32 * dt * 136;
                const v2u lo = *(const LAS v2u*)(vrow + 32 * mt + 16 * s + 4 * hi), hh = *(const LAS v2u*)(vrow + 32 * mt + 16 * s + 8 + 4 * hi);
                const v4u wv = {lo.x, lo.y, hh.x, hh.y};
                Y[dt] = __builtin_amdgcn_mfma_f32_32x32x16_bf16(pa, __builtin_bit_cast(bf16x8, wv), Y[dt], 0, 0, 0); } }
        asm volatile("" ::: "memory");
    }
#pragma unroll 1
    for (int d = 0; d < 2; ++d) {
        const float qd = d == 0 ? __builtin_amdgcn_exp2f(lg0 * (float)(n + 1)) : __builtin_amdgcn_exp2f(lg1 * (float)(128 - n));
        const lbf16* S = d ? SL1 : SL0;
#pragma unroll
        for (int ks = 0; ks < 8; ++ks) { const bf16x8 qs = scale_frag(qf[ks], qd);
#pragma unroll
            for (int dt = 0; dt < 2; ++dt) { const bf16x8 sf = *(const LAS bf16x8*)(S + (64 * ch + 32 * dt + r32) * 136 + 16 * ks + 8 * hi);
                Y[dt] = __builtin_amdgcn_mfma_f32_32x32x16_bf16(qs, sf, Y[dt], 0, 0, 0); } }
        asm volatile("" ::: "memory");
    }
    const int nrow = 16 * F.wave + (F.lane >> 2), nq = F.lane & 3;
    v4u gq[4]; f32x4 gn[8];
#pragma unroll
    for (int k = 0; k < 4; ++k) gq[k] = *(const v4u*)(P + (size_t)nrow * E_IN + 1536 + h * 128 + 32 * nq + 8 * k);
#pragma unroll
    for (int k = 0; k < 8; ++k) gn[k] = *(const f32x4*)(A.in[I_RNORMG] + h * 128 + 32 * nq + 4 * k);
    __syncthreads();
#pragma unroll
    for (int dt = 0; dt < 2; ++dt)
#pragma unroll
        for (int r = 0; r < 16; ++r) YS[(32 * rb + (r & 3) + 8 * (r >> 2) + 4 * hi) * 132 + 64 * ch + 32 * dt + r32] = Y[dt][r];
    __syncthreads();
    bf16* MIX = (bf16*)(F.ws + WS_MIX0);
    f32x4 y[8]; float ss = 0.f;
#pragma unroll
    for (int k = 0; k < 8; ++k) { y[k] = *(const LAS f32x4*)(YS + nrow * 132 + 32 * nq + 4 * k); ss += sq4(y[k]); }
    ss += __shfl_xor(ss, 1); ss += __shfl_xor(ss, 2);
    const float rs = rsqrtf(ss * (1.f / 128.f) + NORM_EPS);
#pragma unroll
    for (int k = 0; k < 4; ++k) { float gt[8], o[8]; unpack8(gq[k], gt);
#pragma unroll
        for (int e = 0; e < 4; ++e) { o[e] = y[2 * k][e] * rs * gn[2 * k][e] * siluf_(gt[e]); o[4 + e] = y[2 * k + 1][e] * rs * gn[2 * k + 1][e] * siluf_(gt[4 + e]); }
        *(v4u*)(MIX + (size_t)(r0 + nrow) * D + h * 128 + 32 * nq + 8 * k) = pack8(o); }
    __syncthreads();
}

__device__ __forceinline__ void attn0_unit(const Frame& F, int unit) {
    const att::bf16* P = (const att::bf16*)(F.ws + WS_PRJ0); att::bf16* MIX = (att::bf16*)(F.ws + WS_MIX0);
    int b, qh, qrow0, seq;
    if (unit < 256) { b = unit >> 7; qh = (unit >> 5) & 3; qrow0 = b * TP + CT + (unit & 31) * 256; seq = TP; }
    else { const int u = unit - 256; b = u >> 2; qh = u & 3; qrow0 = b * TP; seq = CT; }
    const int kvh = qh >> 1;
    att::attn_dense_body<E_IN, E_IN, D, 8>(P + (size_t)qrow0 * E_IN + 2048 + qh * 128, P + (size_t)b * TP * E_IN + 2560 + kvh * 128, P + (size_t)b * TP * E_IN + 2816 + kvh * 128,
                                        MIX + (size_t)qrow0 * D + 512 + qh * 128, seq, F.ldsg, 0);
    __syncthreads();
}
constexpr int A1_NP = 11, A1_SPLIT_QB = 56, A1_NWH = 256 + 4 * A1_SPLIT_QB, A1_NU = A1_NWH + 4 * (64 - A1_SPLIT_QB) * A1_NP;
static_assert(TP % (A1_NP * 128) == 0 && (size_t)(64 - A1_SPLIT_QB) * A1_NP * 128 * 1024 * 2 <= WS_ASTAT - WS_OB2 && (size_t)A1_NU * 2048 <= (size_t)1024 * 256 * 8, "layer-1 attention pieces");
__device__ __forceinline__ void attn1_unit(const Frame& F, int unit) {
    int b, h, qb, key0, seq; att::bf16* O; float* st = nullptr;
    if (unit < A1_NWH) {
        if (unit < 256) { b = 0; h = unit >> 6; qb = unit & 63; } else { const int v = unit - 256; b = 1; h = v / A1_SPLIT_QB; qb = v % A1_SPLIT_QB; }
        key0 = 0; seq = TP; O = (att::bf16*)(F.ws + WS_OB) + (size_t)(b * SL + qb * 128) * 1024 + (2 * h) * 128;
    } else {
        const int s = unit - A1_NWH, per = (64 - A1_SPLIT_QB) * A1_NP, rem = s % per, sq = rem / A1_NP, p = rem % A1_NP; b = 1; h = s / per; qb = A1_SPLIT_QB + sq;
        key0 = p * (TP / A1_NP); seq = TP / A1_NP; O = (att::bf16*)(F.ws + WS_OB2) + (size_t)((sq * A1_NP + p) * 128) * 1024 + (2 * h) * 128; st = (float*)(F.ws + WS_ASTAT) + (size_t)unit * 512;
    }
    const att::bf16* KV = (const att::bf16*)(F.ws + WS_KV1) + (size_t)(b * TP + key0) * 1024;
    const size_t qoff = (size_t)(b * SL + qb * 128) * 1024 + (2 * h) * 128;
    att::attn_dense_body<1024, 1024, 1024, 4, true, true>((const att::bf16*)(F.ws + WS_QD) + qoff, KV + h * 128, KV + 512 + h * 128, O, seq, F.ldsg, 0, st);
    __syncthreads();
}

__device__ __forceinline__ void p13_prep1(const Frame& F, const Args& A) {
    const int l = F.lane; unsigned char* ws = F.ws;
    bf16* KV = (bf16*)(ws + WS_KV1); const bf16* RWQ = (const bf16*)(ws + WS_RWQ); bf16* QD = (bf16*)(ws + WS_QD); bf16* LIN = (bf16*)(ws + WS_LIN);
    bf16* SR = (bf16*)(ws + WS_SCAN + SA_R * SCAN_ARR); bf16* SV = (bf16*)(ws + WS_SCAN + SA_V * SCAN_ARR); bf16* SAN = (bf16*)(ws + WS_SCAN + SA_AN * SCAN_ARR); bf16* SK = (bf16*)(ws + WS_SCAN + SA_K * SCAN_ARR);
    const float* mu = A.in[I_RMU];
    float kkg[8];
#pragma unroll
    for (int e = 0; e < 8; ++e) kkg[e] = A.in[I_RKK][8 * l + e];
    float mu8[4][8];
#pragma unroll
    for (int j = 0; j < 4; ++j)
#pragma unroll
        for (int e = 0; e < 8; ++e) mu8[j][e] = ((j < 3) || (l < 48)) ? mu[8 * l + 512 * j + e] : 0.f;
    for (int r = F.gw; r < MR; r += F.NGW) {
        const int b = r / TP, p = r % TP; const bool lat = p >= CT;
        const bf16* row = RWQ + (size_t)r * 2560;
        if (lat) {
            float cs[8], sn[8]; rope_cs<32>(l, p - CT, cs, sn); const bool first = (l & 4) == 0; float v[8];
            unpack8(ldnt((const v4u*)(row + 8 * l)), v); rope_apply<4>(v, cs, sn, first);
#pragma unroll
            for (int e = 0; e < 8; ++e) v[e] *= 1.41421356237f;
            { const int qh = l >> 3, m = qh & 1; bf16* q = QD + (size_t)(b * SL + p - CT) * 1024 + qh * 128;
              *(v4u*)(q + m * 64 + 8 * (l & 7)) = pack8(v); }
            bf16* kr = KV + (size_t)r * 1024 + 8 * l; unpack8(*(const v4u*)kr, v); rope_apply<4>(v, cs, sn, first); *(v4u*)kr = pack8(v);
        }
        const bool hasp = lat ? (p > CT) : (p > 0), hasn = lat ? (p < TP - 1) : (p < CT - 1);
        float pv[4][8];
#pragma unroll
        for (int j = 0; j < 4; ++j) {
            const int c = 8 * l + 512 * j; const bool on = (j < 3) || (l < 48);
            float x[8], xp[8], xn[8];
#pragma unroll
            for (int e = 0; e < 8; ++e) { x[e] = 0.f; xp[e] = 0.f; xn[e] = 0.f; }
            if (on) { unpack8(*(const v4u*)(row + 512 + c), x); if (hasp) unpack8(*(const v4u*)(row - 2560 + 512 + c), xp); if (hasn) unpack8(*(const v4u*)(row + 2560 + 512 + c), xn); }
#pragma unroll
            for (int e = 0; e < 8; ++e) pv[j][e] = x[e] + mu8[j][e] * (0.5f * (xp[e] + xn[e]) - x[e]);
        }
        const size_t so = (size_t)r * 512 + 8 * l;
        stnt((v4u*)(SR + so), pack8(pv[0])); stnt((v4u*)(SK + so), pack8(pv[1])); stnt((v4u*)(SV + so), pack8(pv[2]));
        { float kk[8]; float ss = 0.f;
#pragma unroll
          for (int e = 0; e < 8; ++e) { kk[e] = pv[1][e] * kkg[e]; ss += kk[e] * kk[e]; }
          ss = sum8(ss);
          const float inv = -1.0f / fmaxf(sqrtf(ss), 1e-12f);
#pragma unroll
          for (int e = 0; e < 8; ++e) kk[e] *= inv;
          stnt((v4u*)(SAN + so), pack8(kk)); }
        if (l < 48) { float o[8];
#pragma unroll
            for (int e = 0; e < 8; ++e) o[e] = l < 16 ? 1.0f - 2.0f * __builtin_amdgcn_rcpf(1.0f + __builtin_amdgcn_exp2f(2.88539008178f * pv[3][e])) : (l < 32 ? pv[3][e] : sigmoidf_(pv[3][e]));
            stnt((v4u*)(LIN + (size_t)r * 384 + 8 * l), pack8(o)); }
    }
}

template <int NB_> __device__ __forceinline__ void mg_batch(const bf16* ap, const bf16* bp, f32x4& c) {
    bf16x8 a[NB_], b[NB_];
#pragma unroll
    for (int j = 0; j < NB_; ++j) { a[j] = *(const bf16x8*)(ap + 32 * j); b[j] = *(const bf16x8*)(bp + 32 * j); }
#pragma unroll
    for (int j = 0; j < NB_; ++j) c = __builtin_amdgcn_mfma_f32_16x16x32_bf16(a[j], b[j], c, 0, 0, 0);
}
template <class Epi> __device__ __forceinline__ void mini_gemm_ctx(const Frame& F, const bf16* Abase, int lda, const bf16* Wt, int K, int ncs, int first_wg, const Epi& E) {
    const int NP = 32 * ncs, r = F.lane & 15, kq = F.lane >> 4;
    int Kr = K; asm volatile("" : "+s"(Kr));
#ifndef MINI_REP
#define MINI_REP 1
#endif
    for (int rep = 0; rep < MINI_REP; ++rep)
    for (int p = ((int)blockIdx.x - first_wg + F.G) % F.G; p < NP; p += F.G) {
        const int rs = p & 31, cs = p >> 5, r0 = (rs >> 4) * TP + (rs & 15) * 16;
        const bf16* ap = Abase + (size_t)(r0 + r) * lda + 8 * kq;
        const bf16* bp = Wt + (size_t)(128 * cs + 16 * F.wave + r) * K + 8 * kq;
        f32x4 c = {0.f, 0.f, 0.f, 0.f};
        int k = 0;
#pragma unroll 1
        for (; k + 512 <= Kr; k += 512) { mg_batch<16>(ap + k, bp + k, c); __builtin_amdgcn_sched_barrier(0); }
        if (k < Kr) mg_batch<8>(ap + k, bp + k, c);
        const int col = 128 * cs + 16 * F.wave + r;
#pragma unroll
        for (int j = 0; j < 4; ++j) E.elem(r0 + 4 * kq + j, col, c[j], 0.f);
    }
}
struct MStore { bf16* O; int ldc; __device__ __forceinline__ void elem(int row, int col, float v, float) const { O[(size_t)row * ldc + col] = (bf16)f2bf(v); } };
struct MSwiglu { bf16* O; int ldc; __device__ __forceinline__ void elem(int row, int col, float g, float u) const { O[(size_t)row * ldc + col] = (bf16)f2bf(siluf_(g) * u); } };
struct MSplit1 { bf16* KV; bf16* RWQ; __device__ __forceinline__ void elem(int row, int col, float v, float) const {
    if (col >= 512 && col < 1536) KV[(size_t)row * 1024 + col - 512] = (bf16)f2bf(v); else RWQ[(size_t)row * 2560 + (col < 512 ? col : col - 1024)] = (bf16)f2bf(v); } };
struct MLora { bf16* base; const float* w0; const float* a0;
    __device__ __forceinline__ void elem(int row, int col, float v, float) const { const int blk = col >> 9, c = col & 511;
        const int arr = blk == 0 ? SA_L0 : blk == 1 ? SA_L1 : blk == 2 ? SA_A0 : blk == 3 ? SA_A1 : SA_G;
        float o = v; if (blk < 2) o = sigmoidf_(v + w0[blk * 512 + c]) * (0.60653065971f * 1.44269504089f); else if (blk < 4) o = sigmoidf_(v + a0[(blk - 2) * 512 + c]);
        ((bf16*)((unsigned char*)base + (size_t)arr * SCAN_ARR))[(size_t)row * 512 + c] = (bf16)f2bf(o); } };

__device__ __forceinline__ float dpp_add16(float x) {
    x += __builtin_bit_cast(float, __builtin_amdgcn_update_dpp(0, __builtin_bit_cast(int, x), 0xB1, 0xF, 0xF, true));
    x += __builtin_bit_cast(float, __builtin_amdgcn_update_dpp(0, __builtin_bit_cast(int, x), 0x4E, 0xF, 0xF, true));
    x += __builtin_bit_cast(float, __builtin_amdgcn_update_dpp(0, __builtin_bit_cast(int, x), 0x141, 0xF, 0xF, true));
    x += __builtin_bit_cast(float, __builtin_amdgcn_update_dpp(0, __builtin_bit_cast(int, x), 0x140, 0xF, 0xF, true));
    return x;
}
constexpr int SC_TOK = 32, SC_STRIDE = 336;
constexpr int SC_BUF = SC_TOK * SC_STRIDE;
constexpr int SC_YOFF = 2 * SC_BUF;
__device__ __forceinline__ int scan_row(int b, int d, int i) { return b * TP + (d == 0 ? i : (i < CT ? CT - 1 - i : CT + (TP - 1 - i))); }
struct ScanOps { f32x4 w, a, b, k, r; float v; };
__device__ __forceinline__ float dot4(const f32x4 s, const f32x4 a) { f32x2v p = (f32x2v){s[0], s[1]} * (f32x2v){a[0], a[1]}; p = __builtin_elementwise_fma((f32x2v){s[2], s[3]}, (f32x2v){a[2], a[3]}, p); return p.x + p.y; }
template <int DIR, int NREP> __device__ __forceinline__ void rwkv_scan(const Frame& F, const Args& A, int sid) {
    const int b = sid >> 5, h = (sid >> 2) & 7, q = sid & 3;
    unsigned char* ws = F.ws;
    const bf16* aL = (const bf16*)(ws + WS_SCAN + (size_t)(DIR ? SA_L1 : SA_L0) * SCAN_ARR); const bf16* aAN = (const bf16*)(ws + WS_SCAN + (size_t)SA_AN * SCAN_ARR);
    const bf16* aA = (const bf16*)(ws + WS_SCAN + (size_t)(DIR ? SA_A1 : SA_A0) * SCAN_ARR); const bf16* aK = (const bf16*)(ws + WS_SCAN + (size_t)SA_K * SCAN_ARR);
    const bf16* aR = (const bf16*)(ws + WS_SCAN + (size_t)SA_R * SCAN_ARR); const bf16* aV = (const bf16*)(ws + WS_SCAN + (size_t)SA_V * SCAN_ARR);
    bf16* YO = (bf16*)(ws + WS_YS) + (size_t)DIR * ML * 512;
    LAS float* buf = (LAS float*)F.lds;
    constexpr int NCHK = TP / SC_TOK;
    if (F.wave >= 4) {
        const int st = F.tid - 256, stok = st >> 3, sc8 = 8 * (st & 7), vtok = st >> 1, vc8 = 8 * (st & 1);
        float ka8[8];
#pragma unroll
        for (int e = 0; e < 8; ++e) ka8[e] = A.in[I_RKA][h * 64 + sc8 + e];
        v4u sr[6];
#define SC_LOAD(ch) do { const size_t ro = (size_t)scan_row(b, DIR, (ch) * SC_TOK + stok) * 512 + h * 64 + sc8; \
            sr[0] = *(const v4u*)(aL + ro); sr[1] = *(const v4u*)(aAN + ro); sr[2] = *(const v4u*)(aA + ro); sr[3] = *(const v4u*)(aK + ro); sr[4] = *(const v4u*)(aR + ro); \
            if (st < 64) sr[5] = *(const v4u*)(aV + (size_t)scan_row(b, DIR, (ch) * SC_TOK + vtok) * 512 + h * 64 + 16 * q + vc8); } while (0)
#define SC_ST8(dst, f) do { *(LAS f32x4*)(dst) = (f32x4){f[0], f[1], f[2], f[3]}; *(LAS f32x4*)((dst) + 4) = (f32x4){f[4], f[5], f[6], f[7]}; } while (0)
#define SC_WRITE(bi) do { LAS float* tb_ = buf + (bi) * SC_BUF + stok * SC_STRIDE + sc8; \
            float fl[8], fn[8], fa[8], fk[8], fr[8], o[8]; unpack8(sr[0], fl); unpack8(sr[1], fn); unpack8(sr[2], fa); unpack8(sr[3], fk); unpack8(sr[4], fr); \
            _Pragma("unroll") for (int e = 0; e < 8; ++e) o[e] = __builtin_amdgcn_exp2f(-fl[e]); SC_ST8(tb_, o); SC_ST8(tb_ + 64, fn); \
            _Pragma("unroll") for (int e = 0; e < 8; ++e) o[e] = -fn[e] * fa[e]; SC_ST8(tb_ + 128, o); \
            _Pragma("unroll") for (int e = 0; e < 8; ++e) o[e] = fk[e] * (1.0f + (fa[e] - 1.0f) * ka8[e]); SC_ST8(tb_ + 192, o); SC_ST8(tb_ + 256, fr); \
            if (st < 64) { float fv[8]; unpack8(sr[5], fv); SC_ST8(buf + (bi) * SC_BUF + vtok * SC_STRIDE + 320 + vc8, fv); } } while (0)
        for (int rep = 0; rep < NREP; ++rep) {
        SC_LOAD(0); SC_WRITE(0); SC_LOAD(1);
        __syncthreads();
        for (int ch = 0; ch < NCHK; ++ch) {
            if (ch + 1 < NCHK) SC_WRITE((ch + 1) & 1);
            if (ch + 2 < NCHK) SC_LOAD(ch + 2);
            if (ch >= 1 && (ch - 1) * SC_TOK >= CT) { const int i = (ch - 1) * SC_TOK + stok, lt = DIR == 0 ? i - CT : (TP - 1 - i);
                const f32x2v y = *(const LAS f32x2v*)(buf + SC_YOFF + ((ch - 1) & 1) * (SC_TOK * 16) + stok * 16 + 2 * (st & 7));
                *(unsigned*)(YO + (size_t)(b * SL + lt) * 512 + h * 64 + 16 * q + 2 * (st & 7)) = pk2(y.x, y.y); }
            __syncthreads();
        }
        { const int i = (NCHK - 1) * SC_TOK + stok, lt = DIR == 0 ? i - CT : (TP - 1 - i);
          const f32x2v y = *(const LAS f32x2v*)(buf + SC_YOFF + ((NCHK - 1) & 1) * (SC_TOK * 16) + stok * 16 + 2 * (st & 7));
          *(unsigned*)(YO + (size_t)(b * SL + lt) * 512 + h * 64 + 16 * q + 2 * (st & 7)) = pk2(y.x, y.y); }
        __syncthreads();
        }
#undef SC_LOAD
#undef SC_WRITE
#undef SC_ST8
    } else {
        const int rowl = F.wave * 4 + (F.lane >> 4), ks = F.lane & 15;
#define SC_RD(X, p) do { X.w = *(const LAS f32x4*)((p) + 4 * ks); X.a = *(const LAS f32x4*)((p) + 64 + 4 * ks); X.b = *(const LAS f32x4*)((p) + 128 + 4 * ks); \
            X.k = *(const LAS f32x4*)((p) + 192 + 4 * ks); X.r = *(const LAS f32x4*)((p) + 256 + 4 * ks); X.v = (p)[320 + rowl]; } while (0)
#define SC_STEP(X, yp) do { float sa = dot4(s, X.a); float yo = DIR ? dot4(s, X.r) : 0.f; sa = dpp_add16(sa); \
            s = s * X.w + X.b * sa + X.k * X.v; if (!DIR) yo = dot4(s, X.r); yo = dpp_add16(yo); *(yp) = yo; } while (0)
        for (int rep = 0; rep < NREP; ++rep) {
        f32x4 s = {0.f, 0.f, 0.f, 0.f};
        __syncthreads();
        for (int ch = 0; ch < NCHK; ++ch) {
            const LAS float* tb = buf + (ch & 1) * SC_BUF; LAS float* yb = buf + SC_YOFF + (ch & 1) * (SC_TOK * 16) + rowl;
            ScanOps XA, XB; SC_RD(XA, tb);
#pragma unroll 2
            for (int t = 0; t < SC_TOK; t += 2) {
                SC_RD(XB, tb + SC_STRIDE); SC_STEP(XA, yb);
                SC_RD(XA, tb + 2 * SC_STRIDE); SC_STEP(XB, yb + 16);
                tb += 2 * SC_STRIDE; yb += 32;
            }
            __syncthreads();
        }
        __syncthreads();
        }
#undef SC_RD
#undef SC_STEP
    }
}
__device__ __forceinline__ void p15_finish1(const Frame& F, const Args& A) {
    const int l = F.lane; unsigned char* ws = F.ws;
    const bf16* OB = (const bf16*)(ws + WS_OB); const bf16* OB2 = (const bf16*)(ws + WS_OB2); const float* AST = (const float*)(ws + WS_ASTAT); const bf16* Y0 = (const bf16*)(ws + WS_YS); const bf16* Y1 = Y0 + (size_t)ML * 512; bf16* MIX = (bf16*)(ws + WS_H);
    const bf16* SR = (const bf16*)(ws + WS_SCAN + SA_R * SCAN_ARR); const bf16* SV = (const bf16*)(ws + WS_SCAN + SA_V * SCAN_ARR); const bf16* SK = (const bf16*)(ws + WS_SCAN + SA_K * SCAN_ARR); const bf16* SG = (const bf16*)(ws + WS_SCAN + SA_G * SCAN_ARR);
    const float* lv = A.in[I_DLAM];
    const float lam = __expf(wave_sum(lv[l] * lv[64 + l])) - __expf(wave_sum(lv[128 + l] * lv[192 + l])) + LAM_INIT;
    float sg[8], rk[8], lg[8], lb[8];
#pragma unroll
    for (int e = 0; e < 8; ++e) { sg[e] = A.in[I_DSUBG][8 * (l & 15) + e] * (1.0f - LAM_INIT); rk[e] = A.in[I_RRK][8 * l + e]; lg[e] = A.in[I_RLNG][8 * l + e]; lb[e] = A.in[I_RLNB][8 * l + e]; }
    for (int t = F.gw; t < ML; t += F.NGW) {
        const int b = t / SL, r = b * TP + CT + (t % SL);
        const int tl = t % SL; const bool split = (b == 1) && ((tl >> 7) >= A1_SPLIT_QB);
#pragma unroll
        for (int j = 0; j < 2; ++j) {
            float o[8];
            if (!split) unpack8(ldnt((const v4u*)(OB + (size_t)t * 1024 + 512 * j + 8 * l)), o);
            else {
                const int qh = (l >> 4) + 4 * j, sq = (tl >> 7) - A1_SPLIT_QB, u0 = A1_NWH + ((qh >> 1) * (64 - A1_SPLIT_QB) + sq) * A1_NP;
                const float* sp = AST + (size_t)u0 * 512 + ((qh & 1) * 128 + (tl & 127)) * 2; const bf16* op = OB2 + (size_t)(sq * A1_NP * 128 + (tl & 127)) * 1024 + 512 * j + 8 * l;
                f32x2v s[A1_NP]; float M = -3.0e38f, W = 0.f;
#pragma unroll
                for (int p = 0; p < A1_NP; ++p) { s[p] = *(const f32x2v*)(sp + (size_t)p * 512); M = fmaxf(M, s[p].x); }
#pragma unroll
                for (int e = 0; e < 8; ++e) o[e] = 0.f;
#pragma unroll
                for (int p = 0; p < A1_NP; ++p) { float op8[8]; unpack8(ldnt((const v4u*)(op + (size_t)p * 128 * 1024)), op8); const float w = s[p].y * exp2f((s[p].x - M) * 0.12751743f); W += w;
#pragma unroll
                    for (int e = 0; e < 8; ++e) o[e] += op8[e] * w; }
                const float inv = 1.0f / W;
#pragma unroll
                for (int e = 0; e < 8; ++e) o[e] *= inv;
            }
            float ss = 0.f;
#pragma unroll
            for (int e = 0; e < 8; ++e) { const float oo = __shfl_xor(o[e], 16); o[e] = o[e] - lam * oo; ss += o[e] * o[e]; }
            ss = sum16(ss);
            const float rs = rsqrtf(ss * (1.f / 128.f) + NORM_EPS);
#pragma unroll
            for (int e = 0; e < 8; ++e) o[e] = o[e] * rs * sg[e];
            if ((l & 16) == 0) stnt((v4u*)(MIX + (size_t)r * D + ((l >> 5) + 2 * j) * 128 + 8 * (l & 15)), pack8(o));
        }
        { float y0[8], y1[8], rr[8], kk[8], vv[8], gg[8];
          unpack8(ldnt((const v4u*)(Y0 + (size_t)t * 512 + 8 * l)), y0); unpack8(ldnt((const v4u*)(Y1 + (size_t)t * 512 + 8 * l)), y1);
          unpack8(ldnt((const v4u*)(SR + (size_t)r * 512 + 8 * l)), rr); unpack8(ldnt((const v4u*)(SK + (size_t)r * 512 + 8 * l)), kk); unpack8(ldnt((const v4u*)(SV + (size_t)r * 512 + 8 * l)), vv); unpack8(ldnt((const v4u*)(SG + (size_t)r * 512 + 8 * l)), gg);
          float sm = 0.f, bs = 0.f;
#pragma unroll
          for (int e = 0; e < 8; ++e) { y0[e] += y1[e]; sm += y0[e]; bs += rr[e] * kk[e] * rk[e]; }
          sm = sum8(sm); bs = sum8(bs);
          const float mean = sm * (1.f / 64.f); float vs = 0.f;
#pragma unroll
          for (int e = 0; e < 8; ++e) { y0[e] -= mean; vs += y0[e] * y0[e]; }
          vs = sum8(vs);
          const float rs = rsqrtf(vs * (1.f / 64.f) + RWKV_LN_EPS);
#pragma unroll
          for (int e = 0; e < 8; ++e) y0[e] = ((y0[e] * rs * lg[e] + lb[e]) + bs * vv[e]) * gg[e];
          stnt((v4u*)(MIX + (size_t)r * D + 512 + 8 * l), pack8(y0)); }
    }
}
__device__ __forceinline__ void route_row(const Frame& F, const Args& A, int t, const RowYX& R, ModRegs& M) {
    bf16* H2 = (bf16*)(F.ws + WS_H2);
    {
        f32x4 h[4]; mod_load(F, A, M, t / SL, 1, 0);
        resid_norm_m(F, R, M, A.out + (size_t)t * D, H2 + (size_t)t * D, h);
        float lg[8];
        const LAS float* RL = (const LAS float*)(F.lds + 1024);
#pragma unroll
        for (int e = 0; e < 8; ++e) { float s = 0.f;
#pragma unroll
            for (int j = 0; j < 4; ++j) { const f32x4 rw = *(const LAS f32x4*)(RL + e * 1024 + 4 * F.lane + 256 * j); s += (h[j][0] * rw[0] + h[j][1] * rw[1]) + (h[j][2] * rw[2] + h[j][3] * rw[3]); }
            lg[e] = s; }
#pragma unroll
        for (int e = 0; e < 8; ++e) lg[e] = wave_sum(lg[e]);
        int e0 = 0; float l0 = lg[0];
#pragma unroll
        for (int e = 1; e < 8; ++e) if (lg[e] > l0) { l0 = lg[e]; e0 = e; }
        int e1 = -1; float l1 = -3.0e38f;
#pragma unroll
        for (int e = 0; e < 8; ++e) if (e != e0 && lg[e] > l1) { l1 = lg[e]; e1 = e; }
        if (F.lane == 0) {
            const float w0 = __builtin_amdgcn_rcpf(1.0f + __expf(l1 - l0));
            LAS unsigned* lc = (LAS unsigned*)(F.lds + 64);
            const unsigned p0 = __hip_atomic_fetch_add(lc + e0, 1u, __ATOMIC_RELAXED, __HIP_MEMORY_SCOPE_WORKGROUP), p1 = __hip_atomic_fetch_add(lc + e1, 1u, __ATOMIC_RELAXED, __HIP_MEMORY_SCOPE_WORKGROUP);
            int* rec = (int*)(F.ws + WS_ROUTE) + (size_t)t * 8; rec[0] = e0; rec[1] = e1; rec[2] = (int)p0; rec[3] = (int)p1; ((float*)rec)[4] = w0; ((float*)rec)[5] = 1.0f - w0;
        }
    }
}
__device__ __forceinline__ void p17_route(const Frame& F, const Args& A) {
    const bf16* XR = (const bf16*)(F.ws + WS_XR); const bf16* Y = (const bf16*)(F.ws + WS_Y1);
    LAS unsigned* lc = (LAS unsigned*)(F.lds + 64); LAS unsigned* lb = (LAS unsigned*)(F.lds + 128);
    ModRegs M; M.cur = -1;
    if (F.tid < 8) lc[F.tid] = 0u;
    { LAS float* RL = (LAS float*)(F.lds + 1024); const float* RT = A.in[I_MROUTER];
      for (int i = F.tid; i < 8192; i += NWAVES * 64) RL[(i & 7) * 1024 + (i >> 3)] = RT[i]; }
    __syncthreads();
    for (int t = F.gw; t < ML; t += 2 * F.NGW) {
        const int t2 = t + F.NGW; const bool two = t2 < ML; const int tb = two ? t2 : t; RowYX Ra, Rb;
        const size_t ra = (size_t)((t / SL) * TP + CT + (t % SL)) * D, rb = (size_t)((tb / SL) * TP + CT + (tb % SL)) * D;
        load_yxb(F, Y + ra, XR + ra, Ra); load_yxb(F, Y + rb, XR + rb, Rb);
        route_row(F, A, t, Ra, M); if (two) route_row(F, A, t2, Rb, M);
    }
    asm volatile("s_waitcnt vmcnt(0) lgkmcnt(0)" ::: "memory");
    __syncthreads();
    if (F.tid < 8) lb[F.tid] = __hip_atomic_fetch_add((unsigned*)(F.ctl + CW_CNT + 64 * F.tid), lc[F.tid], RLX_AGENT);
    __syncthreads();
    for (int k = F.lane; F.gw + k * F.NGW < ML; k += 64) {
        int* rec = (int*)(F.ws + WS_ROUTE) + (size_t)(F.gw + k * F.NGW) * 8; const int e0 = rec[0], e1 = rec[1]; rec[2] += (int)lb[e0]; rec[3] += (int)lb[e1]; }
    __syncthreads();
}
__device__ __forceinline__ int moe_offsets(const Frame& F, int (&off)[NE + 1]) {
    int o = 0;
#pragma unroll
    for (int e = 0; e < NE; ++e) { off[e] = o; const int c = (int)__hip_atomic_load((unsigned*)(F.ctl + CW_CNT + 64 * e), RLX_AGENT); o += ((c + 255) >> 8) << 8; }
    off[NE] = o; return o >> 8;
}
__device__ __forceinline__ void p18_gather(const Frame& F, const Args& A) {
    int off[NE + 1]; const int nT = moe_offsets(F, off);
    if (blockIdx.x == 0 && F.tid < 256) { int e = 0;
#pragma unroll
        for (int k = 1; k < NE; ++k) if (F.tid * 256 >= off[k]) e = k;
        ((int*)(F.ws + WS_TILEE))[F.tid] = (F.tid < nT) ? e : 0; }
    const bf16* H2 = (const bf16*)(F.ws + WS_H2); bf16* AG = (bf16*)(F.ws + WS_AG);
    for (int t = F.gw; t < ML; t += F.NGW) {
        const int* rec = (const int*)(F.ws + WS_ROUTE) + (size_t)t * 8; const int e0 = rec[0], e1 = rec[1], p0 = rec[2], p1 = rec[3];
        int o0 = 0, o1 = 0;
#pragma unroll
        for (int k = 0; k < NE; ++k) { if (k == e0) o0 = off[k]; if (k == e1) o1 = off[k]; }
        const v4u a = ldnt((const v4u*)(H2 + (size_t)t * D + 8 * F.lane)), c = ldnt((const v4u*)(H2 + (size_t)t * D + 512 + 8 * F.lane));
        bf16* d0 = AG + (size_t)(o0 + p0) * D; bf16* d1 = AG + (size_t)(o1 + p1) * D;
        *(v4u*)(d0 + 8 * F.lane) = a; *(v4u*)(d0 + 512 + 8 * F.lane) = c; *(v4u*)(d1 + 8 * F.lane) = a; *(v4u*)(d1 + 512 + 8 * F.lane) = c;
    }
    moe_weights(F, A);
}
struct FinIn { f32x4 a[4], bq[4], o[4]; float w0, w1; };
__device__ __forceinline__ void fin_load(const Frame& F, const Args& A, int t, const int (&off)[NE + 1], FinIn& I) {
    const bf16* Y2 = (const bf16*)(F.ws + WS_AG);
    const int* rec = (const int*)(F.ws + WS_ROUTE) + (size_t)t * 8; const int e0 = rec[0], e1 = rec[1], p0 = rec[2], p1 = rec[3]; I.w0 = ((const float*)rec)[4]; I.w1 = ((const float*)rec)[5];
    int o0 = 0, o1 = 0;
#pragma unroll
    for (int k = 0; k < NE; ++k) { if (k == e0) o0 = off[k]; if (k == e1) o1 = off[k]; }
    const int ra = o0 + p0, rb = o1 + p1; const float* YF = (const float*)(F.ws + WS_Y2F);
    const bf16* ya = Y2 + (size_t)ra * D; const bf16* yb = Y2 + (size_t)rb * D; const float* o = A.out + (size_t)t * D;
#pragma unroll
    for (int j = 0; j < 4; ++j) { const int c = 4 * F.lane + 256 * j;
        if (ra < 32768 || F.G != 256) I.a[j] = ld_bf4_nt(ya + c); else { const float* q = YF + (size_t)(ra - 32768) * D + c; I.a[j] = ((*(const f32x4*)q + *(const f32x4*)(q + 2048 * D)) + *(const f32x4*)(q + 2 * 2048 * D)) + *(const f32x4*)(q + 3 * 2048 * D); }
        if (rb < 32768 || F.G != 256) I.bq[j] = ld_bf4_nt(yb + c); else { const float* q = YF + (size_t)(rb - 32768) * D + c; I.bq[j] = ((*(const f32x4*)q + *(const f32x4*)(q + 2048 * D)) + *(const f32x4*)(q + 2 * 2048 * D)) + *(const f32x4*)(q + 3 * 2048 * D); }
        I.o[j] = ldnt((const f32x4*)(o + c)); }
}
__device__ __forceinline__ void fin_row(const Frame& F, const Args& A, int t, const FinIn& I) {
    const float* ng = A.in[I_NORMG] + (4 + 3) * D; const int b = t / SL, r = b * TP + CT + (t % SL); const float* mv = modv(F, 1, r) + 5 * 1024;
    f32x4 m[4]; float ss = 0.f;
#pragma unroll
    for (int j = 0; j < 4; ++j) { m[j] = I.a[j] * I.w0 + I.bq[j] * I.w1; ss += sq4(m[j]); }
    const float rs = rsqrtf(wave_sum(ss) * (1.f / D) + NORM_EPS);
    float* o = A.out + (size_t)t * D;
#pragma unroll
    for (int j = 0; j < 4; ++j) { const int c = 4 * F.lane + 256 * j; stnt((f32x4*)(o + c), I.o[j] + *(const f32x4*)(mv + c) * (m[j] * rs * *(const f32x4*)(ng + c))); }
}
__device__ __forceinline__ void p21_final(const Frame& F, const Args& A) {
    int off[NE + 1]; (void)moe_offsets(F, off);
    for (int t = F.gw; t < ML; t += 2 * F.NGW) {
        const int t2 = t + F.NGW; const bool two = t2 < ML; FinIn Ia, Ib;
        fin_load(F, A, t, off, Ia); fin_load(F, A, two ? t2 : t, off, Ib);
        fin_row(F, A, t, Ia); if (two) fin_row(F, A, t2, Ib);
    }
}

constexpr int CK_RS = 72, CK_ARR = 64 * CK_RS * 2;
constexpr int CK_AH = 0, CK_BH = CK_ARR, CK_KH = 2 * CK_ARR, CK_RH = 3 * CK_ARR, CK_BCT = 4 * CK_ARR, CK_KCT = 5 * CK_ARR + 128, CK_VT = 6 * CK_ARR + 256, CK_ZT = 7 * CK_ARR + 384,
              CK_NOFF = 9 * CK_ARR + 640, CK_MAK = 10 * CK_ARR + 640, CK_ARB = 11 * CK_ARR + 640, CK_ARK = 12 * CK_ARR + 640, CK_XT = 13 * CK_ARR + 640, CK_TT = 14 * CK_ARR + 640, CK_ND = CK_TT + 4 * 16 * 40 * 2,
              CK_WS = CK_ND + 4 * 16 * 17 * 4, CK_GAM = CK_WS + 8 * 16 * 40 * 2, CK_WT = CK_GAM + 256, CK_END = CK_WT + 8 * 64 * 4;
constexpr int CK_P0 = CK_AH, CK_RT = CK_BH;
static_assert(CK_END <= RING_BYTES, "chunked scan LDS");
__device__ __forceinline__ int trow(int f) { return f * CK_RS + (f >> 3) * 8; }
template <int KS, bool SA, bool SB> __device__ __forceinline__ void mm32s(f32x16& acc, const lbf16* A, const lbf16* B, int r32, int hi) {
    const int oa = r32 * CK_RS + (SA ? (r32 >> 3) * 8 : 0), ob = r32 * CK_RS + (SB ? (r32 >> 3) * 8 : 0);
#pragma unroll
    for (int ks = 0; ks < KS; ++ks) { const bf16x8 a = *(const LAS bf16x8*)(A + oa + 16 * ks + 8 * hi), bb = *(const LAS bf16x8*)(B + ob + 16 * ks + 8 * hi);
        acc = __builtin_amdgcn_mfma_f32_32x32x16_bf16(a, bb, acc, 0, 0, 0); }
}
template <int KS> __device__ __forceinline__ void mm32(f32x16& acc, const lbf16* A, const lbf16* B, int r32, int hi) {
#pragma unroll
    for (int ks = 0; ks < KS; ++ks) { const bf16x8 a = *(const LAS bf16x8*)(A + r32 * CK_RS + 16 * ks + 8 * hi), bb = *(const LAS bf16x8*)(B + r32 * CK_RS + 16 * ks + 8 * hi);
        acc = __builtin_amdgcn_mfma_f32_32x32x16_bf16(a, bb, acc, 0, 0, 0); }
}
__device__ __forceinline__ unsigned pk2h(float lo, float hi) { return pk2(lo, hi); }
__device__ __forceinline__ v4u pack8h(const float (&f)[8]) { v4u w; w.x = pk2h(f[0], f[1]); w.y = pk2h(f[2], f[3]); w.z = pk2h(f[4], f[5]); w.w = pk2h(f[6], f[7]); return w; }
#define CK_LDSFENCE() asm volatile("s_waitcnt lgkmcnt(0)" ::: "memory")
__device__ __forceinline__ void ck_precompute(const Frame& F, const Args& A) {
    constexpr int NCK = TP / 64, NITEM = 32 * NCK;
    unsigned char* ws = F.ws; LAS unsigned char* L = F.lds;
    const bf16* SC = (const bf16*)(ws + WS_SCAN);
    const int tid = F.tid, lane = F.lane, w = F.wave, r32 = lane & 31, hi = lane >> 5;
    const int tt = tid >> 3, pc = tid & 7;
    lbf16* AH = (lbf16*)(L + CK_AH); lbf16* BH = (lbf16*)(L + CK_BH); lbf16* KH = (lbf16*)(L + CK_KH); lbf16* RH = (lbf16*)(L + CK_RH);
    lbf16* BCT = (lbf16*)(L + CK_BCT); lbf16* KCT = (lbf16*)(L + CK_KCT); lbf16* VT = (lbf16*)(L + CK_VT); lbf16* ZT = (lbf16*)(L + CK_ZT);
    lbf16* NOFF = (lbf16*)(L + CK_NOFF); lbf16* MAK = (lbf16*)(L + CK_MAK); lbf16* ARB = (lbf16*)(L + CK_ARB); lbf16* ARK = (lbf16*)(L + CK_ARK);
    lbf16* XT = (lbf16*)(L + CK_XT); lbf16* TT = (lbf16*)(L + CK_TT); LAS float* ND = (LAS float*)(L + CK_ND); lbf16* WS = (lbf16*)(L + CK_WS) + w * 16 * 40;
    LAS float* GAM = (LAS float*)(L + CK_GAM); LAS float* WT = (LAS float*)(L + CK_WT); lbf16* P0 = (lbf16*)(L + CK_P0); lbf16* RT = (lbf16*)(L + CK_RT);
    for (int i = tid; i < (CK_ND - CK_TT) / 4; i += 512) ((LAS unsigned*)TT)[i] = 0u;
    for (int i = tid; i < 8 * 16 * 40 / 2; i += 512) ((LAS unsigned*)(L + CK_WS))[i] = 0u;
    v4u pl, pn, pa, pk, pr, pv;
#define CK_LOAD(it_) do { const int sd_ = (it_) / NCK, c_ = (it_) % NCK, d_ = sd_ & 1, s_ = sd_ >> 1; \
        const size_t ro = (size_t)scan_row(s_ >> 3, d_, c_ * 64 + tt) * 512 + (s_ & 7) * 64 + 8 * pc; const size_t SAE = SCAN_ARR / 2; \
        pl = *(const v4u*)(SC + (size_t)(d_ ? SA_L1 : SA_L0) * SAE + ro); pn = *(const v4u*)(SC + (size_t)SA_AN * SAE + ro); pa = *(const v4u*)(SC + (size_t)(d_ ? SA_A1 : SA_A0) * SAE + ro); \
        pk = *(const v4u*)(SC + (size_t)SA_K * SAE + ro); pr = *(const v4u*)(SC + (size_t)SA_R * SAE + ro); pv = *(const v4u*)(SC + (size_t)SA_V * SAE + ro); } while (0)
    const int it0 = (int)blockIdx.x;
    if (it0 < NITEM) CK_LOAD(it0);
    __syncthreads();
#ifdef PROBE_STAGE
    volatile LAS unsigned long long* ps_ = (volatile LAS unsigned long long*)(F.lds + MISC_OFF + 64); unsigned long long st_prev = rt(); int st_id = 0;
#define CK_STAMP() do { if (blockIdx.x == 0 && tid == 0) { const unsigned long long n_ = rt(); if (st_id == PROBE_STAGE) ps_[1] = ps_[1] + (n_ - st_prev); st_prev = n_; } ++st_id; } while (0)
#else
#define CK_STAMP() do {} while (0)
#endif
    for (int item = it0; item < NITEM; item += F.G) {
#ifdef PROBE_STAGE
        st_id = 0;
#endif
        const int sdir = item / NCK, c = item % NCK, DIR = sdir & 1, sid = sdir >> 1, h = sid & 7;
        float ka8[8];
#pragma unroll
        for (int e = 0; e < 8; ++e) ka8[e] = A.in[I_RKA][h * 64 + 8 * pc + e];
        float lam[8]; unpack8(pl, lam);
        float Lm[8];
#pragma unroll
        for (int e = 0; e < 8; ++e) { float x = lam[e]; float y = __shfl_up(x, 8); if (lane >= 8) x += y; y = __shfl_up(x, 16); if (lane >= 16) x += y; y = __shfl_up(x, 32); if (lane >= 32) x += y; Lm[e] = x; }
        if (lane >= 56) {
#pragma unroll
            for (int e = 0; e < 8; ++e) WT[w * 64 + 8 * pc + e] = Lm[e]; }
        __syncthreads(); CK_STAMP();
        {
            float off[8], tot[8];
#pragma unroll
            for (int e = 0; e < 8; ++e) { off[e] = 0.f; tot[e] = 0.f; }
#pragma unroll
            for (int w2 = 0; w2 < 8; ++w2) { const f32x4 x0 = *(const LAS f32x4*)(WT + w2 * 64 + 8 * pc), x1 = *(const LAS f32x4*)(WT + w2 * 64 + 8 * pc + 4);
#pragma unroll
                for (int e = 0; e < 4; ++e) { tot[e] += x0[e]; tot[4 + e] += x1[e]; if (w2 < w) { off[e] += x0[e]; off[4 + e] += x1[e]; } } }
            float an[8], ag[8], kk[8], rr[8]; unpack8(pn, an); unpack8(pa, ag); unpack8(pk, kk); unpack8(pr, rr);
            float ah[8], bh[8], kh[8], rh[8], bc[8], kc[8];
#pragma unroll
            for (int e = 0; e < 8; ++e) {
                const float Lt = Lm[e] + off[e], Lp = Lt - lam[e];
                const float em = __builtin_amdgcn_exp2f(-Lp), ep = __builtin_amdgcn_exp2f(Lt), ec = __builtin_amdgcn_exp2f(Lt - tot[e]), er = DIR ? em : __builtin_amdgcn_exp2f(-Lt);
                const float bb = -an[e] * ag[e], kd = kk[e] * (1.0f + (ag[e] - 1.0f) * ka8[e]);
                ah[e] = an[e] * em; bh[e] = bb * ep; kh[e] = kd * ep; rh[e] = rr[e] * er; bc[e] = bb * ec; kc[e] = kd * ec;
            }
            const v4u pah = pack8h(ah), pbc = pack8h(bc), pkc = pack8h(kc);
            *(LAS v4u*)(AH + tt * CK_RS + 8 * pc) = pah; *(LAS v4u*)(BH + tt * CK_RS + 8 * pc) = pack8h(bh);
            *(LAS v4u*)(KH + tt * CK_RS + 8 * pc) = pack8h(kh); *(LAS v4u*)(RH + tt * CK_RS + 8 * pc) = pack8h(rh);
#pragma unroll
            for (int e2 = 0; e2 < 4; ++e2) { const int kcol = 8 * pc + 2 * e2; const unsigned xa = pah[e2], xb = pbc[e2], xk = pkc[e2], xv = pv[e2];
                ZT[trow(kcol) + tt] = (unsigned short)xa; ZT[trow(kcol + 1) + tt] = (unsigned short)(xa >> 16);
                BCT[trow(kcol) + tt] = (unsigned short)xb; BCT[trow(kcol + 1) + tt] = (unsigned short)(xb >> 16);
                KCT[trow(kcol) + tt] = (unsigned short)xk; KCT[trow(kcol + 1) + tt] = (unsigned short)(xk >> 16);
                VT[trow(kcol) + tt] = (unsigned short)xv; VT[trow(kcol + 1) + tt] = (unsigned short)(xv >> 16); }
            if (tt == 63) {
#pragma unroll
                for (int e = 0; e < 8; ++e) ((float*)(ws + WS_CKGAM))[(size_t)item * 64 + 8 * pc + e] = __builtin_amdgcn_exp2f(-tot[e]); }
        }
        if (item + F.G < NITEM) CK_LOAD(item + F.G);
        __syncthreads(); CK_STAMP();
        {
            const int rt = w >> 1; const lbf16* Ap = (rt < 2 ? AH : RH) + (32 * (rt & 1)) * CK_RS;
#pragma unroll
            for (int q = 0; q < 2; ++q) {
                const int ct = 2 * (w & 1) + q, rbk = rt & 1; const lbf16* Bp = (ct < 2 ? BH : KH) + (32 * q) * CK_RS;
                const int i = 32 * q + r32;
                lbf16* dst = rt < 2 ? (ct < 2 ? NOFF : MAK) : (ct < 2 ? ARB : ARK);
                if (rbk < q) {
#pragma unroll
                    for (int r = 0; r < 16; ++r) dst[(32 * rbk + (r & 3) + 8 * (r >> 2) + 4 * hi) * CK_RS + i] = 0;
                } else {
                    f32x16 acc = {}; mm32<4>(acc, Ap, Bp, r32, hi);
                    if (rbk > q) {
#pragma unroll
                        for (int r = 0; r < 16; r += 2) { const unsigned x = pk2h(acc[r], acc[r + 1]); const int t = 32 * rbk + (r & 3) + 8 * (r >> 2) + 4 * hi;
                            dst[t * CK_RS + i] = (unsigned short)x; dst[(t + 1) * CK_RS + i] = (unsigned short)(x >> 16); }
                    } else {
#pragma unroll
                        for (int r = 0; r < 16; ++r) { const int t = 32 * rbk + (r & 3) + 8 * (r >> 2) + 4 * hi;
                            const bool keep = rt < 2 ? (t > i) : (DIR ? (t > i) : (t >= i)); float v = keep ? acc[r] : 0.f;
                            if (rt < 2 && ct < 2) { if ((t >> 4) == (i >> 4)) { ND[((t >> 4) * 16 + (t & 15)) * 17 + (i & 15)] = v; v = 0.f; } }
                            dst[t * CK_RS + i] = (unsigned short)pk2h(v, v); }
                    }
                }
            }
        }
        __syncthreads(); CK_STAMP();
        if (w < 4) {
            const int vt = w >> 1, t2 = w & 1; f32x16 acc = {}; mm32s<4, true, false>(acc, VT + trow(32 * vt), MAK + 32 * t2 * CK_RS, r32, hi);
#pragma unroll
            for (int r = 0; r < 16; ++r) ZT[trow(64 + 32 * vt + (r & 3) + 8 * (r >> 2) + 4 * hi) + 32 * t2 + r32] = (unsigned short)f2bf(acc[r]);
        } else if (w == 4) {
            const int blk = lane >> 4, j = lane & 15; float s[16];
#pragma unroll
            for (int t = 0; t < 16; ++t) s[t] = (t == j) ? 1.f : 0.f;
#pragma unroll
            for (int i = 0; i < 16; ++i) { const float ti = s[i]; TT[(blk * 16 + i) * 40 + j] = (unsigned short)f2bf(ti);
#pragma unroll
                for (int t = 0; t < 16; ++t) if (t > i) s[t] += ND[(blk * 16 + t) * 17 + i] * ti; }
        }
        __syncthreads(); CK_STAMP();
        {
            const int c16 = lane & 15, q4 = lane >> 4; const int zr0 = 16 * w;
#pragma unroll
            for (int I = 0; I < 4; ++I) {
                f32x4 acc;
#pragma unroll
                for (int j = 0; j < 4; ++j) acc[j] = bf2f(ZT[trow(zr0 + 4 * q4 + j) + 16 * I + c16]);
                if (I >= 1) {
#pragma unroll
                    for (int ks = 0; ks < (I == 3 ? 2 : 1); ++ks) {
                        const bf16x8 a = *(const LAS bf16x8*)(ZT + trow(zr0 + c16) + 32 * ks + 8 * q4), bb = *(const LAS bf16x8*)(NOFF + (16 * I + c16) * CK_RS + 32 * ks + 8 * q4);
                        acc = __builtin_amdgcn_mfma_f32_16x16x32_bf16(a, bb, acc, 0, 0, 0); } }
#pragma unroll
                for (int j = 0; j < 4; ++j) WS[(4 * q4 + j) * 40 + c16] = (unsigned short)f2bf(acc[j]);
                CK_LDSFENCE();
                const bf16x8 a2 = *(const LAS bf16x8*)(WS + c16 * 40 + 8 * q4), b2 = *(const LAS bf16x8*)(TT + (I * 16 + c16) * 40 + 8 * q4);
                f32x4 z = {0.f, 0.f, 0.f, 0.f}; z = __builtin_amdgcn_mfma_f32_16x16x32_bf16(a2, b2, z, 0, 0, 0);
#pragma unroll
                for (int j = 0; j < 4; ++j) ZT[trow(zr0 + 4 * q4 + j) + 16 * I + c16] = (unsigned short)f2bf(z[j]);
                CK_LDSFENCE();
            }
        }
        __syncthreads(); CK_STAMP();
        {
            const int u = w & 3, kpt = u >> 1, ot = u & 1; f32x16 acc = {};
            if (w < 4) mm32s<4, true, true>(acc, ZT + trow(32 * kpt), BCT + trow(32 * ot), r32, hi); else mm32s<4, true, false>(acc, ZT + trow(32 * kpt), ARB + 32 * ot * CK_RS, r32, hi);
            v4u* dst = (v4u*)(ws + (w < 4 ? WS_CKP0 : WS_CKRT)) + (size_t)item * 512 + (ot * 4 + 2 * kpt) * 64 + lane;
#pragma unroll
            for (int s2 = 0; s2 < 2; ++s2) { float o[8];
#pragma unroll
                for (int j = 0; j < 8; ++j) o[j] = acc[8 * s2 + j];
                if (w >= 4) {
#pragma unroll
                    for (int hf = 0; hf < 2; ++hf) { const v2u rw = *(const LAS v2u*)(RH + (32 * ot + r32) * CK_RS + 32 * kpt + 16 * s2 + 8 * hf + 4 * hi);
                        o[4 * hf] += __uint_as_float(rw.x << 16); o[4 * hf + 1] += __uint_as_float(rw.x & 0xffff0000u); o[4 * hf + 2] += __uint_as_float(rw.y << 16); o[4 * hf + 3] += __uint_as_float(rw.y & 0xffff0000u); } }
                dst[s2 * 64] = pack8(o); }
        }
        {
            const int u = w & 3, rt2 = u >> 1, vt = u & 1; f32x16 acc = {};
            if (w < 4) mm32s<4, true, true>(acc, BCT + trow(32 * rt2), ZT + trow(64 + 32 * vt), r32, hi); else mm32s<4, false, true>(acc, ARB + 32 * rt2 * CK_RS, ZT + trow(64 + 32 * vt), r32, hi);
            if (w < 4) mm32s<4, true, true>(acc, KCT + trow(32 * rt2), VT + trow(32 * vt), r32, hi); else mm32s<4, false, true>(acc, ARK + 32 * rt2 * CK_RS, VT + trow(32 * vt), r32, hi);
            unsigned* dmp = (unsigned*)(ws + (w < 4 ? WS_CKQ : (DIR ? WS_CKC4B : WS_CKC4A))) + (size_t)(w < 4 ? item : sid * (TP / 64) + c) * 2048 + u * 512 + lane;
#pragma unroll
            for (int g = 0; g < 8; ++g) dmp[g * 64] = pk2(acc[2 * g], acc[2 * g + 1]);
        }
        __syncthreads(); CK_STAMP();
    }
#undef CK_LOAD
}

struct CkSet { bf16x8 af[4]; unsigned dq[8]; f32x4 gm[4]; };
template <int DIR> __device__ __forceinline__ void ck_consume(const Frame& F, int sid) {
    const int b = sid >> 3, h = sid & 7; unsigned char* ws = F.ws;
    constexpr int NCK = TP / 64; const int item0 = (sid * 2 + DIR) * NCK;
    const int lane = F.lane, w = F.wave, r32 = lane & 31, hi = lane >> 5, u = w & 3, rt2 = u >> 1, vt = u & 1;
    lbf16* XT = (lbf16*)(F.lds);
    bf16* YO = (bf16*)(ws + WS_YS) + (size_t)DIR * ML * 512;
    for (int i = F.tid; i < 64 * CK_RS / 2; i += 512) ((LAS unsigned*)XT)[i] = 0u;
    const bf16x8* Ag = (const bf16x8*)(ws + (w < 4 ? WS_CKP0 : WS_CKRT)) + (size_t)item0 * 512 + (rt2 * 4) * 64 + lane;
    const unsigned* Dg = (const unsigned*)(ws + (w < 4 ? WS_CKQ : (DIR ? WS_CKC4B : WS_CKC4A))) + (size_t)(w < 4 ? item0 : sid * NCK) * 2048 + u * 512 + lane;
    const float* Gg = (const float*)(ws + WS_CKGAM) + (size_t)item0 * 64 + 32 * rt2 + 4 * hi;
    f32x16 X = {};
#define CC_LOAD(S, c) do { _Pragma("unroll") for (int ks = 0; ks < 4; ++ks) S.af[ks] = __builtin_nontemporal_load(Ag + (size_t)(c) * 512 + ks * 64); \
        _Pragma("unroll") for (int g = 0; g < 8; ++g) S.dq[g] = __builtin_nontemporal_load(Dg + (size_t)(c) * 2048 + g * 64); \
        if (w < 4) { _Pragma("unroll") for (int g4 = 0; g4 < 4; ++g4) S.gm[g4] = *(const f32x4*)(Gg + (size_t)(c) * 64 + 8 * g4); } } while (0)
#define CC_STEP(S, c) do { f32x16 acc; \
        _Pragma("unroll") for (int g = 0; g < 8; ++g) { acc[2 * g] = __uint_as_float(S.dq[g] << 16); acc[2 * g + 1] = __uint_as_float(S.dq[g] & 0xffff0000u); } \
        _Pragma("unroll") for (int ks = 0; ks < 4; ++ks) { const v2u xl_ = *(const LAS v2u*)(XT + (32 * vt + r32) * CK_RS + 16 * ks + 4 * hi), xh_ = *(const LAS v2u*)(XT + (32 * vt + r32) * CK_RS + 16 * ks + 8 + 4 * hi); \
            const bf16x8 xb = __builtin_bit_cast(bf16x8, ((v4u){xl_.x, xl_.y, xh_.x, xh_.y})); \
            acc = __builtin_amdgcn_mfma_f32_32x32x16_bf16(S.af[ks], xb, acc, 0, 0, 0); } \
        if (w < 4) { _Pragma("unroll") for (int g4 = 0; g4 < 4; ++g4) _Pragma("unroll") for (int j = 0; j < 4; ++j) X[4 * g4 + j] = S.gm[g4][j] * X[4 * g4 + j] + acc[4 * g4 + j]; } \
        else if ((c) * 64 >= CT) { _Pragma("unroll") for (int r = 0; r < 16; ++r) { const int i = (c) * 64 + 32 * rt2 + (r & 3) + 8 * (r >> 2) + 4 * hi, lt = DIR == 0 ? i - CT : (TP - 1 - i); \
                YO[(size_t)(b * SL + lt) * 512 + h * 64 + 32 * vt + r32] = (bf16)(pk2h(acc[r], acc[r]) & 0xffffu); } } \
        if ((c) + 4 < NCK) CC_LOAD(S, (c) + 4); \
        __syncthreads(); \
        if (w < 4) { _Pragma("unroll") for (int g4 = 0; g4 < 4; ++g4) { v2u ow; ow.x = pk2h(X[4 * g4], X[4 * g4 + 1]); ow.y = pk2h(X[4 * g4 + 2], X[4 * g4 + 3]); \
                *(LAS v2u*)(XT + (32 * vt + r32) * CK_RS + 32 * rt2 + 8 * g4 + 4 * hi) = ow; } } \
        __syncthreads(); } while (0)
    CkSet S0, S1, S2, S3;
    CC_LOAD(S0, 0); CC_LOAD(S1, 1); CC_LOAD(S2, 2); CC_LOAD(S3, 3);
    __syncthreads();
    static_assert(NCK % 4 == 0, "chunk count");
    for (int c = 0; c < NCK; c += 4) { CC_STEP(S0, c); CC_STEP(S1, c + 1); CC_STEP(S2, c + 2); CC_STEP(S3, c + 3); }
#undef CC_LOAD
#undef CC_STEP
}
__device__ __forceinline__ void ck_consume_wave(const Frame& F, int task) {
    const int sdir = task >> 1, vh = task & 1, dir = sdir & 1, sid = sdir >> 1, b = sid >> 3, h = sid & 7; unsigned char* ws = F.ws;
    constexpr int NCK = TP / 64; const int item0 = sdir * NCK, lane = F.lane, r32 = lane & 31, hi = lane >> 5;
    const bf16* Pg = (const bf16*)(ws + WS_CKP0) + (size_t)item0 * 4096 + r32 * 64 + 4 * hi; const bf16* Rg = (const bf16*)(ws + WS_CKRT) + (size_t)item0 * 4096 + r32 * 64 + 4 * hi;
    const unsigned* Qd = (const unsigned*)(ws + WS_CKQ) + (size_t)item0 * 2048 + vh * 512 + lane;
    const unsigned* Cd = (const unsigned*)(ws + (dir ? WS_CKC4B : WS_CKC4A)) + (size_t)(sid * NCK) * 2048 + vh * 512 + lane;
    const float* Gg = (const float*)(ws + WS_CKGAM) + (size_t)item0 * 64 + 4 * hi;
    bf16* YO = (bf16*)(ws + WS_YS) + (size_t)dir * ML * 512 + h * 64 + 32 * vh + r32;
    f32x16 X0 = {}, X1 = {};
    v2u pf[2][4][2], rf[2][4][2]; unsigned qd[2][8], cd[2][8]; f32x4 gm[2][4];
#define CW_LOADP(c) do { _Pragma("unroll") for (int kt = 0; kt < 2; ++kt) _Pragma("unroll") for (int q = 0; q < 4; ++q) { const bf16* p_ = Pg + (size_t)(c) * 4096 + kt * 2048 + 16 * q; pf[kt][q][0] = *(const v2u*)p_; pf[kt][q][1] = *(const v2u*)(p_ + 8); } \
        _Pragma("unroll") for (int kt = 0; kt < 2; ++kt) { _Pragma("unroll") for (int g = 0; g < 8; ++g) qd[kt][g] = Qd[(size_t)(c) * 2048 + kt * 1024 + g * 64]; \
            _Pragma("unroll") for (int g4 = 0; g4 < 4; ++g4) gm[kt][g4] = *(const f32x4*)(Gg + (size_t)(c) * 64 + 32 * kt + 8 * g4); } } while (0)
#define CW_LOADR(c) do { _Pragma("unroll") for (int kt = 0; kt < 2; ++kt) { _Pragma("unroll") for (int q = 0; q < 4; ++q) { const bf16* p_ = Rg + (size_t)(c) * 4096 + kt * 2048 + 16 * q; rf[kt][q][0] = *(const v2u*)p_; rf[kt][q][1] = *(const v2u*)(p_ + 8); } \
            _Pragma("unroll") for (int g = 0; g < 8; ++g) cd[kt][g] = Cd[(size_t)(c) * 2048 + kt * 1024 + g * 64]; } } while (0)
#define CW_FRAG(f_) __builtin_bit_cast(bf16x8, ((v4u){f_[0].x, f_[0].y, f_[1].x, f_[1].y}))
#define CW_XB(Xt, s) __builtin_bit_cast(bf16x8, ((v4u){pk2h(Xt[8 * (s)], Xt[8 * (s) + 1]), pk2h(Xt[8 * (s) + 2], Xt[8 * (s) + 3]), pk2h(Xt[8 * (s) + 4], Xt[8 * (s) + 5]), pk2h(Xt[8 * (s) + 6], Xt[8 * (s) + 7])}))
    CW_LOADR(0); CW_LOADP(0);
    for (int c = 0; c < NCK; ++c) {
        bf16x8 xb[4]; xb[0] = CW_XB(X0, 0); xb[1] = CW_XB(X0, 1); xb[2] = CW_XB(X1, 0); xb[3] = CW_XB(X1, 1);
#pragma unroll
        for (int t2 = 0; t2 < 2; ++t2) {
            f32x16 acc;
#pragma unroll
            for (int g = 0; g < 8; ++g) { acc[2 * g] = __uint_as_float(cd[t2][g] << 16); acc[2 * g + 1] = __uint_as_float(cd[t2][g] & 0xffff0000u); }
#pragma unroll
            for (int q = 0; q < 4; ++q) acc = __builtin_amdgcn_mfma_f32_32x32x16_bf16(CW_FRAG(rf[t2][q]), xb[q], acc, 0, 0, 0);
            if (c * 64 >= CT) {
#pragma unroll
                for (int r = 0; r < 16; ++r) { const int i = c * 64 + 32 * t2 + (r & 3) + 8 * (r >> 2) + 4 * hi, lt = dir == 0 ? i - CT : (TP - 1 - i);
                    YO[(size_t)(b * SL + lt) * 512] = (bf16)(pk2h(acc[r], acc[r]) & 0xffffu); } }
        }
        if (c + 1 < NCK) CW_LOADR(c + 1);
        f32x16 a0, a1;
#pragma unroll
        for (int g = 0; g < 8; ++g) { a0[2 * g] = __uint_as_float(qd[0][g] << 16); a0[2 * g + 1] = __uint_as_float(qd[0][g] & 0xffff0000u); a1[2 * g] = __uint_as_float(qd[1][g] << 16); a1[2 * g + 1] = __uint_as_float(qd[1][g] & 0xffff0000u); }
#pragma unroll
        for (int q = 0; q < 4; ++q) { a0 = __builtin_amdgcn_mfma_f32_32x32x16_bf16(CW_FRAG(pf[0][q]), xb[q], a0, 0, 0, 0); a1 = __builtin_amdgcn_mfma_f32_32x32x16_bf16(CW_FRAG(pf[1][q]), xb[q], a1, 0, 0, 0); }
#pragma unroll
        for (int g4 = 0; g4 < 4; ++g4)
#pragma unroll
            for (int j = 0; j < 4; ++j) { X0[4 * g4 + j] = gm[0][g4][j] * X0[4 * g4 + j] + a0[4 * g4 + j]; X1[4 * g4 + j] = gm[1][g4][j] * X1[4 * g4 + j] + a1[4 * g4 + j]; }
        if (c + 1 < NCK) CW_LOADP(c + 1);
    }
#undef CW_LOADP
#undef CW_LOADR
#undef CW_FRAG
#undef CW_XB
}

__global__ void __launch_bounds__(NWAVES * 64, 2) hyb_fwd(Args args) {
    extern __shared__ __attribute__((aligned(16))) unsigned char lds[];
    Frame F;
    F.lds = (LAS unsigned char*)lds; F.ldsg = (char*)lds;
    F.MISC = (volatile LAS unsigned*)(F.lds + MISC_OFF);
    F.tid = threadIdx.x; F.lane = F.tid & 63; F.wave = __builtin_amdgcn_readfirstlane(F.tid >> 6);
    F.G = gridDim.x; { const int bx = blockIdx.x; F.vcu = (F.G % 8 == 0) ? (bx % 8) * (F.G / 8) + bx / 8 : bx; }
    F.gw = F.vcu * NWAVES + F.wave; F.NGW = F.G * NWAVES;
    F.ws = args.ws; F.ctl = (gu32*)(args.ws + WS_CTL);
    unsigned char* ws = args.ws;
    for (int u = F.tid; u < (LDS_BYTES - LDSCTL_OFF) / 4; u += NWAVES * 64) ((LAS unsigned*)(F.lds + LDSCTL_OFF))[u] = 0u;
    __syncthreads();
    XcdBarrier bar; bar.bar = (unsigned*)(F.ctl + CW_BAR); bar.x = 0; bar.st = nullptr;
    if (N_LAUNCHES == 1) bar = xcd_barrier_post((unsigned*)(F.ctl + CW_BAR), F.MISC + 8);
#ifndef EXTRA_BAR
#define EXTRA_BAR 0
#endif
#define GRID_BAR() do { if (N_LAUNCHES == 1) { xcd_barrier(bar); for (int xb_ = 0; xb_ < EXTRA_BAR; ++xb_) xcd_barrier(bar); } } while (0)
    const int lo = args.ph_lo, hi = args.ph_hi;
#ifndef PHMASK
#define PHMASK 0xffffffu
#endif
#define IN(k) ((((PHMASK) >> (k)) & 1u) && lo <= (k) && (k) < hi)
#ifndef REPMASK
#define REPMASK 0u
#endif
#define REPN(k) ((((REPMASK) >> (k)) & 1u) ? 2 : 1)
#define REP(k) _Pragma("unroll") for (int rep_ = 0; rep_ < (((k) == 6 || (k) == 16) ? 1 : REPN(k)); ++rep_)
#ifdef PROBE_MASK
    volatile LAS unsigned long long* pr_ = (volatile LAS unsigned long long*)(F.lds + MISC_OFF + 64);
    if (F.tid == 0) { pr_[0] = rt(); pr_[1] = 0ull; }
#ifdef PROBE_TAILK
#define SEAM(k) do { if ((k) == PROBE_TAILK) { __syncthreads(); if (F.tid == 0) { unsigned long long z_ = 0ull; __hip_atomic_compare_exchange_strong((unsigned long long*)(F.ctl + 4608), &z_, (unsigned long long)rt(), __ATOMIC_RELAXED, __ATOMIC_RELAXED, __HIP_MEMORY_SCOPE_AGENT); } } \
    if (IN(k) && IN((k) + 1)) GRID_BAR(); if ((k) == PROBE_TAILK && blockIdx.x == 0 && F.tid == 0) { const unsigned long long now_ = rt(); pr_[1] = pr_[1] + (now_ - __hip_atomic_load((unsigned long long*)(F.ctl + 4608), __ATOMIC_RELAXED, __HIP_MEMORY_SCOPE_AGENT)); } } while (0)
#else
#define SEAM(k) do { if (IN(k) && IN((k) + 1)) GRID_BAR(); if (blockIdx.x == 0 && F.tid == 0) { const unsigned long long now_ = rt(); if (((PROBE_MASK) >> (k)) & 1u) pr_[1] = pr_[1] + (now_ - pr_[0]); pr_[0] = now_; } } while (0)
#endif
#else
#define SEAM(k) do { if (IN(k) && IN((k) + 1)) GRID_BAR(); } while (0)
#endif
    const int cb = (int)blockIdx.x;
#define OPQ(x) ({ int v_ = (x); asm volatile("" : "+s"(v_)); v_; })

    if (IN(0)) REP(0) { p0_prologue(F, args); } SEAM(0);
    if (IN(1)) REP(1) { p1_first_h(F, args); } SEAM(1);
    if (IN(2)) REP(2) {
        { pg8::Gemm g{(const pg8::bf16_t*)(ws + WS_H), (const pg8::bf16_t*)(ws + WS_WIN0), MR, E_IN, OPQ(D)}; pg8::LatOrder S; S.init(ML, E_IN, F.G, cb);
          pg8::EpiStore E{(pg8::bf16_t*)(ws + WS_PRJ0), E_IN, E_IN / 256};
          pg8::gemm_phase<pg8::EpiStore, pg8::LatOrder, true, true>(F.lds + RING_OFF, g, S, E); }
        { pg8::Gemm g{(const pg8::bf16_t*)(ws + WS_H), (const pg8::bf16_t*)(ws + WS_WIN0), MR, E_IN, OPQ(256), D}; pg8::CtxSplitOrderN S{D / 256, 256, E_IN / 256, F.G, cb};
          pg8::EpiCtxPartial E{(float*)(ws + WS_PRJF), 256, E_IN};
          pg8::gemm_phase<pg8::EpiCtxPartial, pg8::CtxSplitOrderN, true, true>(F.lds + RING_OFF, g, S, E); }
        p0_rest(F, args, (2 * (E_IN / 256) * (D / 256)) % F.G);
    } SEAM(2);
    if (IN(3)) REP(3) { p3_post0(F, args); } SEAM(3);
    if (IN(4)) REP(4) { for (int u = F.vcu; u < NB * 4 * NCH; u += F.G) ret_u_unit(F, args, u); } SEAM(4);
    if (IN(5)) REP(5) { ret_prefix(F, args); } SEAM(5);
    if (IN(6)) REP(6) {
        if (REPN(6) == 1) {
            for (int i = cb; i < 264; i += F.G) {
                int u = i; if (F.G == 256 && i < 256) { const int x = i & 7, kk = i >> 3; u = ((x >> 2) << 7) | (((x >> 1) & 1) * 2 + (x & 1)) << 5 | kk; }
                attn0_unit(F, u); }
            for (;;) {
                if (F.tid == 0) F.MISC[0] = __hip_atomic_fetch_add((unsigned*)(F.ctl + CW_QUEUE + 32), 1u, RLX_AGENT);
                __syncthreads(); const int u = (int)F.MISC[0]; __syncthreads();
                if (u >= NB * 4 * NCH) break;
                ret_out_unit(F, args, u);
            }
        } else {
            for (int i = cb; i < 264 * 2; i += F.G) attn0_unit(F, i % 264);
            for (int i = cb; i < NB * 4 * NCH * 2; i += F.G) ret_out_unit(F, args, i % (NB * 4 * NCH));
        }
    } SEAM(6);
    if (IN(7)) REP(7) {
        pg8::Gemm g{(const pg8::bf16_t*)(ws + WS_MIX0), (const pg8::bf16_t*)(ws + WS_WOUT0), MR, D, OPQ(D)}; pg8::StaticOrder S; S.init(MR, D, F.G, cb);
        pg8::EpiStore E{(pg8::bf16_t*)(ws + WS_Y0), D, D / 256};
        pg8::gemm_phase<pg8::EpiStore, pg8::StaticOrder, true, true>(F.lds + RING_OFF, g, S, E);
    } SEAM(7);
    if (IN(8)) REP(8) { p_resid_all<0>(F, args, (const bf16*)(ws + WS_Y0), 0, 0); } SEAM(8);
    if (IN(9)) REP(9) {
        pg8::Gemm g{(const pg8::bf16_t*)(ws + WS_H), (const pg8::bf16_t*)(ws + WS_WGU0), MR, 2 * FFH, OPQ(D)}; pg8::StaticOrder S; S.init(MR, 2 * FFH, F.G, cb);
        pg8::EpiSwiglu E{(pg8::bf16_t*)(ws + WS_ACT0), FFH, 2 * FFH / 256};
        pg8::gemm_phase<pg8::EpiSwiglu, pg8::StaticOrder, true, true>(F.lds + RING_OFF, g, S, E);
    } SEAM(9);
    if (IN(10)) REP(10) {
        { pg8::Gemm g{(const pg8::bf16_t*)(ws + WS_ACT0), (const pg8::bf16_t*)(ws + WS_WD0), MR, D, OPQ(FFH)}; pg8::LatOrder S; S.init(ML, D, F.G, cb);
          pg8::EpiStore E{(pg8::bf16_t*)(ws + WS_Y0), D, D / 256};
          pg8::gemm_phase<pg8::EpiStore, pg8::LatOrder, true, true>(F.lds + RING_OFF, g, S, E); }
        { pg8::Gemm g{(const pg8::bf16_t*)(ws + WS_ACT0), (const pg8::bf16_t*)(ws + WS_WD0), MR, D, OPQ(256), FFH}; pg8::CtxSplitOrder S{FFH / 256, 256, F.G, cb};
          pg8::EpiAtomicCtx E{(float*)(ws + WS_Y0F), 256};
          pg8::gemm_phase<pg8::EpiAtomicCtx, pg8::CtxSplitOrder, true, true>(F.lds + RING_OFF, g, S, E); }
    } SEAM(10);
    if (IN(11)) REP(11) { p_resid_all<FFH / 256>(F, args, (const bf16*)(ws + WS_Y0), 0, 1); } SEAM(11);
    if (IN(12)) REP(12) {
        pg8::Gemm g{(const pg8::bf16_t*)(ws + WS_H), (const pg8::bf16_t*)(ws + WS_WIN1), MR, O_INP, OPQ(D)}; pg8::StaticOrder S; S.init(MR, O_INP, F.G, cb);
        pg8::EpiSplit1 E{(pg8::bf16_t*)(ws + WS_KV1), (pg8::bf16_t*)(ws + WS_RWQ)};
        pg8::gemm_phase<pg8::EpiSplit1, pg8::StaticOrder, true, true>(F.lds + RING_OFF, g, S, E);
    } SEAM(12);
    if (IN(13)) REP(13) { p13_prep1(F, args); } SEAM(13);
    if (IN(14)) REP(14) {
        pg8::Gemm g{(const pg8::bf16_t*)(ws + WS_LIN), (const pg8::bf16_t*)(ws + WS_WL), MR, 2560, OPQ(384)}; pg8::LoraOrder S; S.init(MR, 2560, F.G, cb);
        pg8::EpiLora E{(pg8::bf16_t*)(ws + WS_SCAN + SA_L0 * SCAN_ARR), (pg8::bf16_t*)(ws + WS_SCAN + SA_L1 * SCAN_ARR), (pg8::bf16_t*)(ws + WS_SCAN + SA_A0 * SCAN_ARR), (pg8::bf16_t*)(ws + WS_SCAN + SA_A1 * SCAN_ARR),
                       (pg8::bf16_t*)(ws + WS_SCAN + SA_G * SCAN_ARR), args.in[I_RW0], args.in[I_RA0]};
        pg8::gemm_phase<pg8::EpiLora, pg8::LoraOrder, true, true>(F.lds + RING_OFF, g, S, E);
    } SEAM(14);
    if (IN(15)) REP(15) { ck_precompute(F, args); } SEAM(15);
    if (IN(16)) REP(16) {
        #ifdef OLD_SCAN
            if (cb < 128) { if (cb & 1) rwkv_scan<1, REPN(16)>(F, args, cb >> 1); else rwkv_scan<0, REPN(16)>(F, args, cb >> 1); __syncthreads(); }
#else
            if (cb < NCONS) { if (cb & 1) ck_consume<1>(F, cb >> 1); else ck_consume<0>(F, cb >> 1); __syncthreads();
                if (F.tid == 0) __hip_atomic_fetch_add((unsigned*)(F.ctl + CW_CONSDONE), 1u, RLX_AGENT); }
#endif
        for (;;) {
            if (F.tid == 0) F.MISC[0] = __hip_atomic_fetch_add((unsigned*)(F.ctl + CW_QUEUE + 64 * rep_), 1u, RLX_AGENT);
            __syncthreads(); const unsigned u = F.MISC[0]; __syncthreads();
            if (u >= (unsigned)(A1_NU + MOE_FILL_NCH)) break;
            constexpr int NPC = A1_NU - A1_NWH, A1_MIX = 2; static_assert(NPC * A1_MIX <= MOE_FILL_NCH, "interleave");
            int au = (int)u, fc = -1;
            if (u >= (unsigned)A1_NWH) { const int v = (int)u - A1_NWH;
                if (v < NPC * (A1_MIX + 1)) { const int per = v / (A1_MIX + 1), slot = v % (A1_MIX + 1); if (slot) fc = per * A1_MIX + slot - 1; else au = A1_NWH + per; }
                else fc = v - NPC; }
            if (fc >= 0) { moe_gu_fill_chunk(F, args, fc); continue; }
            attn1_unit(F, au);
        }
    } SEAM(16);
    if (IN(17)) REP(17) { p15_finish1(F, args); } SEAM(17);
    if (IN(18)) REP(18) {
        pg8::Gemm g{(const pg8::bf16_t*)(ws + WS_H), (const pg8::bf16_t*)(ws + WS_WOUT1), MR, D, OPQ(D)}; pg8::LatOrder S; S.init(ML, D, F.G, cb);
        pg8::EpiStore E{(pg8::bf16_t*)(ws + WS_Y1), D, D / 256};
        pg8::gemm_phase<pg8::EpiStore, pg8::LatOrder, true, true>(F.lds + RING_OFF, g, S, E);
    } SEAM(18);
    if (IN(19)) REP(19) { p17_route(F, args); } SEAM(19);
    if (IN(20)) REP(20) { p18_gather(F, args); } SEAM(20);
    if (IN(21)) REP(21) {
        int off[NE + 1]; const int nT = moe_offsets(F, off);
        pg8::Gemm g{(const pg8::bf16_t*)(ws + WS_AG), (const pg8::bf16_t*)(ws + WS_WMOE_GU), nT * 256, 2 * EH, OPQ(D)};
        pg8::MoeOrder S{nT, 2 * EH / 256, F.G, cb, (const int*)(ws + WS_TILEE)};
        pg8::EpiSwiglu E{(pg8::bf16_t*)(ws + WS_ACT1), EH, 2 * EH / 256};
        pg8::gemm_phase<pg8::EpiSwiglu, pg8::MoeOrder, true, true>(F.lds + RING_OFF, g, S, E);
        moe_weights_down_queue(F, args);
    } SEAM(21);
    if (IN(22)) REP(22) {
        int off[NE + 1]; const int nT = moe_offsets(F, off); const bool split = (F.G == 256); const int nMain = (split && nT > 128) ? 128 : nT;
        pg8::Gemm g{(const pg8::bf16_t*)(ws + WS_ACT1), (const pg8::bf16_t*)(ws + WS_WMOE_D), nT * 256, D, OPQ(EH)};
        pg8::MoeDownOrder S{pg8::MoeOrder{nMain, D / 256, F.G, cb, (const int*)(ws + WS_TILEE)}, nT, EH / 4};
        pg8::EpiDown E{(pg8::bf16_t*)(ws + WS_AG), (float*)(ws + WS_Y2F), 128, EH / 4, 8 * 256};
        pg8::gemm_phase<pg8::EpiDown, pg8::MoeDownOrder, true, true>(F.lds + RING_OFF, g, S, E);
    } SEAM(22);
    if (IN(23)) REP(23) { p21_final(F, args); }
#ifdef PROBE_MASK
    SEAM(23);
    if (blockIdx.x == 0 && F.tid == 0) { const unsigned long long t0_ = rt(); const unsigned long long w_ = (unsigned long long)(PROBE_AMP) * pr_[1]; while (rt() - t0_ < w_) __builtin_amdgcn_s_sleep(8); }
#endif
#undef IN
#undef SEAM
#undef GRID_BAR
}

extern "C" void kernel_launch(void* const* d_in, const int* in_sizes, int n_in, void* d_out, int out_size, void* d_ws, size_t ws_size, hipStream_t stream) {
    static int grid = 0;
    if (grid == 0) {
        if (n_in != 35 || in_sizes[0] != ML * D || out_size != ML * D || ws_size < WS_END) {
            fprintf(stderr, "kernel_launch: shape mismatch: n_in %d in0 %d out %d ws %zu (need >= %zu); nothing launched\n", n_in, n_in > 0 ? in_sizes[0] : -1, out_size, ws_size, (size_t)WS_END); grid = -1; return; }
        int dev = 0, cus = 0, per_cu = 0;
        if (hipGetDevice(&dev) != hipSuccess || hipDeviceGetAttribute(&cus, hipDeviceAttributeMultiprocessorCount, dev) != hipSuccess) { grid = -1; return; }
        if (hipFuncSetAttribute((const void*)hyb_fwd, hipFuncAttributeMaxDynamicSharedMemorySize, LDS_BYTES) != hipSuccess) { fprintf(stderr, "kernel_launch: hipFuncSetAttribute failed\n"); grid = -1; return; }
        if (hipOccupancyMaxActiveBlocksPerMultiprocessor(&per_cu, (const void*)hyb_fwd, NWAVES * 64, LDS_BYTES) != hipSuccess || per_cu < 1)
            fprintf(stderr, "kernel_launch: note: occupancy query reports %d workgroups per CU\n", per_cu);
        (void)hipGetLastError();
        if (cus < NCONS) { fprintf(stderr, "kernel_launch: %d CUs: the phase program needs at least %d co-resident workgroups (one per RWKV recurrence); nothing launched\n", cus, NCONS); grid = -1; return; }
        grid = cus;
    }
    if (grid < 0) return;
    if (hipMemsetAsync((char*)d_ws + WS_CTL, 0, CTL_ZERO_BYTES, stream) != hipSuccess) return;
    Args a{};
    for (int i = 0; i < 35; ++i) a.in[i] = (const float*)d_in[i];
    a.out = (float*)d_out; a.ws = (unsigned char*)d_ws;
    if (N_LAUNCHES == 1) { a.ph_lo = 0; a.ph_hi = NPH; hipLaunchKernelGGL(hyb_fwd, dim3(grid), dim3(NWAVES * 64), LDS_BYTES, stream, a); }
    else { for (int li = 0; li < NPH; ++li) { a.ph_lo = li; a.ph_hi = li + 1; hipLaunchKernelGGL(hyb_fwd, dim3(grid), dim3(NWAVES * 64), LDS_BYTES, stream, a); } }
    const hipError_t le = hipPeekAtLastError();
    if (le != hipSuccess) fprintf(stderr, "kernel_launch: launch failed: %s\n", hipGetErrorName(le));
}
```
